# Optimizing an MI355X kernel written in HIP

```python
import math
import jax
import jax.numpy as jnp
from jax import lax
import numpy as np

D_MODEL = 4096
BATCH = 1
SEQ = 16384
DEPTH = 4

CTX_LEN = 256
GRID_W = 64
N_MIXERS = 4
ROPE_BASE = 10000.0
LN_EPS = 1e-6
NEG_INF = -1e30
DN_ALPHA = (2 * DEPTH) ** 0.25
DN_BETA = (8 * DEPTH) ** -0.25

WA_HEADS = 32
WA_KV_HEADS = 8
WA_HEAD_DIM = D_MODEL // WA_HEADS
WA_WINDOW = 128
WA_BLOCK = 128
WA_Q_W = WA_HEADS * WA_HEAD_DIM
WA_KV_W = WA_KV_HEADS * WA_HEAD_DIM
WA_IN_W = 2 * WA_KV_W + 2 * WA_Q_W

RT_HEADS = 16
RT_KEY_DIM = D_MODEL // RT_HEADS
RT_VAL_DIM = 2 * RT_KEY_DIM
RT_QK_W = RT_HEADS * RT_KEY_DIM
RT_V_W = RT_HEADS * RT_VAL_DIM
RT_IN_W = 2 * RT_QK_W + 2 * RT_V_W
RT_CHUNK = 128

NA_HEADS = 32
NA_HEAD_DIM = D_MODEL // NA_HEADS
NA_W = NA_HEADS * NA_HEAD_DIM
NA_IN_W = 4 * NA_W
NA_KH = 8
NA_KW = 16

S5_WIDTH = D_MODEL
S5_GROUP = 16
S5_GROUPS = S5_WIDTH // S5_GROUP
S5_STATE = 64
S5_CHUNK = 128
S5_IN_W = 2 * S5_WIDTH

kernel_name = 'hybrid_prefix_diffusion_backbone'


def _layer_norm(x, g, b):
    xf = x.astype(jnp.float32)
    mu = xf.mean(-1, keepdims=True)
    var = jnp.square(xf - mu).mean(-1, keepdims=True)
    return ((xf - mu) * lax.rsqrt(var + LN_EPS) * g.astype(jnp.float32) + b.astype(jnp.float32)).astype(x.dtype)


def _rope_1d(x, pos):
    half = x.shape[-1] // 2
    inv_freq = ROPE_BASE ** (-jnp.arange(half, dtype=jnp.float32) / half)
    ang = pos.astype(jnp.float32)[:, None] * inv_freq[None, :]
    cos = jnp.cos(ang)[None, :, None, :]
    sin = jnp.sin(ang)[None, :, None, :]
    x1 = x[..., :half].astype(jnp.float32)
    x2 = x[..., half:].astype(jnp.float32)
    return jnp.concatenate([x1 * cos - x2 * sin, x2 * cos + x1 * sin], axis=-1).astype(x.dtype)


def _rope_2d(x, rows, cols):
    half = x.shape[-1] // 2
    return jnp.concatenate([_rope_1d(x[..., :half], rows), _rope_1d(x[..., half:], cols)], axis=-1)


def _joint_softmax(scores, sink=None):
    parts = list(scores)
    if sink is not None:
        parts.append(jnp.broadcast_to(sink, parts[0].shape[:-1] + (1,)))
    p = jax.nn.softmax(jnp.concatenate(parts, axis=-1), axis=-1)
    out, start = [], 0
    for s in scores:
        n = s.shape[-1]
        out.append(p[..., start:start + n])
        start += n
    return out


def _mixer_window_gqa(h_lat, h_ctx, w_in, w_out, sink, ctx_out):
    B, L, _ = h_lat.shape
    n_ctx = h_ctx.shape[1]
    G = WA_HEADS // WA_KV_HEADS
    scale = WA_HEAD_DIM ** -0.5
    pos = jnp.arange(L)
    rows, cols = pos // GRID_W, pos % GRID_W
    p = h_lat @ w_in
    k = _rope_2d(p[..., :WA_KV_W].reshape(B, L, WA_KV_HEADS, WA_HEAD_DIM), rows, cols)
    v = p[..., WA_KV_W:2 * WA_KV_W].reshape(B, L, WA_KV_HEADS, WA_HEAD_DIM)
    q = _rope_2d(p[..., 2 * WA_KV_W:2 * WA_KV_W + WA_Q_W].reshape(B, L, WA_HEADS, WA_HEAD_DIM), rows, cols)
    q = (q * scale).reshape(B, L, WA_KV_HEADS, G, WA_HEAD_DIM)
    z = p[..., 2 * WA_KV_W + WA_Q_W:]
    pc = h_ctx @ (w_in if ctx_out else w_in[:, :2 * WA_KV_W])
    kc = pc[..., :WA_KV_W].reshape(B, n_ctx, WA_KV_HEADS, WA_HEAD_DIM)
    vc = pc[..., WA_KV_W:2 * WA_KV_W].reshape(B, n_ctx, WA_KV_HEADS, WA_HEAD_DIM)
    sink_g = sink.astype(jnp.float32).reshape(WA_KV_HEADS, G)[None, :, :, None, None]
    pad = ((0, 0), (WA_BLOCK, WA_BLOCK), (0, 0), (0, 0))
    k_pad, v_pad = jnp.pad(k, pad), jnp.pad(v, pad)
    offs_q = jnp.arange(WA_BLOCK)
    offs_k = jnp.arange(3 * WA_BLOCK) - WA_BLOCK

    def block(j):
        start = j * WA_BLOCK
        qb = lax.dynamic_slice_in_dim(q, start, WA_BLOCK, axis=1)
        kb = lax.dynamic_slice_in_dim(k_pad, start, 3 * WA_BLOCK, axis=1)
        vb = lax.dynamic_slice_in_dim(v_pad, start, 3 * WA_BLOCK, axis=1)
        kpos = start + offs_k
        valid = (jnp.abs(offs_q[:, None] - offs_k[None, :]) <= WA_WINDOW) & ((kpos >= 0) & (kpos < L))[None, :]
        s_loc = jnp.where(valid, jnp.einsum('bqhgd,bkhd->bhgqk', qb, kb).astype(jnp.float32), NEG_INF)
        s_ctx = jnp.einsum('bqhgd,bkhd->bhgqk', qb, kc).astype(jnp.float32)
        p_loc, p_ctx = _joint_softmax([s_loc, s_ctx], sink_g)
        return (jnp.einsum('bhgqk,bkhd->bqhgd', p_loc.astype(vb.dtype), vb)
                + jnp.einsum('bhgqk,bkhd->bqhgd', p_ctx.astype(vc.dtype), vc))

    o = lax.map(block, jnp.arange(L // WA_BLOCK))
    o = jnp.moveaxis(o, 0, 1).reshape(B, L, WA_Q_W)
    y_lat = (o * jax.nn.silu(z)) @ w_out
    if not ctx_out:
        return y_lat, None
    qc = (pc[..., 2 * WA_KV_W:2 * WA_KV_W + WA_Q_W] * scale).reshape(B, n_ctx, WA_KV_HEADS, G, WA_HEAD_DIM)
    zc = pc[..., 2 * WA_KV_W + WA_Q_W:]
    (p_cc,) = _joint_softmax([jnp.einsum('bqhgd,bkhd->bhgqk', qc, kc).astype(jnp.float32)], sink_g)
    oc = jnp.einsum('bhgqk,bkhd->bqhgd', p_cc.astype(vc.dtype), vc).reshape(B, n_ctx, WA_Q_W)
    y_ctx = (oc * jax.nn.silu(zc)) @ w_out
    return y_lat, y_ctx


def _retention_scan(q, k, v, log_g, s0, inclusive):
    B, L, H, _ = k.shape
    n = L // RT_CHUNK
    idx = jnp.arange(RT_CHUNK, dtype=jnp.float32)
    diff = idx[:, None] - idx[None, :]
    mask = (diff >= 0) if inclusive else (diff > 0)
    d_intra = jnp.where(mask[None], jnp.exp(jnp.maximum(diff, 0.0)[None] * log_g[:, None, None]), 0.0)
    q_decay = jnp.exp((idx[:, None] + 1.0) * log_g[None, :])[None, :, :, None]
    k_decay = jnp.exp((RT_CHUNK - 1.0 - idx[:, None]) * log_g[None, :])[None, :, :, None]
    c_decay = jnp.exp(RT_CHUNK * log_g)[None, :, None, None]
    emit = q is not None

    def chunks(t):
        return jnp.moveaxis(t.reshape(B, n, RT_CHUNK, *t.shape[2:]), 1, 0)

    def step(s, xs):
        if emit:
            qc, kc, vc = xs
        else:
            kc, vc = xs
        s_new = c_decay * s + jnp.einsum('bjhd,bjhe->bhde', kc * k_decay, vc)
        if not emit:
            return s_new, None
        att = jnp.einsum('bihd,bjhd->bhij', qc, kc) * d_intra[None]
        o = jnp.einsum('bhij,bjhe->bihe', att, vc) + jnp.einsum('bihd,bhde->bihe', qc * q_decay, s)
        return s_new, o

    xs = (chunks(q), chunks(k), chunks(v)) if emit else (chunks(k), chunks(v))
    s_fin, o = lax.scan(step, s0, xs)
    if emit:
        o = jnp.moveaxis(o, 0, 1).reshape(B, L, H, v.shape[-1])
    return o, s_fin


def _retention_out(o, z, w_out):
    B, L = o.shape[:2]
    mu = o.mean(-1, keepdims=True)
    var = jnp.square(o - mu).mean(-1, keepdims=True)
    y = ((o - mu) * lax.rsqrt(var + LN_EPS)).reshape(B, L, RT_V_W).astype(z.dtype)
    return (y * jax.nn.silu(z)) @ w_out


def _mixer_retention(h_lat, h_ctx, w_in, w_out, log_decay, ctx_out):
    B, L, _ = h_lat.shape
    lg_f = log_decay[0].astype(jnp.float32)
    lg_b = log_decay[1].astype(jnp.float32)
    kscale = RT_KEY_DIM ** -0.5

    def heads(t, d):
        return t.reshape(B, t.shape[1], RT_HEADS, d).astype(jnp.float32)

    s0 = jnp.zeros((B, RT_HEADS, RT_KEY_DIM, RT_VAL_DIM), jnp.float32)
    pc = h_ctx @ (w_in if ctx_out else w_in[:, :RT_QK_W + RT_V_W])
    kc = heads(pc[..., :RT_QK_W], RT_KEY_DIM) * kscale
    vc = heads(pc[..., RT_QK_W:RT_QK_W + RT_V_W], RT_VAL_DIM)
    qc = heads(pc[..., RT_QK_W + RT_V_W:2 * RT_QK_W + RT_V_W], RT_KEY_DIM) if ctx_out else None
    oc_f, sc_f = _retention_scan(qc, kc, vc, lg_f, s0, True)
    oc_b, sc_b = _retention_scan(qc[:, ::-1] if ctx_out else None, kc[:, ::-1], vc[:, ::-1], lg_b, s0, False)
    p = h_lat @ w_in
    pos = jnp.arange(L)
    k = _rope_1d(heads(p[..., :RT_QK_W], RT_KEY_DIM), pos) * kscale
    v = heads(p[..., RT_QK_W:RT_QK_W + RT_V_W], RT_VAL_DIM)
    q = _rope_1d(heads(p[..., RT_QK_W + RT_V_W:2 * RT_QK_W + RT_V_W], RT_KEY_DIM), pos)
    z = p[..., 2 * RT_QK_W + RT_V_W:]
    o_f, _ = _retention_scan(q, k, v, lg_f, sc_f, True)
    o_b, _ = _retention_scan(q[:, ::-1], k[:, ::-1], v[:, ::-1], lg_b, sc_b, False)
    y_lat = _retention_out(o_f + o_b[:, ::-1], z, w_out)
    if not ctx_out:
        return y_lat, None
    y_ctx = _retention_out(oc_f + oc_b[:, ::-1], pc[..., 2 * RT_QK_W + RT_V_W:], w_out)
    return y_lat, y_ctx


def _mixer_neighbourhood(h_lat, h_ctx, w_in, w_out, rpb, ctx_out):
    B, L, _ = h_lat.shape
    n_ctx = h_ctx.shape[1]
    rows = L // GRID_W
    kh = min(NA_KH, rows)
    scale = NA_HEAD_DIM ** -0.5
    p = h_lat @ w_in
    grid = (B, rows, GRID_W, NA_HEADS, NA_HEAD_DIM)
    k = p[..., :NA_W].reshape(grid)
    v = p[..., NA_W:2 * NA_W].reshape(grid)
    q = (p[..., 2 * NA_W:3 * NA_W] * scale).reshape(grid)
    z = p[..., 3 * NA_W:]
    pc = h_ctx @ (w_in if ctx_out else w_in[:, :2 * NA_W])
    kc = pc[..., :NA_W].reshape(B, n_ctx, NA_HEADS, NA_HEAD_DIM)
    vc = pc[..., NA_W:2 * NA_W].reshape(B, n_ctx, NA_HEADS, NA_HEAD_DIM)
    cq = jnp.arange(GRID_W)
    col_start = jnp.clip(cq - NA_KW // 2, 0, GRID_W - NA_KW)
    col_idx = col_start[:, None] + jnp.arange(NA_KW)[None, :]
    col_off = col_idx - cq[:, None] + (NA_KW - 1)
    rpb_f = rpb.astype(jnp.float32)

    def row_block(r):
        rs = jnp.clip(r - kh // 2, 0, rows - kh)
        k_g = lax.dynamic_slice_in_dim(k, rs, kh, axis=1)[:, :, col_idx]
        v_g = lax.dynamic_slice_in_dim(v, rs, kh, axis=1)[:, :, col_idx]
        q_r = lax.dynamic_index_in_dim(q, r, axis=1, keepdims=False)
        row_off = rs + jnp.arange(kh) - r + (NA_KH - 1)
        bias = jnp.transpose(rpb_f[:, row_off][:, :, col_off], (0, 2, 1, 3))
        s_loc = jnp.einsum('bqhd,baqwhd->bhqaw', q_r, k_g).astype(jnp.float32) + bias[None]
        s_loc = s_loc.reshape(B, NA_HEADS, GRID_W, kh * NA_KW)
        s_ctx = jnp.einsum('bqhd,bkhd->bhqk', q_r, kc).astype(jnp.float32)
        p_loc, p_ctx = _joint_softmax([s_loc, s_ctx])
        p_loc = p_loc.reshape(B, NA_HEADS, GRID_W, kh, NA_KW).astype(v_g.dtype)
        return (jnp.einsum('bhqaw,baqwhd->bqhd', p_loc, v_g)
                + jnp.einsum('bhqk,bkhd->bqhd', p_ctx.astype(vc.dtype), vc))

    o = lax.map(row_block, jnp.arange(rows))
    o = jnp.moveaxis(o, 0, 1).reshape(B, L, NA_W)
    y_lat = (o * jax.nn.silu(z)) @ w_out
    if not ctx_out:
        return y_lat, None
    qc = (pc[..., 2 * NA_W:3 * NA_W] * scale).reshape(B, n_ctx, NA_HEADS, NA_HEAD_DIM)
    (p_cc,) = _joint_softmax([jnp.einsum('bqhd,bkhd->bhqk', qc, kc).astype(jnp.float32)])
    oc = jnp.einsum('bhqk,bkhd->bqhd', p_cc.astype(vc.dtype), vc).reshape(B, n_ctx, NA_W)
    y_ctx = (oc * jax.nn.silu(pc[..., 3 * NA_W:])) @ w_out
    return y_lat, y_ctx


def _linear_combine(e1, e2):
    a1, b1 = e1
    a2, b2 = e2
    return a1 * a2, a2 * b1 + b2


def _s5_discretise(a_re, a_im, log_dt, b_mat):
    lam = lax.complex(a_re.astype(jnp.float32), a_im.astype(jnp.float32))
    dt = jnp.exp(log_dt.astype(jnp.float32))[:, None]
    lam_bar = jnp.exp(lam * dt)
    b_bar = ((lam_bar - 1.0) / lam)[..., None] * b_mat
    return lam_bar, b_bar


def _s5_scan(u, lam_bar, b_bar, c_mat, x0, emit):
    B, L, G, N = u.shape
    n = L // S5_CHUNK
    a = jnp.broadcast_to(lam_bar, (B, S5_CHUNK) + lam_bar.shape)

    def step(x, u_blk):
        bu = jnp.einsum('bcgn,gpn->bcgp', u_blk.astype(jnp.complex64), b_bar)
        bu = bu.at[:, 0].add(lam_bar * x)
        _, xs = lax.associative_scan(_linear_combine, (a, bu), axis=1)
        y = jnp.einsum('bcgp,gnp->bcgn', xs, c_mat).real if emit else None
        return xs[:, -1], y

    x_fin, y = lax.scan(step, x0, jnp.moveaxis(u.reshape(B, n, S5_CHUNK, G, N), 1, 0))
    if emit:
        y = jnp.moveaxis(y, 0, 1).reshape(B, L, G, N)
    return y, x_fin


def _s5_out(y, u, z, d_skip, w_glu, b_glu, w_out):
    B, L = y.shape[:2]
    y = (y + d_skip.astype(jnp.float32).reshape(S5_GROUPS, S5_GROUP) * u).reshape(B, L, S5_WIDTH)
    y = jax.nn.gelu(y).astype(z.dtype)
    y = y * jax.nn.sigmoid(y @ w_glu + b_glu)
    return (y * jax.nn.silu(z)) @ w_out


def _mixer_s5(h_lat, h_ctx, w_in, a_re, a_im, log_dt, b_re, b_im, c_re, c_im, d_skip, w_glu, b_glu, w_out, ctx_out):
    B, L, _ = h_lat.shape
    b_mat = lax.complex(b_re.astype(jnp.float32), b_im.astype(jnp.float32))
    c_mat = lax.complex(c_re.astype(jnp.float32), c_im.astype(jnp.float32))
    fwd = _s5_discretise(a_re[0], a_im[0], log_dt[0], b_mat)
    bwd = _s5_discretise(a_re[1], a_im[1], log_dt[1], b_mat)
    x0 = jnp.zeros((B, S5_GROUPS, S5_STATE), jnp.complex64)

    def groups(t):
        return t.reshape(B, t.shape[1], S5_GROUPS, S5_GROUP).astype(jnp.float32)

    pc = h_ctx @ (w_in if ctx_out else w_in[:, :S5_WIDTH])
    uc = groups(pc[..., :S5_WIDTH])
    yc_f, xc_f = _s5_scan(uc, fwd[0], fwd[1], c_mat, x0, ctx_out)
    yc_b, xc_b = _s5_scan(uc[:, ::-1], bwd[0], bwd[1], c_mat, x0, ctx_out)
    p = h_lat @ w_in
    u = groups(p[..., :S5_WIDTH])
    y_f, _ = _s5_scan(u, fwd[0], fwd[1], c_mat, xc_f, True)
    y_b, _ = _s5_scan(u[:, ::-1], bwd[0], bwd[1], c_mat, xc_b, True)
    y_lat = _s5_out(y_f + y_b[:, ::-1], u, p[..., S5_WIDTH:], d_skip, w_glu, b_glu, w_out)
    if not ctx_out:
        return y_lat, None
    y_ctx = _s5_out(yc_f + yc_b[:, ::-1], uc, pc[..., S5_WIDTH:], d_skip, w_glu, b_glu, w_out)
    return y_lat, y_ctx


def setup_inputs(seed: int = 0) -> dict:
    key = jax.random.key(seed)
    keys = iter(jax.random.split(key, 40))
    f32 = jnp.float32

    def nrm(shape, std=1.0):
        return std * jax.random.normal(next(keys), shape, f32)

    nA, nB, nC, nD = [len(range(m, DEPTH, N_MIXERS)) for m in range(N_MIXERS)]
    D = D_MODEL
    G, P, N, E = S5_GROUPS, S5_STATE, S5_GROUP, S5_WIDTH
    rt_base = jnp.log1p(-(2.0 ** (-5.0 - jnp.arange(RT_HEADS, dtype=f32))))
    return {
        'x': nrm((BATCH, SEQ, D)),
        'c': nrm((BATCH, D)),
        'ctx': nrm((BATCH, CTX_LEN, D)),
        'c_ctx': nrm((D,)),
        'mod_w': nrm((DEPTH, D, 3 * D), D ** -0.5),
        'mod_b': nrm((DEPTH, 3 * D), 0.01),
        'ln_g': 1.0 + nrm((DEPTH, D), 0.02),
        'ln_b': nrm((DEPTH, D), 0.02),
        'wa_w_in': nrm((nA, D, WA_IN_W), D ** -0.5),
        'wa_w_out': nrm((nA, WA_Q_W, D), DN_BETA * WA_Q_W ** -0.5),
        'wa_sink': nrm((nA, WA_HEADS), 0.5),
        'rt_w_in': nrm((nB, D, RT_IN_W), D ** -0.5),
        'rt_w_out': nrm((nB, RT_V_W, D), DN_BETA * RT_V_W ** -0.5),
        'rt_log_decay': rt_base * jnp.exp(nrm((nB, 2, RT_HEADS), 0.1)),
        'na_w_in': nrm((nC, D, NA_IN_W), D ** -0.5),
        'na_w_out': nrm((nC, NA_W, D), DN_BETA * NA_W ** -0.5),
        'na_rpb': nrm((nC, NA_HEADS, 2 * NA_KH - 1, 2 * NA_KW - 1), 0.1),
        's5_w_in': nrm((nD, D, S5_IN_W), D ** -0.5),
        's5_a_re': -0.5 * jnp.exp(nrm((nD, 2, G, P), 0.05)),
        's5_a_im': jnp.pi * jnp.arange(P, dtype=f32) + nrm((nD, 2, G, P), 0.05),
        's5_log_dt': jax.random.uniform(next(keys), (nD, 2, G), f32, math.log(1e-3), math.log(1e-1)),
        's5_b_re': nrm((nD, G, P, N), (2 * N) ** -0.5),
        's5_b_im': nrm((nD, G, P, N), (2 * N) ** -0.5),
        's5_c_re': nrm((nD, G, N, P), (2 * P) ** -0.5),
        's5_c_im': nrm((nD, G, N, P), (2 * P) ** -0.5),
        's5_d': nrm((nD, E)),
        's5_w_glu': nrm((nD, E, E), E ** -0.5),
        's5_b_glu': nrm((nD, E), 0.01),
        's5_w_out': nrm((nD, E, D), DN_BETA * E ** -0.5),
    }


def reference(x, c, ctx, c_ctx, mod_w, mod_b, ln_g, ln_b,
              wa_w_in, wa_w_out, wa_sink,
              rt_w_in, rt_w_out, rt_log_decay,
              na_w_in, na_w_out, na_rpb,
              s5_w_in, s5_a_re, s5_a_im, s5_log_dt, s5_b_re, s5_b_im, s5_c_re, s5_c_im,
              s5_d, s5_w_glu, s5_b_glu, s5_w_out):
    Dm = D_MODEL
    silu_c = jax.nn.silu(c)
    silu_cc = jax.nn.silu(c_ctx)
    x_ctx = ctx
    for i in range(DEPTH):
        m, j = i % N_MIXERS, i // N_MIXERS
        ctx_out = i < DEPTH - 1
        mod = silu_c @ mod_w[i] + mod_b[i]
        shift, scale, gate = jnp.split(mod[:, None, :], 3, axis=-1)
        n_mod = (3 if ctx_out else 2) * Dm
        mod_c = silu_cc @ mod_w[i][:, :n_mod] + mod_b[i][:n_mod]
        h_lat = x * (1.0 + scale) + shift
        h_ctx = x_ctx * (1.0 + mod_c[Dm:2 * Dm]) + mod_c[:Dm]
        if m == 0:
            y_lat, y_ctx = _mixer_window_gqa(h_lat, h_ctx, wa_w_in[j], wa_w_out[j], wa_sink[j], ctx_out)
        elif m == 1:
            y_lat, y_ctx = _mixer_retention(h_lat, h_ctx, rt_w_in[j], rt_w_out[j], rt_log_decay[j], ctx_out)
        elif m == 2:
            y_lat, y_ctx = _mixer_neighbourhood(h_lat, h_ctx, na_w_in[j], na_w_out[j], na_rpb[j], ctx_out)
        else:
            y_lat, y_ctx = _mixer_s5(h_lat, h_ctx, s5_w_in[j], s5_a_re[j], s5_a_im[j], s5_log_dt[j],
                                     s5_b_re[j], s5_b_im[j], s5_c_re[j], s5_c_im[j], s5_d[j],
                                     s5_w_glu[j], s5_b_glu[j], s5_w_out[j], ctx_out)
        x = _layer_norm(DN_ALPHA * x + gate * y_lat, ln_g[i], ln_b[i])
        if ctx_out:
            x_ctx = _layer_norm(DN_ALPHA * x_ctx + mod_c[2 * Dm:] * y_ctx, ln_g[i], ln_b[i])
    return x
```

```cpp
#include <hip/hip_runtime.h>
#include <cstdio>
#include <cstdint>
#include <cmath>

#define LAS __attribute__((address_space(3)))
typedef unsigned short bf16_t;
typedef short bf16x8 __attribute__((ext_vector_type(8)));
typedef short s16x4 __attribute__((ext_vector_type(4)));
typedef float f32x2 __attribute__((ext_vector_type(2)));
typedef float f32x4 __attribute__((ext_vector_type(4)));
typedef float f32x16 __attribute__((ext_vector_type(16)));
typedef unsigned u32x2 __attribute__((ext_vector_type(2)));
typedef unsigned u32x4 __attribute__((ext_vector_type(4)));

constexpr int DM = 4096, SEQ = 16384, NCTX = 256, MROWS = SEQ + NCTX;
constexpr int WA_INW = 10240, RT_INW = 24576, NA_INW = 16384, S5_INW = 8192;
constexpr float DN_ALPHA = 1.6817928305074292f;
constexpr float LN_EPS = 1e-6f;
constexpr float L2E = 1.4426950408889634f;
constexpr int NTHREADS = 512;
constexpr int LDS_BYTES = 163840;
constexpr int MISC_OFF = 163824;

constexpr size_t WS_CTL = 0;
constexpr size_t WS_MOD = 65536;
constexpr size_t WS_ROPEA = WS_MOD + 4ull * 2 * 3 * DM * 4;
constexpr size_t WS_ROPEB = WS_ROPEA + 320ull * 32 * 8;
constexpr size_t WS_W = WS_ROPEB + 16384ull * 128 * 8;
constexpr size_t W_WA_IN = 0, W_WA_OUT = W_WA_IN + 10240ull * 4096, W_RT_IN = W_WA_OUT + 4096ull * 4096, W_RT_OUT = W_RT_IN + 24576ull * 4096,
                 W_NA_IN = W_RT_OUT + 4096ull * 8192, W_NA_OUT = W_NA_IN + 16384ull * 4096, W_S5_IN = W_NA_OUT + 4096ull * 4096,
                 W_S5_GLU = W_S5_IN + 8192ull * 4096, W_S5_OUT = W_S5_GLU + 4096ull * 4096, W_END = W_S5_OUT + 4096ull * 4096;
constexpr size_t WS_X = WS_W + W_END * 2;
constexpr size_t WS_H = WS_X + (size_t)MROWS * DM * 4;
constexpr size_t WS_P = WS_H + (size_t)MROWS * DM * 2;
constexpr size_t WS_G = WS_P + (size_t)MROWS * 24576 * 2;
constexpr size_t WS_OF = WS_G + (size_t)MROWS * 8192 * 2;
constexpr size_t WS_OB = WS_OF + (size_t)MROWS * 8192 * 2;
constexpr size_t WS_YS = WS_OB + (size_t)MROWS * 8192 * 2;
constexpr size_t WS_END = WS_YS + 16ull * 256 * DM * 4;

typedef __bf16 bf16v2_t __attribute__((ext_vector_type(2)));
__device__ __forceinline__ unsigned cvt_pk_bf16(float lo, float hi) { bf16v2_t v; v[0] = (__bf16)lo; v[1] = (__bf16)hi; return __builtin_bit_cast(unsigned, v); }
__device__ __forceinline__ float bf_lo(unsigned w) { return __uint_as_float(w << 16); }
__device__ __forceinline__ float bf_hi(unsigned w) { return __uint_as_float(w & 0xffff0000u); }
__device__ __forceinline__ float bf2f(bf16_t b) { return __uint_as_float(((unsigned)b) << 16); }
__device__ __forceinline__ bf16_t f2bf(float f) { return (bf16_t)(cvt_pk_bf16(f, 0.f) & 0xffffu); }
__device__ __forceinline__ float silu_f(float v) { return v * __builtin_amdgcn_rcpf(1.0f + __expf(-v)); }
__device__ __forceinline__ float sigmoid_f(float v) { return __builtin_amdgcn_rcpf(1.0f + __expf(-v)); }

#define XB_TMO      128
#define XB_XCNT(j)  (256  + 64 * (j))
#define XB_XSUB(j)  (1280 + 64 * (j))
#define XB_XGEN(j)  (2304 + 64 * (j))
#define XB_TOP      3328
#define XB_TOPGEN   3392
#define XCD_BAR_WORDS 3456
#define XB_SPIN_CAP (1u << 18)
#define LAS __attribute__((address_space(3)))

__device__ __forceinline__ unsigned xb_ld(unsigned* p)              { return __hip_atomic_load(p, __ATOMIC_RELAXED, __HIP_MEMORY_SCOPE_AGENT); }
__device__ __forceinline__ unsigned xb_add(unsigned* p, unsigned v) { return __hip_atomic_fetch_add(p, v, __ATOMIC_RELAXED, __HIP_MEMORY_SCOPE_AGENT); }
__device__ __forceinline__ unsigned xb_xcc_id() { return (unsigned)__builtin_amdgcn_s_getreg((3 << 11) | 20) & 0xFu; }
#define XB_SPIN(cond, bar) do { unsigned _sp = 0; while (cond) { __builtin_amdgcn_s_sleep(1); \
    if ((++_sp & 255u) == 0u) { if (xb_ld(&(bar)[XB_TMO])) break; if (_sp > XB_SPIN_CAP) { atomicAdd(&(bar)[XB_TMO], 1u); break; } } } } while (0)

struct XcdBarrier {
    unsigned* bar; unsigned x;
    volatile LAS unsigned* st;
};

__device__ __forceinline__ XcdBarrier xcd_barrier_post(unsigned* bar, volatile LAS unsigned* st) {
    XcdBarrier b; b.bar = bar; b.x = xb_xcc_id(); b.st = st;
    if (threadIdx.x == 0) (void)xb_add(&bar[XB_XCNT(b.x)], 1u);
    return b;
}
__device__ __forceinline__ void xcd_barrier_complete(unsigned* bar, unsigned x, unsigned& nloc, unsigned& nx) {
    const unsigned G = gridDim.x * gridDim.y * gridDim.z;
    unsigned sum, cnt, mine, sp = 0u;
    for (;;) {
        sum = 0u; cnt = 0u; mine = 0u;
#pragma unroll
        for (unsigned j = 0; j < 16; ++j) { const unsigned c = xb_ld(&bar[XB_XCNT(j)]); sum += c; cnt += (c > 0u) ? 1u : 0u; mine = (j == x) ? c : mine; }
        if (sum == G) break;
        __builtin_amdgcn_s_sleep(1);
        if ((++sp & 255u) == 0u) { if (xb_ld(&bar[XB_TMO])) break; if (sp > XB_SPIN_CAP) { atomicAdd(&bar[XB_TMO], 1u); break; } }
    }
    nloc = mine > 0u ? mine : 1u; nx = cnt > 0u ? cnt : 1u;
}

__device__ __forceinline__ void xcd_barrier(const XcdBarrier& b) {
    asm volatile("s_waitcnt vmcnt(0)" ::: "memory");
    __syncthreads();
    if (threadIdx.x == 0) {
        unsigned* bar = b.bar;
        __builtin_amdgcn_s_waitcnt(0);
        unsigned nloc = b.st[0], nx = b.st[1];
        if (nloc == 0u) { xcd_barrier_complete(bar, b.x, nloc, nx); b.st[0] = nloc; b.st[1] = nx; }
        const unsigned old = xb_add(&bar[XB_XSUB(b.x)], 1u);
        const unsigned gen = old / nloc;
        if (old + 1u == (gen + 1u) * nloc) {
            __builtin_amdgcn_fence(__ATOMIC_RELEASE, "agent");
            asm volatile("s_waitcnt vmcnt(0)" ::: "memory");
            const unsigned og = xb_add(&bar[XB_TOP], 1u);
            const unsigned tg = og / nx;
            if (og + 1u == (tg + 1u) * nx) xb_add(&bar[XB_TOPGEN], 1u);
            else XB_SPIN(xb_ld(&bar[XB_TOPGEN]) == tg, bar);
            __builtin_amdgcn_fence(__ATOMIC_ACQUIRE, "agent");
            xb_add(&bar[XB_XGEN(b.x)], 1u);
            asm volatile("s_waitcnt vmcnt(0)" ::: "memory");
        } else {
            XB_SPIN(xb_ld(&bar[XB_XGEN(b.x)]) == gen, bar);
            __builtin_amdgcn_fence(__ATOMIC_ACQUIRE, "agent");
            asm volatile("s_waitcnt vmcnt(0)" ::: "memory");
        }
    }
    __syncthreads();
}

namespace pg8 {
#define PG8_LAS __attribute__((address_space(3)))
typedef unsigned short bf16_t;
typedef short bf16x8 __attribute__((ext_vector_type(8)));
typedef float f32x4 __attribute__((ext_vector_type(4)));
typedef unsigned u32x4 __attribute__((ext_vector_type(4)));
constexpr int BM = 256, BK = 64, HALF = 128, HTB = HALF * BK * 2  , STAGE_BYTES = 8 * HTB, NXCD = 8, WGM = 8;

__host__ __device__ __forceinline__ int lds_byte(int r, int c) { const int st = (r >> 4) * 2 + (c >> 5), rr = r & 15, cc = c & 31, ob = rr * 64 + cc * 2; return st * 1024 + (ob ^ (((ob >> 9) & 1) << 5)); }
__host__ __device__ __forceinline__ void stage_rc(int b, int& R, int& C) { const int st = b / 1024, sb = b % 1024, swz = sb ^ (((sb >> 9) & 1) << 5); R = (st >> 1) * 16 + swz / 64; C = (st & 1) * 32 + (swz % 64) / 2; }
__host__ __device__ __forceinline__ int perm32(int rho) { const int n = rho >> 4, i = rho & 15; return 8 * (i >> 2) + 4 * n + (i & 3); }

struct Unit { int pm, pn, koff, nkt, ks; };
struct Gemm { const bf16_t* A; const bf16_t* Bt; int M, N, K; };

struct StaticOrder {
    int nM, nN, nwg, G, c;
    __host__ __device__ void init(int M, int N, int G_, int c_) { nM = M / BM; nN = N / BM; nwg = nM * nN; G = G_; c = c_; }
    __host__ __device__ bool next(int i, Unit& u) const {
        const long L = (long)i * G + c; if (L >= nwg) return false;
        int wgid = (int)L; { const int q = nwg / NXCD, r = nwg % NXCD, xcd = wgid % NXCD, off = wgid / NXCD; wgid = (xcd < r ? xcd * (q + 1) : r * (q + 1) + (xcd - r) * q) + off; }
        const int nig = WGM * nN, gid = wgid / nig, fm = gid * WGM, gsz = (nM - fm) < WGM ? (nM - fm) : WGM;
        u.pm = fm + ((wgid % nig) % gsz); u.pn = (wgid % nig) / gsz; u.koff = 0; u.nkt = 0; u.ks = -1; return true;
    }
    __device__ __forceinline__ void a_ready(const Unit&) const {}
    __device__ __forceinline__ void done(const Unit&) const {}
};

struct DynOrder {
    int nM, nN, nwg, q, xcd;
    int qm, nks, pm_sub, sub_nkt;
    unsigned* ctr;
    volatile PG8_LAS int* slots;
    mutable int nf;
    __device__ void init(int M, int N, unsigned* ctr_, volatile PG8_LAS int* slots_, int xcd_, int nks_ = 0, int pm_sub_ = 0, int sub_nkt_ = 0) {
        nM = M / BM; nN = N / BM; nwg = nM * nN; qm = nwg / NXCD; nks = nks_; pm_sub = pm_sub_; sub_nkt = sub_nkt_; q = qm + (nN * nks_) / NXCD; ctr = ctr_; slots = slots_; xcd = xcd_ & 7; nf = 0; }
    __device__ __forceinline__ int fetch() const {
        for (int a = 0; a < NXCD; ++a) { const int x = (xcd + a) & 7;
            const unsigned k = __hip_atomic_fetch_add(ctr + 64 * x, 1u, __ATOMIC_RELAXED, __HIP_MEMORY_SCOPE_AGENT);
            if (k < (unsigned)qm) return x * qm + (int)k;
            if (k < (unsigned)q) return nwg + x * (q - qm) + (int)k - qm; }
        return -1;
    }
    __device__ __forceinline__ void prime() const { if (threadIdx.x == 0) { slots[0] = fetch(); slots[1] = fetch(); slots[2] = fetch(); } nf = 3; __syncthreads(); }
    __device__ __forceinline__ bool next(int i, Unit& u) const {
        const int wgid = __builtin_amdgcn_readfirstlane(slots[i & 3]);
        const bool sub = wgid >= nwg;
        const int s = sub ? wgid - nwg : 0, nk1 = nks > 0 ? nks : 1, spn = s / nk1, sks = s - spn * nk1;
        const int wm = (wgid < 0 || sub) ? 0 : wgid;
        const int x = wm / qm, k = wm - x * qm, full = WGM * nN, kk = k - full;
        Unit r;
        r.pm = sub ? pm_sub : (k < full ? WGM * x + (k % WGM) : NXCD * WGM); r.pn = sub ? spn : (k < full ? k / WGM : x * (qm - full) + kk);
        r.ks = sub ? sks : -1; r.nkt = sub ? sub_nkt : 0; r.koff = sub ? sks * sub_nkt * BK * 2 : 0;
        u = r;
        return wgid >= 0;
    }
    __device__ __forceinline__ void a_ready(const Unit&) const {}
    __device__ __forceinline__ void done(const Unit&) const { if (threadIdx.x == 0) slots[nf & 3] = fetch(); ++nf; }
};

typedef __bf16 bf16v2_t __attribute__((ext_vector_type(2)));
__device__ __forceinline__ unsigned cvt_pk_bf16(float lo, float hi) { bf16v2_t v; v[0] = (__bf16)lo; v[1] = (__bf16)hi; return __builtin_bit_cast(unsigned, v); }
__device__ __forceinline__ float e_silu(float v) { return v * __builtin_amdgcn_rcpf(1.0f + __expf(-v)); }

template <int LT> struct EpiIn {
    static constexpr bool PERM = true, AFTER_DRAIN = false;
    static constexpr int c1 = LT == 0 ? 1024 : LT == 1 ? 4096 : LT == 2 ? 8192 : 4096, c2 = LT == 0 ? 2048 : LT == 1 ? 12288 : LT == 2 ? 12288 : 8192, c3 = LT == 0 ? 6144 : LT == 1 ? 16384 : LT == 2 ? 12288 : 8192;
    static constexpr int m0 = LT == 0 ? 2 : LT == 1 ? 3 : 0, m1 = LT == 3 ? 1 : 0, m2 = LT == 0 ? 2 : LT == 1 ? 3 : LT == 2 ? 0 : 1, m3 = LT == 1 ? 0 : 1;
    bf16_t* O; int ldc;
    const float* ropeA; const float* ropeB;
    int seq_rows;
    __device__ __forceinline__ void operator()(const f32x4 (&acc)[2][2][4][2], const Unit& u, int wr, int wc, int fr, int fq) const {
        const int colt = u.pn * BM;
        int mode; float scl;
        if (colt < c1) { mode = m0; scl = (LT == 1) ? 0.0625f : 1.0f; } else if (colt < c2) { mode = m1; scl = (LT == 2) ? 0.08838834764831845f : 1.0f; }
        else if (colt < c3) { mode = m2; scl = (LT == 0) ? 0.08838834764831845f : 1.0f; } else { mode = m3; scl = 1.0f; }
        if (u.pm * BM >= seq_rows && mode >= 2) mode = 0;
        const int row0 = u.pm * BM + wr * 64 + fr, col0 = colt + wc * 32 + 8 * fq;
        if (mode >= 2) {
            f32x4 cs[2][2][2];
#define RP_ISSUE(b_) do { const int bj_ = (b_) >> 2, ai_ = ((b_) >> 1) & 1, mp_ = (b_) & 1; \
            _Pragma("unroll") for (int r_ = 0; r_ < 2; ++r_) { const int row_ = row0 + ai_ * HALF + (2 * mp_ + r_) * 16, col_ = col0 + bj_ * HALF; const float* tb_; \
                if (mode == 2) { const int jj0_ = (col_ & 127) >> 1; const int idx_ = (jj0_ < 32) ? (row_ >> 6) : 256 + (row_ & 63); tb_ = ropeA + ((size_t)idx_ * 32 + (jj0_ & 31)) * 2; } \
                else           { const int jj0_ = (col_ & 255) >> 1; tb_ = ropeB + ((size_t)row_ * 128 + jj0_) * 2; } \
                cs[(b_) & 1][r_][0] = *(const f32x4*)tb_; cs[(b_) & 1][r_][1] = *(const f32x4*)(tb_ + 4); } } while (0)
            RP_ISSUE(0);
#pragma unroll
            for (int b = 0; b < 8; ++b) {
                const int bj = b >> 2, ai = (b >> 1) & 1, mp = b & 1;
                if (b + 1 < 8) RP_ISSUE(b + 1);
#pragma unroll
                for (int r = 0; r < 2; ++r) {
                    const int m = 2 * mp + r, row = row0 + ai * HALF + m * 16;
                    const f32x4 v0 = acc[ai][bj][m][0], v1 = acc[ai][bj][m][1], cs0 = cs[b & 1][r][0], cs1 = cs[b & 1][r][1];
                    f32x4 w0, w1;
                    w0[0] = v0[0] * cs0[0] - v0[1] * cs0[1]; w0[1] = v0[1] * cs0[0] + v0[0] * cs0[1];
                    w0[2] = v0[2] * cs0[2] - v0[3] * cs0[3]; w0[3] = v0[3] * cs0[2] + v0[2] * cs0[3];
                    w1[0] = v1[0] * cs1[0] - v1[1] * cs1[1]; w1[1] = v1[1] * cs1[0] + v1[0] * cs1[1];
                    w1[2] = v1[2] * cs1[2] - v1[3] * cs1[3]; w1[3] = v1[3] * cs1[2] + v1[2] * cs1[3];
                    w0 *= scl; w1 *= scl;
                    u32x4 w; w.x = cvt_pk_bf16(w0[0], w0[1]); w.y = cvt_pk_bf16(w0[2], w0[3]); w.z = cvt_pk_bf16(w1[0], w1[1]); w.w = cvt_pk_bf16(w1[2], w1[3]);
                    *(u32x4*)(O + (size_t)row * ldc + col0 + bj * HALF) = w;
                }
            }
#undef RP_ISSUE
            return;
        }
#pragma unroll
        for (int ai = 0; ai < 2; ++ai)
#pragma unroll
            for (int m = 0; m < 4; ++m) {
                const int row = row0 + ai * HALF + m * 16;
                bf16_t* rowp = O + (size_t)row * ldc + col0;
#pragma unroll
                for (int bj = 0; bj < 2; ++bj) {
                    f32x4 v0 = acc[ai][bj][m][0], v1 = acc[ai][bj][m][1];
                    const int col = col0 + bj * HALF;
                    if (mode == 1) {
#pragma unroll
                        for (int j = 0; j < 4; ++j) { v0[j] = e_silu(v0[j]); v1[j] = e_silu(v1[j]); }
                    } else { v0 *= scl; v1 *= scl; }
                    u32x4 w; w.x = cvt_pk_bf16(v0[0], v0[1]); w.y = cvt_pk_bf16(v0[2], v0[3]); w.z = cvt_pk_bf16(v1[0], v1[1]); w.w = cvt_pk_bf16(v1[2], v1[3]);
                    *(u32x4*)(rowp + bj * HALF) = w;
                }
            }
    }
};

struct EpiOut {
    static constexpr bool PERM = true, AFTER_DRAIN = false;
    bf16_t* Y; int ldc;
    float* slab;
    __device__ __forceinline__ void operator()(const f32x4 (&acc)[2][2][4][2], const Unit& u, int wr, int wc, int fr, int fq) const {
        const int col0 = u.pn * BM + wc * 32 + 8 * fq;
        if (u.ks >= 0) {
            float* sp = slab + (size_t)u.ks * 256 * ldc + col0;
#pragma unroll
            for (int ai = 0; ai < 2; ++ai)
#pragma unroll
                for (int m = 0; m < 4; ++m) { float* rowp = sp + (size_t)(wr * 64 + fr + ai * HALF + m * 16) * ldc;
#pragma unroll
                    for (int bj = 0; bj < 2; ++bj) { *(f32x4*)(rowp + bj * HALF) = acc[ai][bj][m][0]; *(f32x4*)(rowp + bj * HALF + 4) = acc[ai][bj][m][1]; } }
            return;
        }
        const int row0 = u.pm * BM + wr * 64 + fr;
#pragma unroll
        for (int ai = 0; ai < 2; ++ai)
#pragma unroll
            for (int m = 0; m < 4; ++m) {
                bf16_t* rowp = Y + (size_t)(row0 + ai * HALF + m * 16) * ldc + col0;
#pragma unroll
                for (int bj = 0; bj < 2; ++bj) { const f32x4 v0 = acc[ai][bj][m][0], v1 = acc[ai][bj][m][1];
                    u32x4 w; w.x = cvt_pk_bf16(v0[0], v0[1]); w.y = cvt_pk_bf16(v0[2], v0[3]); w.z = cvt_pk_bf16(v1[0], v1[1]); w.w = cvt_pk_bf16(v1[2], v1[3]);
                    *(u32x4*)(rowp + bj * HALF) = w; }
            }
    }
};

struct EpiGlu {
    static constexpr bool PERM = true, AFTER_DRAIN = false;
    const bf16_t* A2; int lda; const bf16_t* P; int ldp; int szcol; const float* bglu; bf16_t* G; int ldg;
    __device__ __forceinline__ void operator()(const f32x4 (&acc)[2][2][4][2], const Unit& u, int wr, int wc, int fr, int fq) const {
        const int row0 = u.pm * BM + wr * 64 + fr, col0 = u.pn * BM + wc * 32 + 8 * fq;
        u32x4 av[2][2], zv[2][2];
#define GLU_ISSUE(b_) do { const int bj_ = (b_) >> 2, ai_ = ((b_) >> 1) & 1, mp_ = (b_) & 1; \
            _Pragma("unroll") for (int r_ = 0; r_ < 2; ++r_) { const int row_ = row0 + ai_ * HALF + (2 * mp_ + r_) * 16, col_ = col0 + bj_ * HALF; \
                av[(b_) & 1][r_] = *(const u32x4*)(A2 + (size_t)row_ * lda + col_); zv[(b_) & 1][r_] = *(const u32x4*)(P + (size_t)row_ * ldp + szcol + col_); } } while (0)
        f32x4 bb[2][2];
#pragma unroll
        for (int bj = 0; bj < 2; ++bj) { bb[bj][0] = *(const f32x4*)(bglu + col0 + bj * HALF); bb[bj][1] = *(const f32x4*)(bglu + col0 + bj * HALF + 4); }
        GLU_ISSUE(0);
#pragma unroll
        for (int bj = 0; bj < 2; ++bj) asm volatile("" : "+v"(bb[bj][0]), "+v"(bb[bj][1]));
#pragma unroll
        for (int b = 0; b < 8; ++b) {
            const int bj = b >> 2, ai = (b >> 1) & 1, mp = b & 1, col = col0 + bj * HALF;
            if (b + 1 < 8) GLU_ISSUE(b + 1);
            const f32x4 b0 = bb[bj][0], b1 = bb[bj][1];
#pragma unroll
            for (int r = 0; r < 2; ++r) {
                const int m = 2 * mp + r, row = row0 + ai * HALF + m * 16;
                const u32x4 a = av[b & 1][r], z = zv[b & 1][r];
                const f32x4 t0 = acc[ai][bj][m][0] + b0, t1 = acc[ai][bj][m][1] + b1;
                float q[8];
                q[0] = __uint_as_float(a.x << 16) * __uint_as_float(z.x << 16) * __builtin_amdgcn_rcpf(1.0f + __expf(-t0[0]));
                q[1] = __uint_as_float(a.x & 0xffff0000u) * __uint_as_float(z.x & 0xffff0000u) * __builtin_amdgcn_rcpf(1.0f + __expf(-t0[1]));
                q[2] = __uint_as_float(a.y << 16) * __uint_as_float(z.y << 16) * __builtin_amdgcn_rcpf(1.0f + __expf(-t0[2]));
                q[3] = __uint_as_float(a.y & 0xffff0000u) * __uint_as_float(z.y & 0xffff0000u) * __builtin_amdgcn_rcpf(1.0f + __expf(-t0[3]));
                q[4] = __uint_as_float(a.z << 16) * __uint_as_float(z.z << 16) * __builtin_amdgcn_rcpf(1.0f + __expf(-t1[0]));
                q[5] = __uint_as_float(a.z & 0xffff0000u) * __uint_as_float(z.z & 0xffff0000u) * __builtin_amdgcn_rcpf(1.0f + __expf(-t1[1]));
                q[6] = __uint_as_float(a.w << 16) * __uint_as_float(z.w << 16) * __builtin_amdgcn_rcpf(1.0f + __expf(-t1[2]));
                q[7] = __uint_as_float(a.w & 0xffff0000u) * __uint_as_float(z.w & 0xffff0000u) * __builtin_amdgcn_rcpf(1.0f + __expf(-t1[3]));
                u32x4 w; w.x = cvt_pk_bf16(q[0], q[1]); w.y = cvt_pk_bf16(q[2], q[3]); w.z = cvt_pk_bf16(q[4], q[5]); w.w = cvt_pk_bf16(q[6], q[7]);
                *(u32x4*)(G + (size_t)row * ldg + col) = w;
            }
        }
#undef GLU_ISSUE
    }
};

template <class Epi, class Sched, bool ALIGN_EPI = false, bool SP2 = false>
__device__ __forceinline__ void gemm_phase(PG8_LAS unsigned char* lds, const Gemm g, const Sched& S, const Epi& E) {
    const int tid = threadIdx.x, wid = __builtin_amdgcn_readfirstlane(tid >> 6), lane = tid & 63, wr = wid >> 2, wc = wid & 3, fr = lane & 15, fq = lane >> 4;
    const int K = g.K, nt = K / BK;
    unsigned voffA[2], voffB[2];
#pragma unroll
    for (int i = 0; i < 2; ++i) { int R, C; stage_rc(tid * 16 + i * 8192, R, C); const int Rb = Epi::PERM ? ((R & ~31) + perm32(R & 31)) : R;
        voffA[i] = (unsigned)(R * K + C) * 2u; voffB[i] = (unsigned)(Rb * K + C) * 2u; }
    const size_t kstep = (size_t)(BK * 2);
    const size_t hstep = (size_t)HALF * K * 2;
    const size_t tstep = 2 * hstep;
    const unsigned ldsw = (unsigned)wid * 1024u;
    const int aoff = lds_byte(wr * 64 + fr, fq * 8), boff = lds_byte(wc * 32 + fr, fq * 8);
#define PG8_SA(b, h) (((b) * 2 + (h)) * HTB)
#define PG8_SB(b, h) ((4 + (b) * 2 + (h)) * HTB)
#define PG8_STAGE(bufoff, gbase, voff) do { _Pragma("unroll") for (int _i = 0; _i < 2; ++_i) \
        __builtin_amdgcn_global_load_lds((const unsigned*)((const char*)(gbase) + (voff)[_i]), (PG8_LAS unsigned*)(lds + (bufoff) + ldsw + _i * 8192), 16, 0, 0); } while (0)
#define PG8_LDA(dst, b, h) do { _Pragma("unroll") for (int m = 0; m < 4; ++m) _Pragma("unroll") for (int k = 0; k < 2; ++k) dst[m][k] = *(const PG8_LAS bf16x8*)(lds + PG8_SA(b, h) + aoff + m * 2048 + k * 1024); } while (0)
#define PG8_LDB(dst, b, h) do { _Pragma("unroll") for (int n = 0; n < 2; ++n) _Pragma("unroll") for (int k = 0; k < 2; ++k) dst[n][k] = *(const PG8_LAS bf16x8*)(lds + PG8_SB(b, h) + boff + n * 2048 + k * 1024); } while (0)
#define PG8_MMA(ai, bj, At, Bt) do { __builtin_amdgcn_s_setprio(1); _Pragma("unroll") for (int m = 0; m < 4; ++m) _Pragma("unroll") for (int n = 0; n < 2; ++n) _Pragma("unroll") for (int k = 0; k < 2; ++k) \
        acc[ai][bj][m][n] = __builtin_amdgcn_mfma_f32_16x16x32_bf16(Bt[n][k], At[m][k], acc[ai][bj][m][n], 0, 0, 0); __builtin_amdgcn_s_setprio(0); } while (0)
#define PG8_WAIT_V(n) asm volatile("s_waitcnt vmcnt(" #n ")" ::: "memory")
#define PG8_WAIT_L(n) asm volatile("s_waitcnt lgkmcnt(" #n ")" ::: "memory")
#define PG8_BAR __builtin_amdgcn_s_barrier()
#define PG8_SCHED __builtin_amdgcn_sched_barrier(0)
    Unit cur, nxt; int ui = 0;
    if (!S.next(0, cur)) return;
    f32x4 acc[2][2][4][2];
#pragma unroll
    for (int a = 0; a < 2; ++a)
#pragma unroll
        for (int b = 0; b < 2; ++b)
#pragma unroll
            for (int m = 0; m < 4; ++m)
#pragma unroll
                for (int n = 0; n < 2; ++n) acc[a][b][m][n] = (f32x4){0.f, 0.f, 0.f, 0.f};
    bf16x8 At[4][2], B0[2][2], B1[2][2];
    const char* cA = (const char*)g.A + (size_t)cur.pm * tstep + cur.koff; const char* cB = (const char*)g.Bt + (size_t)cur.pn * tstep + cur.koff;
    int ntc = cur.nkt ? cur.nkt : nt;
    S.a_ready(cur);
    if constexpr (SP2) {
        PG8_STAGE(PG8_SB(0, 0), cB, voffB); PG8_STAGE(PG8_SB(0, 1), cB + hstep, voffB); PG8_STAGE(PG8_SA(0, 0), cA, voffA); PG8_STAGE(PG8_SA(0, 1), cA + hstep, voffA);
        if (wr == 1) PG8_BAR;
        PG8_WAIT_V(2); PG8_BAR;
        PG8_STAGE(PG8_SB(1, 0), cB + kstep, voffB); PG8_STAGE(PG8_SA(1, 0), cA + kstep, voffA); PG8_STAGE(PG8_SB(1, 1), cB + hstep + kstep, voffB);
        PG8_WAIT_V(6); PG8_BAR;
    } else {
        PG8_STAGE(PG8_SB(0, 0), cB, voffB); PG8_STAGE(PG8_SA(0, 0), cA, voffA); PG8_STAGE(PG8_SB(0, 1), cB + hstep, voffB); PG8_STAGE(PG8_SA(0, 1), cA + hstep, voffA);
        if (wr == 1) PG8_BAR;
        PG8_WAIT_V(4); PG8_BAR;
        PG8_STAGE(PG8_SB(1, 0), cB + kstep, voffB); PG8_STAGE(PG8_SA(1, 0), cA + kstep, voffA); PG8_STAGE(PG8_SB(1, 1), cB + hstep + kstep, voffB);
        PG8_WAIT_V(6); PG8_BAR;
    }
    for (;;) {
        const bool has_next = S.next(ui + 1, nxt);
        const char* nA = has_next ? (const char*)g.A + (size_t)nxt.pm * tstep + nxt.koff : cA; const char* nB = has_next ? (const char*)g.Bt + (size_t)nxt.pn * tstep + nxt.koff : cB;
        for (int t = 0; t < ntc; t += 2) {
            const bool last = (t == ntc - 2);
            const char* a1 = cA + (size_t)(t + 1) * kstep;
            const char* a2 = last ? nA : cA + (size_t)(t + 2) * kstep; const char* b2 = last ? nB : cB + (size_t)(t + 2) * kstep;
            const char* a3 = a2 + kstep; const char* b3 = b2 + kstep;
            if (last && has_next) S.a_ready(nxt);
            if constexpr (SP2) {
            PG8_LDB(B0, 0, 0); PG8_LDB(B1, 0, 1); PG8_SCHED; PG8_LDA(At, 0, 0); PG8_STAGE(PG8_SA(1, 1), a1 + hstep, voffA);
            PG8_WAIT_V(8); PG8_WAIT_L(0); PG8_BAR; PG8_MMA(0, 0, At, B0); PG8_MMA(0, 1, At, B1); PG8_BAR; PG8_SCHED;
            PG8_LDA(At, 0, 1); PG8_STAGE(PG8_SB(0, 0), b2, voffB); PG8_STAGE(PG8_SB(0, 1), b2 + hstep, voffB); PG8_STAGE(PG8_SA(0, 0), a2, voffA);
            PG8_WAIT_V(8); PG8_WAIT_L(0); PG8_BAR; PG8_MMA(1, 0, At, B0); PG8_MMA(1, 1, At, B1); PG8_BAR; PG8_SCHED;
            PG8_LDB(B0, 1, 0); PG8_LDB(B1, 1, 1); PG8_SCHED; PG8_LDA(At, 1, 0); PG8_STAGE(PG8_SA(0, 1), a2 + hstep, voffA);
            PG8_WAIT_V(8); PG8_WAIT_L(0); PG8_BAR; PG8_MMA(0, 0, At, B0); PG8_MMA(0, 1, At, B1); PG8_BAR; PG8_SCHED;
            PG8_LDA(At, 1, 1); PG8_STAGE(PG8_SB(1, 0), b3, voffB); PG8_STAGE(PG8_SB(1, 1), b3 + hstep, voffB); PG8_STAGE(PG8_SA(1, 0), a3, voffA);
            PG8_WAIT_V(8); PG8_WAIT_L(0); PG8_BAR; PG8_MMA(1, 0, At, B0); PG8_MMA(1, 1, At, B1); PG8_BAR; PG8_SCHED;
            } else {
            PG8_LDB(B0, 0, 0); PG8_SCHED; PG8_LDA(At, 0, 0); PG8_STAGE(PG8_SA(1, 1), a1 + hstep, voffA);
            PG8_WAIT_L(8); PG8_BAR; PG8_WAIT_L(0); PG8_MMA(0, 0, At, B0); PG8_BAR; PG8_SCHED;
            PG8_LDB(B1, 0, 1); PG8_STAGE(PG8_SB(0, 0), b2, voffB);
            PG8_BAR; PG8_WAIT_L(0); PG8_MMA(0, 1, At, B1); PG8_BAR;
            PG8_LDA(At, 0, 1); PG8_STAGE(PG8_SA(0, 0), a2, voffA);
            PG8_BAR; PG8_WAIT_L(0); PG8_MMA(1, 0, At, B0); PG8_BAR; PG8_SCHED;
            PG8_STAGE(PG8_SB(0, 1), b2 + hstep, voffB);
            PG8_WAIT_V(6); PG8_BAR; PG8_MMA(1, 1, At, B1); PG8_BAR;
            PG8_LDB(B0, 1, 0); PG8_SCHED; PG8_LDA(At, 1, 0); PG8_STAGE(PG8_SA(0, 1), a2 + hstep, voffA);
            PG8_WAIT_L(8); PG8_BAR; PG8_WAIT_L(0); PG8_MMA(0, 0, At, B0); PG8_BAR; PG8_SCHED;
            PG8_LDB(B1, 1, 1); PG8_STAGE(PG8_SB(1, 0), b3, voffB);
            PG8_BAR; PG8_WAIT_L(0); PG8_MMA(0, 1, At, B1); PG8_BAR;
            PG8_LDA(At, 1, 1); PG8_STAGE(PG8_SA(1, 0), a3, voffA);
            PG8_BAR; PG8_WAIT_L(0); PG8_MMA(1, 0, At, B0); PG8_BAR; PG8_SCHED;
            PG8_STAGE(PG8_SB(1, 1), b3 + hstep, voffB);
            PG8_WAIT_V(6); PG8_BAR; PG8_MMA(1, 1, At, B1); PG8_BAR;
            }
        }
        if constexpr (ALIGN_EPI) { if (wr == 0) PG8_BAR; }
        if constexpr (!Epi::AFTER_DRAIN) { E(acc, cur, wr, wc, fr, fq); S.done(cur); }
        if (!has_next) break;
#pragma unroll
        for (int a = 0; a < 2; ++a)
#pragma unroll
            for (int b = 0; b < 2; ++b)
#pragma unroll
                for (int m = 0; m < 4; ++m)
#pragma unroll
                    for (int n = 0; n < 2; ++n) acc[a][b][m][n] = (f32x4){0.f, 0.f, 0.f, 0.f};
        cur = nxt; cA = nA; cB = nB; ++ui; ntc = cur.nkt ? cur.nkt : nt;
        if constexpr (ALIGN_EPI) { if (wr == 1) PG8_BAR; }
    }
    PG8_WAIT_V(0);
    if constexpr (!ALIGN_EPI) { if (wr == 0) PG8_BAR; }
    PG8_BAR;
    if constexpr (Epi::AFTER_DRAIN) { E.fused(acc, cur, wr, wc, fr, fq, lds, wid, lane); S.done(cur); }
#undef PG8_SA
#undef PG8_SB
#undef PG8_STAGE
#undef PG8_LDA
#undef PG8_LDB
#undef PG8_MMA
#undef PG8_WAIT_V
#undef PG8_WAIT_L
#undef PG8_BAR
#undef PG8_SCHED
}
}
struct Params { const float* in[29]; float* out; unsigned char* ws; int ph_lo, ph_hi; };
enum { I_X = 0, I_C, I_CTX, I_CCTX, I_MODW, I_MODB, I_LNG, I_LNB, I_WA_IN, I_WA_OUT, I_WA_SINK, I_RT_IN, I_RT_OUT, I_RT_LD, I_NA_IN, I_NA_OUT, I_NA_RPB,
       I_S5_IN, I_S5_ARE, I_S5_AIM, I_S5_LDT, I_S5_BRE, I_S5_BIM, I_S5_CRE, I_S5_CIM, I_S5_D, I_S5_GLU, I_S5_BGLU, I_S5_OUT };

__device__ __forceinline__ int dst_col(int pmode, int n) {
    if (pmode == 1) {
        if (n < 1024 || (n >= 2048 && n < 6144)) { const int c = n & 127, hlf = c & 64, d = c & 63; return (n - c) + hlf + ((d < 32) ? 2 * d : 2 * (d - 32) + 1); }
        return n;
    }
    if (pmode == 2) {
        if (n < 4096 || (n >= 12288 && n < 16384)) { const int c = n & 255; return (n - c) + ((c < 128) ? 2 * c : 2 * (c - 128) + 1); }
        return n;
    }
    return n;
}
__device__ __forceinline__ void cvt_tile(LAS unsigned char* lds, const float* __restrict__ W, bf16_t* __restrict__ Bt, int K, int N, int pmode, int tile) {
    const int tid = threadIdx.x;
    const int ntn = N / 256, tk = tile / ntn, tn = tile % ntn, k0 = tk * 64, n0 = tn * 256;
    LAS float* T = (LAS float*)lds;
    { const int n4 = tid & 63, ks = tid >> 6;
      const int d0 = dst_col(pmode, n0 + 4 * n4) - n0, d1 = dst_col(pmode, n0 + 4 * n4 + 1) - n0, d2 = dst_col(pmode, n0 + 4 * n4 + 2) - n0, d3 = dst_col(pmode, n0 + 4 * n4 + 3) - n0;
      f32x4 v[8];
#pragma unroll
      for (int i = 0; i < 8; ++i) v[i] = *(const f32x4*)(W + (size_t)(k0 + ks + 8 * i) * N + n0 + 4 * n4);
#pragma unroll
      for (int i = 0; i < 8; ++i) { LAS float* r = T + (ks + 8 * i) * 257; r[d0] = v[i][0]; r[d1] = v[i][1]; r[d2] = v[i][2]; r[d3] = v[i][3]; } }
    __syncthreads();
    { const int nr = tid >> 1, kh = (tid & 1) * 32;
      float v[32];
#pragma unroll
      for (int j = 0; j < 32; ++j) v[j] = T[(kh + j) * 257 + nr];
      bf16_t* dp = Bt + (size_t)(n0 + nr) * K + k0 + kh;
#pragma unroll
      for (int q = 0; q < 4; ++q) { u32x4 w; w.x = cvt_pk_bf16(v[8 * q], v[8 * q + 1]); w.y = cvt_pk_bf16(v[8 * q + 2], v[8 * q + 3]); w.z = cvt_pk_bf16(v[8 * q + 4], v[8 * q + 5]); w.w = cvt_pk_bf16(v[8 * q + 6], v[8 * q + 7]);
          *(u32x4*)(dp + 8 * q) = w; } }
    __syncthreads();
}
__device__ __forceinline__ void mod_unit(LAS unsigned char* lds, const Params& p, int unit) {
    const int tid = threadIdx.x, i = unit / 192, cb = unit % 192;
    LAS float* S0 = (LAS float*)lds; LAS float* S1 = S0 + 4096; LAS float* PT = S1 + 4096;
    for (int k = tid; k < 4096; k += NTHREADS) { S0[k] = silu_f(p.in[I_C][k]); S1[k] = silu_f(p.in[I_CCTX][k]); }
    __syncthreads();
    const int cg = tid & 15, kl = tid >> 4;
    const float* Wp = p.in[I_MODW] + (size_t)i * 4096 * 12288 + cb * 64 + cg * 4;
    f32x4 a0 = {0.f, 0.f, 0.f, 0.f}, a1 = {0.f, 0.f, 0.f, 0.f};
    for (int kk = 0; kk < 128; kk += 8) {
        f32x4 w[8];
#pragma unroll
        for (int j = 0; j < 8; ++j) w[j] = *(const f32x4*)(Wp + (size_t)(kl + 32 * (kk + j)) * 12288);
#pragma unroll
        for (int j = 0; j < 8; ++j) { const int k = kl + 32 * (kk + j); a0 += w[j] * S0[k]; a1 += w[j] * S1[k]; }
    }
#pragma unroll
    for (int j = 0; j < 4; ++j) { PT[kl * 128 + cg * 4 + j] = a0[j]; PT[kl * 128 + 64 + cg * 4 + j] = a1[j]; }
    __syncthreads();
    if (tid < 128) {
        float s = 0.f;
        for (int k = 0; k < 32; ++k) s += PT[k * 128 + tid];
        const int v = tid >> 6, col = cb * 64 + (tid & 63);
        ((float*)(p.ws + WS_MOD))[(size_t)(i * 2 + v) * 12288 + col] = s + p.in[I_MODB][(size_t)i * 12288 + col];
    }
    __syncthreads();
}
__device__ __forceinline__ void rope_unit(const Params& p, int unit) {
    const int e = unit * 4096 + threadIdx.x * 8;
    if (unit < 512) {
        float* T = (float*)(p.ws + WS_ROPEB);
#pragma unroll
        for (int q = 0; q < 8; ++q) { const int idx = e + q, t = idx >> 7, j = idx & 127;
            const double ang = (double)t * exp(-(double)j * (9.210340371976184 / 128.0)); double s, c; sincos(ang, &s, &c);
            T[(size_t)idx * 2] = (float)c; T[(size_t)idx * 2 + 1] = (float)s; }
    } else {
        float* T = (float*)(p.ws + WS_ROPEA);
#pragma unroll
        for (int q = 0; q < 8; ++q) { const int idx = (unit - 512) * 4096 + threadIdx.x * 8 + q;
            if (idx < 320 * 32) { const int i = idx >> 5, j = idx & 31; const int pos = (i < 256) ? i : i - 256;
                const double ang = (double)pos * exp(-(double)j * (9.210340371976184 / 32.0)); double s, c; sincos(ang, &s, &c);
                T[(size_t)idx * 2] = (float)c; T[(size_t)idx * 2 + 1] = (float)s; } }
    }
}
constexpr int CVT_T0 = 0, CVT_T1 = CVT_T0 + 64 * 40, CVT_T2 = CVT_T1 + 64 * 16, CVT_T3 = CVT_T2 + 128 * 16;
constexpr int P0_MOD0 = 0, P0_CVT0 = 768, P0_ROPE0 = P0_CVT0 + CVT_T3, P0_END = P0_ROPE0 + 515;
__device__ __forceinline__ void p0_prologue(LAS unsigned char* lds, const Params& p) {
    bf16_t* Wb = (bf16_t*)(p.ws + WS_W);
    for (int u = blockIdx.x; u < P0_END; u += gridDim.x) {
        if (u < P0_CVT0) mod_unit(lds, p, u);
        else if (u < P0_ROPE0) {
            const int t = u - P0_CVT0;
            if      (t < CVT_T1) cvt_tile(lds, p.in[I_WA_IN],  Wb + W_WA_IN,  4096, 10240, 1, t - CVT_T0);
            else if (t < CVT_T2) cvt_tile(lds, p.in[I_WA_OUT], Wb + W_WA_OUT, 4096, 4096,  0, t - CVT_T1);
            else                 cvt_tile(lds, p.in[I_RT_OUT], Wb + W_RT_OUT, 8192, 4096,  0, t - CVT_T2);
        } else rope_unit(p, u - P0_ROPE0);
    }
}
#define CVT_DESC(t_, SRC, DST, NN, PM, N0) do { const float* W_; size_t wo_; int tile_; \
    if (which == 0) { W_ = wp0; wo_ = W_RT_IN; NN = 24576; PM = 2; tile_ = (t_); } \
    else if (which == 1) { const bool a_ = (t_) < 64 * 64; W_ = a_ ? wp0 : wp1; wo_ = a_ ? W_NA_IN : W_NA_OUT; NN = a_ ? 16384 : 4096; PM = 0; tile_ = a_ ? (t_) : (t_) - 64 * 64; } \
    else { const bool a_ = (t_) < 64 * 32, b_ = (t_) < 64 * 32 + 64 * 16; W_ = a_ ? wp0 : b_ ? wp1 : wp2; wo_ = a_ ? W_S5_IN : b_ ? W_S5_GLU : W_S5_OUT; \
        NN = a_ ? 8192 : 4096; PM = 0; tile_ = a_ ? (t_) : b_ ? (t_) - 64 * 32 : (t_) - 64 * 32 - 64 * 16; } \
    const int ntn_ = NN >> 8, tk_ = tile_ / ntn_, tn_ = tile_ - tk_ * ntn_; \
    SRC = W_ + (size_t)(tk_ * 64) * NN + tn_ * 256; DST = Wb + wo_ + (size_t)(tn_ * 256) * 4096 + tk_ * 64; N0 = tn_ * 256; } while (0)
#define CVT_TAKE(dst_) do { int r_ = -1; \
    if (!(early && __hip_atomic_load(ctr, __ATOMIC_RELAXED, __HIP_MEMORY_SCOPE_AGENT) >= limit)) { \
        const unsigned t_ = __hip_atomic_fetch_add(ctr, 1u, __ATOMIC_RELAXED, __HIP_MEMORY_SCOPE_AGENT); if (t_ < (unsigned)ntile) r_ = (int)t_; } \
    dst_ = r_; } while (0)
__device__ __forceinline__ void cvt_tail(LAS unsigned char* lds, const Params& p, int which, bool early = false) {
    bf16_t* Wb = (bf16_t*)(p.ws + WS_W);
    unsigned* ctr = (unsigned*)(p.ws + WS_CTL + 16384 + 9 * 2048 + which * 256);
    volatile LAS int* slot = (volatile LAS int*)(lds + 131072 + 64);
    const int ntile = (which == 0) ? 64 * 96 : (which == 1) ? 64 * 64 + 64 * 16 : 64 * 32 + 2 * 64 * 16;
    const unsigned limit = early ? (unsigned)(ntile - ntile / 6) : 0xffffffffu;
    const int tid = threadIdx.x, n4 = tid & 63, ks = tid >> 6, nr = tid >> 1, kh = (tid & 1) * 32;
    LAS float* T = (LAS float*)lds;
    const float* wp0 = (which == 0) ? p.in[I_RT_IN] : (which == 1) ? p.in[I_NA_IN] : p.in[I_S5_IN];
    const float* wp1 = (which == 1) ? p.in[I_NA_OUT] : p.in[I_S5_GLU];
    const float* wp2 = p.in[I_S5_OUT];
    asm volatile("" : "+s"(wp0), "+s"(wp1), "+s"(wp2));
    __syncthreads();
    if (tid == 0) CVT_TAKE(slot[0]);
    __syncthreads();
    int t = __builtin_amdgcn_readfirstlane(slot[0]);
    if (t < 0) return;
    const float* src; bf16_t* dst; int N, pmode, n0;
    CVT_DESC(t, src, dst, N, pmode, n0);
    f32x4 v[8];
#pragma unroll
    for (int i = 0; i < 8; ++i) v[i] = *(const f32x4*)(src + (size_t)(ks + 8 * i) * N + 4 * n4);
    for (;;) {
        if (tid == 0) CVT_TAKE(slot[1]);
        { const int d0 = dst_col(pmode, n0 + 4 * n4) - n0, d1 = dst_col(pmode, n0 + 4 * n4 + 1) - n0, d2 = dst_col(pmode, n0 + 4 * n4 + 2) - n0, d3 = dst_col(pmode, n0 + 4 * n4 + 3) - n0;
#pragma unroll
          for (int i = 0; i < 8; ++i) { LAS float* r = T + (ks + 8 * i) * 257; r[d0] = v[i][0]; r[d1] = v[i][1]; r[d2] = v[i][2]; r[d3] = v[i][3]; } }
        __syncthreads();
        const int tn = __builtin_amdgcn_readfirstlane(slot[1]);
        bf16_t* dcur = dst;
        if (tn >= 0) {
            CVT_DESC(tn, src, dst, N, pmode, n0);
#pragma unroll
            for (int i = 0; i < 8; ++i) v[i] = *(const f32x4*)(src + (size_t)(ks + 8 * i) * N + 4 * n4);
        }
        { float w_[32];
#pragma unroll
          for (int j = 0; j < 32; ++j) w_[j] = T[(kh + j) * 257 + nr];
          bf16_t* dp = dcur + (size_t)nr * 4096 + kh;
#pragma unroll
          for (int q = 0; q < 4; ++q) { u32x4 w; w.x = cvt_pk_bf16(w_[8 * q], w_[8 * q + 1]); w.y = cvt_pk_bf16(w_[8 * q + 2], w_[8 * q + 3]); w.z = cvt_pk_bf16(w_[8 * q + 4], w_[8 * q + 5]); w.w = cvt_pk_bf16(w_[8 * q + 6], w_[8 * q + 7]);
              *(u32x4*)(dp + 8 * q) = w; } }
        __syncthreads();
        if (tn < 0) break;
    }
}
#undef CVT_DESC
#undef CVT_TAKE

__device__ __forceinline__ void p1_modulate(LAS unsigned char* lds, const Params& p) {
    const float* mod = (const float*)(p.ws + WS_MOD);
    bf16_t* H = (bf16_t*)(p.ws + WS_H);
    LAS float* Lm = (LAS float*)lds;
    __syncthreads();
    for (int k = threadIdx.x; k < 2048; k += NTHREADS) { *(LAS f32x4*)(Lm + 4 * k) = *(const f32x4*)(mod + 4 * k); *(LAS f32x4*)(Lm + 8192 + 4 * k) = *(const f32x4*)(mod + 12288 + 4 * k); }
    __syncthreads();
    const size_t nchunk = (size_t)MROWS * (DM / 8), stride = (size_t)gridDim.x * NTHREADS;
    for (size_t ch0 = (size_t)blockIdx.x * NTHREADS + threadIdx.x; ch0 < nchunk; ch0 += 4 * stride) {
        f32x4 x0[4], x1[4];
#pragma unroll
        for (int j = 0; j < 4; ++j) { const size_t ch = ch0 + j * stride; if (ch < nchunk) { const int row = (int)(ch >> 9), col = (int)(ch & 511) * 8;
            const float* src = (row >= SEQ) ? p.in[I_CTX] + (size_t)(row - SEQ) * DM + col : p.in[I_X] + (size_t)row * DM + col; x0[j] = *(const f32x4*)src; x1[j] = *(const f32x4*)(src + 4); } }
#pragma unroll
        for (int j = 0; j < 4; ++j) { const size_t ch = ch0 + j * stride; if (ch < nchunk) { const int row = (int)(ch >> 9), col = (int)(ch & 511) * 8;
            LAS float* md = Lm + ((row >= SEQ) ? 8192 : 0);
            const f32x4 sh0 = *(const LAS f32x4*)(md + col), sh1 = *(const LAS f32x4*)(md + col + 4), sc0 = *(const LAS f32x4*)(md + 4096 + col), sc1 = *(const LAS f32x4*)(md + 4096 + col + 4);
            const f32x4 h0 = x0[j] * (sc0 + 1.0f) + sh0, h1 = x1[j] * (sc1 + 1.0f) + sh1;
            u32x4 w; w.x = cvt_pk_bf16(h0[0], h0[1]); w.y = cvt_pk_bf16(h0[2], h0[3]); w.z = cvt_pk_bf16(h1[0], h1[1]); w.w = cvt_pk_bf16(h1[2], h1[3]);
            *(u32x4*)(H + (size_t)row * DM + col) = w; } }
    }
}

typedef _Float16 f16v2_t __attribute__((ext_vector_type(2)));
__device__ __forceinline__ unsigned pk_f16(float lo, float hi) { f16v2_t v; v[0] = (_Float16)lo; v[1] = (_Float16)hi; return __builtin_bit_cast(unsigned, v); }
__device__ __forceinline__ float f16_lo(unsigned w) { return (float)__builtin_bit_cast(_Float16, (unsigned short)(w & 0xffffu)); }
__device__ __forceinline__ float f16_hi(unsigned w) { return (float)__builtin_bit_cast(_Float16, (unsigned short)(w >> 16)); }
__device__ __forceinline__ f32x4 unpk_f16x4(u32x2 w) { f32x4 r; r[0] = f16_lo(w.x); r[1] = f16_hi(w.x); r[2] = f16_lo(w.y); r[3] = f16_hi(w.y); return r; }
__device__ __forceinline__ void ln_phase(LAS unsigned char* lds, const Params& p, int layer, int nrows, float* Xout, bool write_h, bool ctx_slabs) {
    const int wid = threadIdx.x >> 6, lane = threadIdx.x & 63;
    unsigned short* Xh = (unsigned short*)(p.ws + WS_X);
    const float* g = p.in[I_LNG] + (size_t)layer * DM; const float* b = p.in[I_LNB] + (size_t)layer * DM;
    const float* modc = (const float*)(p.ws + WS_MOD) + (size_t)layer * 2 * 12288;
    const float* modn = (const float*)(p.ws + WS_MOD) + (size_t)(layer + 1) * 2 * 12288;
    bf16_t* H = (bf16_t*)(p.ws + WS_H);
    const int nrows_w = ctx_slabs ? SEQ : nrows;
    LAS float* Lv = (LAS float*)lds;
    __syncthreads();
    for (int k = threadIdx.x; k < 1024; k += NTHREADS) {
        *(LAS f32x4*)(Lv + 4 * k) = *(const f32x4*)(modc + 8192 + 4 * k); *(LAS f32x4*)(Lv + 4096 + 4 * k) = *(const f32x4*)(g + 4 * k); *(LAS f32x4*)(Lv + 8192 + 4 * k) = *(const f32x4*)(b + 4 * k);
        if (write_h) { *(LAS f32x4*)(Lv + 12288 + 4 * k) = *(const f32x4*)(modn + 4 * k); *(LAS f32x4*)(Lv + 16384 + 4 * k) = *(const f32x4*)(modn + 4096 + 4 * k); } }
    __syncthreads();
    for (int row = blockIdx.x * 8 + wid; row < nrows_w; row += gridDim.x * 8) {
        const bool ctx = row >= SEQ;
        const float* xr = ctx ? p.in[I_CTX] + (size_t)(row - SEQ) * DM : p.in[I_X] + (size_t)row * DM;
        const float* gate = modc + (ctx ? 12288 : 0) + 8192;
        const float* gr = g; const float* br = b; const float* md = modn + (ctx ? 12288 : 0);
        int lane4 = lane * 4; asm volatile("" : "+v"(lane4));
        f32x4 v[16]; u32x2 yv[16];
        if (layer == 0) {
#pragma unroll
            for (int i = 0; i < 16; ++i) { v[i] = *(const f32x4*)(xr + i * 256 + lane * 4); yv[i] = *(const u32x2*)(H + (size_t)row * DM + i * 256 + lane * 4); }
        } else {
            u32x2 xh[16];
#pragma unroll
            for (int i = 0; i < 16; ++i) { xh[i] = *(const u32x2*)(Xh + (size_t)row * DM + i * 256 + lane * 4); yv[i] = *(const u32x2*)(H + (size_t)row * DM + i * 256 + lane * 4); }
#pragma unroll
            for (int i = 0; i < 16; ++i) v[i] = unpk_f16x4(xh[i]);
        }
        float s = 0.f;
#pragma unroll
        for (int i = 0; i < 16; ++i) { const f32x4 gt = *(const LAS f32x4*)(Lv + i * 256 + lane4);
            v[i][0] = v[i][0] * DN_ALPHA + gt[0] * bf_lo(yv[i].x); v[i][1] = v[i][1] * DN_ALPHA + gt[1] * bf_hi(yv[i].x);
            v[i][2] = v[i][2] * DN_ALPHA + gt[2] * bf_lo(yv[i].y); v[i][3] = v[i][3] * DN_ALPHA + gt[3] * bf_hi(yv[i].y);
            s += (v[i][0] + v[i][1]) + (v[i][2] + v[i][3]); }
#pragma unroll
        for (int o = 32; o >= 1; o >>= 1) s += __shfl_xor(s, o);
        const float mean = s * (1.0f / DM);
        float q = 0.f;
#pragma unroll
        for (int i = 0; i < 16; ++i) { const f32x4 d = v[i] - mean; q += (d[0] * d[0] + d[1] * d[1]) + (d[2] * d[2] + d[3] * d[3]); }
#pragma unroll
        for (int o = 32; o >= 1; o >>= 1) q += __shfl_xor(q, o);
        const float rstd = 1.0f / sqrtf(q * (1.0f / DM) + LN_EPS);
        float* xo = Xout + (size_t)row * DM;
#pragma unroll
        for (int i = 0; i < 16; ++i) {
            const int col = i * 256 + lane4;
            const f32x4 gv = *(const LAS f32x4*)(Lv + 4096 + col), bv = *(const LAS f32x4*)(Lv + 8192 + col);
            const f32x4 y = (v[i] - mean) * rstd * gv + bv;
            if (write_h) { u32x2 xw; xw.x = pk_f16(y[0], y[1]); xw.y = pk_f16(y[2], y[3]); *(u32x2*)(Xh + (size_t)row * DM + col) = xw; } else *(f32x4*)(xo + col) = y;
            if (write_h) {
                const f32x4 sh = *(const LAS f32x4*)(Lv + 12288 + col), sc = *(const LAS f32x4*)(Lv + 16384 + col);
                const f32x4 h = y * (sc + 1.0f) + sh;
                u32x2 w; w.x = cvt_pk_bf16(h[0], h[1]); w.y = cvt_pk_bf16(h[2], h[3]);
                *(u32x2*)(H + (size_t)row * DM + col) = w;
            }
        }
    }
    if (ctx_slabs) {
        LAS float* red = (LAS float*)(lds + 90112);
        for (int cr = blockIdx.x; cr < NCTX; cr += gridDim.x) {
            const int row = SEQ + cr;
            const float* gate = modc + 12288 + 8192; const float* md = modn + 12288;
            const float* ys = (const float*)(p.ws + WS_YS) + (size_t)cr * DM;
            f32x4 t[2]; float s = 0.f;
#pragma unroll
            for (int j = 0; j < 2; ++j) { const int col = wid * 512 + j * 256 + lane * 4;
                f32x4 yk[16];
#pragma unroll
                for (int ks = 0; ks < 16; ++ks) yk[ks] = *(const f32x4*)(ys + (size_t)ks * 256 * DM + col);
                const f32x4 y = ((yk[0] + yk[1]) + (yk[2] + yk[3])) + ((yk[4] + yk[5]) + (yk[6] + yk[7])) + (((yk[8] + yk[9]) + (yk[10] + yk[11])) + ((yk[12] + yk[13]) + (yk[14] + yk[15])));
                const f32x4 xv = (layer == 0) ? *(const f32x4*)(p.in[I_CTX] + (size_t)cr * DM + col) : unpk_f16x4(*(const u32x2*)(Xh + (size_t)row * DM + col));
                t[j] = xv * DN_ALPHA + *(const f32x4*)(gate + col) * y;
                s += (t[j][0] + t[j][1]) + (t[j][2] + t[j][3]); }
#pragma unroll
            for (int o = 32; o >= 1; o >>= 1) s += __shfl_xor(s, o);
            __syncthreads();
            if (lane == 0) red[wid] = s;
            __syncthreads();
            float tot = 0.f;
#pragma unroll
            for (int w = 0; w < 8; ++w) tot += red[w];
            const float mean = tot * (1.0f / DM);
            float q = 0.f;
#pragma unroll
            for (int j = 0; j < 2; ++j) { const f32x4 d = t[j] - mean; q += (d[0] * d[0] + d[1] * d[1]) + (d[2] * d[2] + d[3] * d[3]); }
#pragma unroll
            for (int o = 32; o >= 1; o >>= 1) q += __shfl_xor(q, o);
            if (lane == 0) red[8 + wid] = q;
            __syncthreads();
            float qt = 0.f;
#pragma unroll
            for (int w = 0; w < 8; ++w) qt += red[8 + w];
            const float rstd = 1.0f / sqrtf(qt * (1.0f / DM) + LN_EPS);
#pragma unroll
            for (int j = 0; j < 2; ++j) { const int col = wid * 512 + j * 256 + lane * 4;
                const f32x4 y = (t[j] - mean) * rstd * *(const f32x4*)(g + col) + *(const f32x4*)(b + col);
                if (write_h) { u32x2 xw; xw.x = pk_f16(y[0], y[1]); xw.y = pk_f16(y[2], y[3]); *(u32x2*)(Xh + (size_t)row * DM + col) = xw; } else *(f32x4*)(Xout + (size_t)row * DM + col) = y;
                if (write_h) { const f32x4 h = y * (*(const f32x4*)(md + 4096 + col) + 1.0f) + *(const f32x4*)(md + col);
                    u32x2 w; w.x = cvt_pk_bf16(h[0], h[1]); w.y = cvt_pk_bf16(h[2], h[3]); *(u32x2*)(H + (size_t)row * DM + col) = w; } }
        }
    }
}

namespace att {
#define KSWZ(row, colB) ((row) * 256 + ((colB) ^ ((((row) & 7) | ((((row) >> 4) & 1) << 3)) << 4)))
__device__ __forceinline__ int crow(int r, int hi) { return (r & 3) + 8 * (r >> 2) + 4 * hi; }
__device__ __forceinline__ void qkt(f32x16& p0, f32x16& p1, const bf16_t* Ks, const bf16x8* qr, int r32, int hi) {
  p0 = f32x16{}; p1 = f32x16{};
#pragma unroll
  for (int d0 = 0; d0 < 8; ++d0) { const int cb = (d0 * 16 + hi * 8) * 2;
    const bf16x8 b0 = *reinterpret_cast<const bf16x8*>((const char*)Ks + KSWZ(r32, cb));
    const bf16x8 b1 = *reinterpret_cast<const bf16x8*>((const char*)Ks + KSWZ(32 + r32, cb));
    p0 = __builtin_amdgcn_mfma_f32_32x32x16_bf16(b0, qr[d0], p0, 0, 0, 0);
    p1 = __builtin_amdgcn_mfma_f32_32x32x16_bf16(b1, qr[d0], p1, 0, 0, 0); }
}
__device__ __forceinline__ int v_st(int k, int c) { const int kk = (k & ~0xC) | ((k & 4) << 1) | ((k & 8) >> 1); return ((kk >> 3) * 4 + (c >> 5)) * 512 + ((kk & 7) * 32 + (c & 31)) * 2; }
__device__ __forceinline__ int v_rd_base(int lane) { return ((lane & 3) << 3) | (((lane >> 2) & 3) << 6) | (((lane >> 4) & 1) << 5) | (((lane >> 5) & 1) << 8); }
constexpr int v_rd_off(int d0, int ks, int half) { return d0 * 512 + ks * 4096 + half * 2048; }
template <int OFF> __device__ __forceinline__ s16x4 tr_read(int vb) {
  s16x4 r; asm volatile("ds_read_b64_tr_b16 %0, %1 offset:%2" : "=&v"(r) : "v"(vb), "i"(OFF) : "memory"); return r;
}
#define PK(L, H) (bf16x8){L[0], L[1], L[2], L[3], H[0], H[1], H[2], H[3]}
template <int D0> __device__ __forceinline__ void pv_reads(int vb, s16x4 (&f)[8], bool k0, bool k3) {
  if (k0) { f[0] = tr_read<v_rd_off(D0, 0, 0)>(vb); f[1] = tr_read<v_rd_off(D0, 0, 1)>(vb); }
  f[2] = tr_read<v_rd_off(D0, 1, 0)>(vb); f[3] = tr_read<v_rd_off(D0, 1, 1)>(vb); f[4] = tr_read<v_rd_off(D0, 2, 0)>(vb); f[5] = tr_read<v_rd_off(D0, 2, 1)>(vb);
  if (k3) { f[6] = tr_read<v_rd_off(D0, 3, 0)>(vb); f[7] = tr_read<v_rd_off(D0, 3, 1)>(vb); }
}
__device__ __forceinline__ void pv_mma(f32x16& od, const s16x4 (&f)[8], bf16x8 pa0, bf16x8 pa1, bf16x8 pa2, bf16x8 pa3, bool k0, bool k3) {
  if (k0) od = __builtin_amdgcn_mfma_f32_32x32x16_bf16(pa0, PK(f[0], f[1]), od, 0, 0, 0);
  od = __builtin_amdgcn_mfma_f32_32x32x16_bf16(pa1, PK(f[2], f[3]), od, 0, 0, 0);
  od = __builtin_amdgcn_mfma_f32_32x32x16_bf16(pa2, PK(f[4], f[5]), od, 0, 0, 0);
  if (k3) od = __builtin_amdgcn_mfma_f32_32x32x16_bf16(pa3, PK(f[6], f[7]), od, 0, 0, 0);
}
#define PV_WAIT1(k0_, k3_) do { if ((k0_) && (k3_)) asm volatile("s_waitcnt lgkmcnt(8)" ::: "memory"); else asm volatile("s_waitcnt lgkmcnt(6)" ::: "memory"); __builtin_amdgcn_sched_barrier(0); } while (0)
__device__ __forceinline__ void pv_all(f32x16 (&o)[4], int vb, bf16x8 pa0, bf16x8 pa1, bf16x8 pa2, bf16x8 pa3, bool k0, bool k3) {
  s16x4 fa[8] = {}, fb[8] = {};
  pv_reads<0>(vb, fa, k0, k3); pv_reads<1>(vb, fb, k0, k3);
  PV_WAIT1(k0, k3); pv_mma(o[0], fa, pa0, pa1, pa2, pa3, k0, k3);
  pv_reads<2>(vb, fa, k0, k3);
  PV_WAIT1(k0, k3); pv_mma(o[1], fb, pa0, pa1, pa2, pa3, k0, k3);
  pv_reads<3>(vb, fb, k0, k3);
  PV_WAIT1(k0, k3); pv_mma(o[2], fa, pa0, pa1, pa2, pa3, k0, k3);
  asm volatile("s_waitcnt lgkmcnt(0)" ::: "memory"); __builtin_amdgcn_sched_barrier(0);
  pv_mma(o[3], fb, pa0, pa1, pa2, pa3, k0, k3);
}
#undef PV_WAIT1
#undef PK

template <int MODE>
__device__ __forceinline__ void attn_unit(unsigned char* lds, const bf16_t* __restrict__ P,
                                          int qrow_w, int qcol, int kcol, int vcol, int n_local, int local_row0,
                                          int qtok0, int wrow, int wcol0, int a_lo, float sink, const float* rpbs,
                                          bf16_t* __restrict__ G, int gcol, int szcol) {
  constexpr int ldp = (MODE == 0) ? WA_INW : NA_INW, ldg = DM;
  const int tid = threadIdx.x, wid = tid >> 6, lane = tid & 63, r32 = lane & 31, hi = lane >> 5;
  bf16_t* V_lds = (bf16_t*)lds;
  float* wsx = (float*)(lds + 65536) + wid * 64; float* li_l = wsx; float* al_l = wsx + 32;
  float m_reg = -1e30f, l_reg = 0.f; f32x16 o[4] = {}; bf16x8 qr[8];
  const bf16_t* Qw = P + (size_t)(qrow_w + r32) * ldp + qcol + hi * 8;
#pragma unroll
  for (int d0 = 0; d0 < 8; ++d0) qr[d0] = *reinterpret_cast<const bf16x8*>(Qw + d0 * 16);
  const int sr = tid >> 4, sc = (tid & 15) * 8, vst0 = v_st(sr, sc), vst1 = v_st(32 + sr, sc);
  const int vb0 = (int)(uintptr_t)V_lds + v_rd_base(lane);
  const int nt = 4 + n_local;
  bf16x8 vs0, vs1, ks0, ks1;
#define TROW(i) ((i) < 4 ? SEQ + 64 * (i) : local_row0 + 64 * ((i) - 4))
#define SLOAD(k0) do { const bf16_t* b_ = P + (size_t)((k0) + sr) * ldp + sc; \
    vs0 = *reinterpret_cast<const bf16x8*>(b_ + vcol); vs1 = *reinterpret_cast<const bf16x8*>(b_ + (size_t)32 * ldp + vcol); \
    ks0 = *reinterpret_cast<const bf16x8*>(b_ + kcol); ks1 = *reinterpret_cast<const bf16x8*>(b_ + (size_t)32 * ldp + kcol); } while (0)
#define SWRITE(b) do { char* vb_ = (char*)lds + (b) * 32768; *(bf16x8*)(vb_ + vst0) = vs0; *(bf16x8*)(vb_ + vst1) = vs1; \
    *(bf16x8*)(vb_ + 16384 + KSWZ(sr, sc * 2)) = ks0; *(bf16x8*)(vb_ + 16384 + KSWZ(32 + sr, sc * 2)) = ks1; } while (0)
  __syncthreads();
  SLOAD(TROW(0)); SWRITE(0); SLOAD(TROW(1));
  __syncthreads();
  for (int i = 0; i < nt; ++i) {
    const int cb = i & 1;
    if (i + 1 < nt) SWRITE(cb ^ 1);
    if (i + 2 < nt) SLOAD(TROW(i + 2));
    const bf16_t* K_cur = (const bf16_t*)(lds + cb * 32768 + 16384); const int vb_cur = vb0 + cb * 32768;
    bool active = true; int arow = 0;
    if (MODE == 1 && i >= 4) { arow = a_lo + (i - 4); const int rs = min(max(wrow - 4, 0), 248); active = (arow >= rs) && (arow < rs + 8); }
    if (active) {
      const bool nA = !(MODE == 1 && i >= 4 && wcol0 != 0), nD = !(MODE == 1 && i >= 4 && wcol0 == 0);
      f32x16 p0, p1; qkt(p0, p1, K_cur, qr, r32, hi);
      if (i >= 4) {
        if (MODE == 0) {
          const int dbase = (qtok0 + r32) - (local_row0 + 64 * (i - 4));
          const int tdiff = (qtok0 >> 6) - ((local_row0 >> 6) + (i - 4));
          if (tdiff >= 2 || tdiff <= -2)
#pragma unroll
          for (int r = 0; r < 16; ++r) { const int d0 = dbase - crow(r, hi), d1 = d0 - 32;
            if (d0 > 128 || d0 < -128) p0[r] = -1e30f; if (d1 > 128 || d1 < -128) p1[r] = -1e30f; }
        } else {
          const int c = wcol0 + r32, cs = min(max(c - 8, 0), 48);
          const unsigned baddr = (unsigned)(uintptr_t)rpbs + (unsigned)(((arow - wrow + 7) * 31 + 15 - c + 4 * hi) * 4);
          const int tv = 4 * hi - cs;
#define NB_RD(dst, OFF) asm volatile("ds_read_b32 %0, %1 offset:%2" : "=v"(dst) : "v"(baddr), "i"(OFF) : "memory")
#define NB_HALF(P_, BASEKEY) do { float b0_, b1_, b2_, b3_, b4_, b5_, b6_, b7_, b8_, b9_, b10_, b11_, b12_, b13_, b14_, b15_; \
            NB_RD(b0_, ((BASEKEY) + 0) * 4); NB_RD(b1_, ((BASEKEY) + 1) * 4); NB_RD(b2_, ((BASEKEY) + 2) * 4); NB_RD(b3_, ((BASEKEY) + 3) * 4); \
            NB_RD(b4_, ((BASEKEY) + 8) * 4); NB_RD(b5_, ((BASEKEY) + 9) * 4); NB_RD(b6_, ((BASEKEY) + 10) * 4); NB_RD(b7_, ((BASEKEY) + 11) * 4); \
            NB_RD(b8_, ((BASEKEY) + 16) * 4); NB_RD(b9_, ((BASEKEY) + 17) * 4); NB_RD(b10_, ((BASEKEY) + 18) * 4); NB_RD(b11_, ((BASEKEY) + 19) * 4); \
            NB_RD(b12_, ((BASEKEY) + 24) * 4); NB_RD(b13_, ((BASEKEY) + 25) * 4); NB_RD(b14_, ((BASEKEY) + 26) * 4); NB_RD(b15_, ((BASEKEY) + 27) * 4); \
            asm volatile("s_waitcnt lgkmcnt(0)" ::: "memory"); __builtin_amdgcn_sched_barrier(0); \
            const float bb_[16] = {b0_, b1_, b2_, b3_, b4_, b5_, b6_, b7_, b8_, b9_, b10_, b11_, b12_, b13_, b14_, b15_}; \
            _Pragma("unroll") for (int r = 0; r < 16; ++r) { const int key_ = (BASEKEY) + (r & 3) + 8 * (r >> 2); P_[r] = ((unsigned)(key_ + tv) < 16u) ? P_[r] + bb_[r] : -1e30f; } } while (0)
#define NB_QUAD(P_, R0, KEY0) do { float b0_, b1_, b2_, b3_; \
            NB_RD(b0_, ((KEY0) + 0) * 4); NB_RD(b1_, ((KEY0) + 1) * 4); NB_RD(b2_, ((KEY0) + 2) * 4); NB_RD(b3_, ((KEY0) + 3) * 4); \
            asm volatile("s_waitcnt lgkmcnt(0)" ::: "memory"); __builtin_amdgcn_sched_barrier(0); \
            const float bb_[4] = {b0_, b1_, b2_, b3_}; \
            _Pragma("unroll") for (int r = 0; r < 4; ++r) { const int key_ = (KEY0) + r; P_[(R0) + r] = ((unsigned)(key_ + tv) < 16u) ? P_[(R0) + r] + bb_[r] : -1e30f; } } while (0)
          if (nA) NB_HALF(p0, 0); else NB_QUAD(p0, 12, 24);
          if (nD) NB_HALF(p1, 32); else NB_QUAD(p1, 0, 32);
#undef NB_RD
#undef NB_HALF
#undef NB_QUAD
        }
      }
      float pmax = fmaxf(fmaxf(p0[12], p0[13]), fmaxf(p0[14], p0[15]));
#pragma unroll
      for (int r = 0; r < 4; ++r) pmax = fmaxf(pmax, p1[r]);
      if (nA) {
#pragma unroll
        for (int r = 0; r < 12; ++r) pmax = fmaxf(pmax, p0[r]); }
      if (nD) {
#pragma unroll
        for (int r = 4; r < 16; ++r) pmax = fmaxf(pmax, p1[r]); }
      { auto rr = __builtin_amdgcn_permlane32_swap(__float_as_uint(pmax), __float_as_uint(pmax), false, false);
        pmax = fmaxf(__uint_as_float(rr[0]), __uint_as_float(rr[1])); }
      const bool resc = !__all(pmax - m_reg <= 8.0f);
      float alpha = 1.0f;
      if (resc) { const float mn_ = fmaxf(m_reg, pmax); alpha = __builtin_amdgcn_exp2f((m_reg - mn_) * L2E); m_reg = mn_; }
      const float mnC = -m_reg * L2E;
      float ps = 0.f;
#pragma unroll
      for (int r = 12; r < 16; ++r) { p0[r] = __builtin_amdgcn_exp2f(fmaf(p0[r], L2E, mnC)); p1[r - 12] = __builtin_amdgcn_exp2f(fmaf(p1[r - 12], L2E, mnC)); ps += p0[r] + p1[r - 12]; }
      if (nA) {
#pragma unroll
        for (int r = 0; r < 12; ++r) { p0[r] = __builtin_amdgcn_exp2f(fmaf(p0[r], L2E, mnC)); ps += p0[r]; }
      } else {
#pragma unroll
        for (int r = 8; r < 12; ++r) p0[r] = 0.f; }
      if (nD) {
#pragma unroll
        for (int r = 4; r < 16; ++r) { p1[r] = __builtin_amdgcn_exp2f(fmaf(p1[r], L2E, mnC)); ps += p1[r]; }
      } else {
#pragma unroll
        for (int r = 4; r < 8; ++r) p1[r] = 0.f; }
      { auto rr = __builtin_amdgcn_permlane32_swap(__float_as_uint(ps), __float_as_uint(ps), false, false);
        ps = __uint_as_float(rr[0]) + __uint_as_float(rr[1]); }
      l_reg = l_reg * alpha + ps;
      bf16x8 pa0, pa1, pa2, pa3;
#define PK4(Pv, BASE, OUT) do { unsigned a0 = cvt_pk_bf16(Pv[BASE + 0], Pv[BASE + 1]), a1 = cvt_pk_bf16(Pv[BASE + 2], Pv[BASE + 3]);   \
    unsigned b0 = cvt_pk_bf16(Pv[BASE + 4], Pv[BASE + 5]), b1 = cvt_pk_bf16(Pv[BASE + 6], Pv[BASE + 7]);                              \
    auto r0 = __builtin_amdgcn_permlane32_swap(a0, b0, false, false); auto r1 = __builtin_amdgcn_permlane32_swap(a1, b1, false, false); \
    u32x4 w = {r0[0], r1[0], r0[1], r1[1]}; OUT = *reinterpret_cast<bf16x8*>(&w); } while (0)
      pa0 = bf16x8{}; pa3 = bf16x8{};
      if (nA) PK4(p0, 0, pa0);
      PK4(p0, 8, pa1); PK4(p1, 0, pa2);
      if (nD) PK4(p1, 8, pa3);
#undef PK4
      if (resc) {
        if (hi == 0) al_l[r32] = alpha;
        asm volatile("s_waitcnt lgkmcnt(0)" ::: "memory");
#pragma unroll
        for (int r = 0; r < 16; ++r) { const float a = al_l[crow(r, hi)];
#pragma unroll
          for (int d = 0; d < 4; ++d) o[d][r] *= a; }
      }
      pv_all(o, vb_cur, pa0, pa1, pa2, pa3, nA, nD);
    }
    __syncthreads();
  }
  if (MODE == 0) l_reg += __builtin_amdgcn_exp2f((sink - m_reg) * L2E);
  if (hi == 0) li_l[r32] = l_reg;
  asm volatile("s_waitcnt lgkmcnt(0)" ::: "memory");
  char* ot = (char*)lds + 73728 + wid * 8704;
#pragma unroll
  for (int r = 0; r < 16; ++r) { const float rl = __builtin_amdgcn_rcpf(li_l[crow(r, hi)]); bf16_t* orow = (bf16_t*)(ot + crow(r, hi) * 272) + r32;
#pragma unroll
    for (int d0 = 0; d0 < 4; ++d0) orow[d0 * 32] = f2bf(o[d0][r] * rl); }
  asm volatile("s_waitcnt lgkmcnt(0)" ::: "memory");
#pragma unroll
  for (int i = 0; i < 8; ++i) { const int id = lane + 64 * i, row = id >> 4, pc = id & 15;
    const u32x4 ov = *(const u32x4*)(ot + row * 272 + pc * 16);
    const u32x4 zv = *(const u32x4*)(P + (size_t)(qrow_w + row) * ldp + szcol + pc * 8);
    u32x4 w;
    w.x = cvt_pk_bf16(bf_lo(ov.x) * bf_lo(zv.x), bf_hi(ov.x) * bf_hi(zv.x)); w.y = cvt_pk_bf16(bf_lo(ov.y) * bf_lo(zv.y), bf_hi(ov.y) * bf_hi(zv.y));
    w.z = cvt_pk_bf16(bf_lo(ov.z) * bf_lo(zv.z), bf_hi(ov.z) * bf_hi(zv.z)); w.w = cvt_pk_bf16(bf_lo(ov.w) * bf_lo(zv.w), bf_hi(ov.w) * bf_hi(zv.w));
    *(u32x4*)(G + (size_t)(qrow_w + row) * ldg + gcol + pc * 8) = w; }
#undef TROW
#undef SLOAD
#undef SWRITE
}
}

__device__ __forceinline__ void mixerA_phase(unsigned char* lds, const Params& p) {
  const bf16_t* P = (const bf16_t*)(p.ws + WS_P); bf16_t* G = (bf16_t*)(p.ws + WS_G);
  const int wid = threadIdx.x >> 6;
  for (int u = blockIdx.x; u < 8 * 260; u += gridDim.x) {
    const int kvh = u & 7, j = u >> 3;
    const int hq = kvh * 4 + (wid >> 1);
    const float sink = p.in[I_WA_SINK][hq];
    int qrow_w, n_local = 0, local_row0 = 0, qtok0 = 0;
    if (j < 256) { qrow_w = 64 * j + 32 * (wid & 1); qtok0 = qrow_w; const int lo = max(j - 2, 0), hi_ = min(j + 2, 255); n_local = hi_ - lo + 1; local_row0 = 64 * lo; }
    else { qrow_w = SEQ + 64 * (j - 256) + 32 * (wid & 1); }
    att::attn_unit<0>(lds, P, qrow_w, 2048 + hq * 128, kvh * 128, 1024 + kvh * 128, n_local, local_row0, qtok0, 0, 0, 0, sink, nullptr,
                      G, hq * 128, 6144 + hq * 128);
  }
}
__device__ __forceinline__ void mixerC_phase(unsigned char* lds, const Params& p) {
  const bf16_t* P = (const bf16_t*)(p.ws + WS_P); bf16_t* G = (bf16_t*)(p.ws + WS_G);
  const int wid = threadIdx.x >> 6;
  float* rpbs = (float*)(lds + 69632);
  for (int u = blockIdx.x; u < 32 * 65; u += gridDim.x) {
    const int h = u & 31, rg = u >> 5;
    __syncthreads();
    if (threadIdx.x < 465) rpbs[threadIdx.x] = p.in[I_NA_RPB][h * 465 + threadIdx.x];
    int qrow_w, n_local = 0, local_row0 = 0, wrow = 0, wcol0 = 0, a_lo = 0;
    if (rg < 64) { wrow = 4 * rg + (wid >> 1); wcol0 = 32 * (wid & 1); qrow_w = 64 * wrow + wcol0;
      a_lo = min(max(4 * rg - 4, 0), 248); const int a_hi = min(max(4 * rg + 3 - 4, 0), 248) + 7; n_local = a_hi - a_lo + 1; local_row0 = 64 * a_lo; }
    else { qrow_w = SEQ + 32 * wid; }
    att::attn_unit<1>(lds, P, qrow_w, 8192 + h * 128, h * 128, 4096 + h * 128, n_local, local_row0, 0, wrow, wcol0, a_lo, 0.f, rpbs,
                      G, h * 128, 12288 + h * 128);
  }
}

__device__ __forceinline__ bf16x8 rowfrag(LAS unsigned char* base, int stride, int row0, int k0, int r32, int hi) {
    return *(const LAS bf16x8*)(base + (row0 + r32) * stride + (k0 + 8 * hi) * 2);
}
__device__ __forceinline__ void trfrag_issue(s16x4& lo, s16x4& hh, unsigned base_addr, int stride, int k0, int n0, int lane) {
    const int hi = lane >> 5, blk = (lane >> 4) & 1, q = (lane & 15) >> 2, pp = lane & 3;
    const unsigned a0 = base_addr + (unsigned)((k0 + 8 * hi + q) * stride + (n0 + 16 * blk + 4 * pp) * 2);
    const unsigned a1 = a0 + (unsigned)(4 * stride);
    asm volatile("ds_read_b64_tr_b16 %0, %1" : "=&v"(lo) : "v"(a0) : "memory");
    asm volatile("ds_read_b64_tr_b16 %0, %1" : "=&v"(hh) : "v"(a1) : "memory");
}
__device__ __forceinline__ void tr_wait() { asm volatile("s_waitcnt lgkmcnt(0)" ::: "memory"); __builtin_amdgcn_sched_barrier(0); }
#define TR2(lo_, hh_, base_, OFF_, STRIDE_) asm volatile("ds_read_b64_tr_b16 %0, %2 offset:%3\n\tds_read_b64_tr_b16 %1, %2 offset:%4" : "=&v"(lo_), "=&v"(hh_) : "v"(base_), "i"(OFF_), "i"((OFF_) + 4 * (STRIDE_)) : "memory")
__device__ __forceinline__ unsigned tr_lane_base(unsigned tile_addr, int stride, int lane) { const int hi = lane >> 5, blk = (lane >> 4) & 1, q = (lane & 15) >> 2, pp = lane & 3; return tile_addr + (unsigned)((8 * hi + q) * stride + (16 * blk + 4 * pp) * 2); }
#define TRPK(L_, H_) (bf16x8){L_[0], L_[1], L_[2], L_[3], H_[0], H_[1], H_[2], H_[3]}
__device__ __forceinline__ int crow16(int r, int hi) { return (r & 3) + 8 * (r >> 2) + 4 * hi; }

typedef float f32x4c __attribute__((ext_vector_type(4)));
template <class EpiC>
__device__ __forceinline__ void ctx_gemm64(LAS unsigned char* L, const bf16_t* __restrict__ A, const bf16_t* __restrict__ Bt, int K, int item, const EpiC& E) {
    constexpr int STR = 528, WOFF = 64 * 528;
    const int tid = threadIdx.x, lane = tid & 63, wid = tid >> 6, li = lane & 15, q = lane >> 4;
    const int rb = item & 3, cb = item >> 2, ar = wid & 3, nb2 = (wid >> 2) * 2;
    const bf16_t* Ab = A + (size_t)(64 * rb) * K; const bf16_t* Wb_ = Bt + (size_t)(64 * cb) * K;
    f32x4c acc0 = {0.f, 0.f, 0.f, 0.f}, acc1 = {0.f, 0.f, 0.f, 0.f};
    bf16x8 gA[8], gB[8];
#define CG_LOAD(R_, kc) do { _Pragma("unroll") for (int i = 0; i < 4; ++i) { const int id = tid + NTHREADS * i; \
        R_[i] = *(const bf16x8*)(Ab + (size_t)(id >> 5) * K + (kc) + (id & 31) * 8); R_[4 + i] = *(const bf16x8*)(Wb_ + (size_t)(id >> 5) * K + (kc) + (id & 31) * 8); } } while (0)
#define CG_WRITE(R_) do { _Pragma("unroll") for (int i = 0; i < 4; ++i) { const int id = tid + NTHREADS * i; \
        *(LAS bf16x8*)(L + (id >> 5) * STR + (id & 31) * 16) = R_[i]; *(LAS bf16x8*)(L + WOFF + (id >> 5) * STR + (id & 31) * 16) = R_[4 + i]; } } while (0)
    CG_LOAD(gA, 0); CG_LOAD(gB, 256);
    const int nch = K / 256;
    for (int c = 0; c < nch; ++c) {
        __syncthreads();
        if (c & 1) CG_WRITE(gB); else CG_WRITE(gA);
        __syncthreads();
        if (c + 2 < nch) { if (c & 1) CG_LOAD(gB, (c + 2) * 256); else CG_LOAD(gA, (c + 2) * 256); }
#pragma unroll
        for (int s = 0; s < 8; ++s) {
            const bf16x8 af = *(const LAS bf16x8*)(L + (16 * ar + li) * STR + (32 * s + 8 * q) * 2);
            const bf16x8 w0 = *(const LAS bf16x8*)(L + WOFF + (16 * nb2 + li) * STR + (32 * s + 8 * q) * 2), w1 = *(const LAS bf16x8*)(L + WOFF + (16 * nb2 + 16 + li) * STR + (32 * s + 8 * q) * 2);
            acc0 = __builtin_amdgcn_mfma_f32_16x16x32_bf16(w0, af, acc0, 0, 0, 0); acc1 = __builtin_amdgcn_mfma_f32_16x16x32_bf16(w1, af, acc1, 0, 0, 0);
        }
    }
#undef CG_LOAD
#undef CG_WRITE
    __syncthreads();
    E(acc0, 64 * cb + 16 * nb2 + 4 * q, 64 * rb + 16 * ar + li); E(acc1, 64 * cb + 16 * nb2 + 16 + 4 * q, 64 * rb + 16 * ar + li);
}
struct EpiCPlain {
    bf16_t* Pc; int ldp;
    __device__ __forceinline__ void operator()(f32x4c acc, int n, int row) const {
        u32x2 w; w.x = cvt_pk_bf16(acc[0], acc[1]); w.y = cvt_pk_bf16(acc[2], acc[3]);
        *(u32x2*)(Pc + (size_t)row * ldp + n) = w;
    }
};

namespace ret {
constexpr int QS = 0, KS = 33792, VS = 70656, ST0 = 82944, ST1 = 116736;
constexpr int QSTR = 528, KSTR = 576, VSTR = 192;
constexpr int NSTEP = 260, LDP = RT_INW;
constexpr size_t ATT_TILE = 64 * 64, ATT_DIR = (size_t)16 * 260 * ATT_TILE;
__device__ __forceinline__ int cid_row(int cid) { return cid < 4 ? SEQ + 64 * cid : 64 * (cid - 4); }
__device__ __forceinline__ int step_cid(int dir, int step) { return dir ? (step < 4 ? 3 - step : 263 - step) : step; }
}
__device__ __forceinline__ void retatt_phase(LAS unsigned char* L, const Params& p) {
    using namespace ret;
    const bf16_t* P = (const bf16_t*)(p.ws + WS_P); bf16_t* ATT = (bf16_t*)(p.ws + WS_G);
    const int tid = threadIdx.x, wid = __builtin_amdgcn_readfirstlane(tid >> 6), lane = tid & 63, r32 = lane & 31, hi = lane >> 5;
    const int hb = wid >> 2, t8 = tid & 255, w4 = wid & 3, qb = w4 >> 1, kb = w4 & 1;
    LAS unsigned char* Lq = L + hb * 67584; LAS unsigned char* Lk = Lq + 33792;
    for (int pair = blockIdx.x; pair < 2080; pair += gridDim.x) {
        const int u = 2 * pair + hb, h = u / 260, cid = u - h * 260, row0 = cid_row(cid);
        const float lgf = p.in[I_RT_LD][h] * L2E, lgb = p.in[I_RT_LD][16 + h] * L2E;
        bf16x8 qg[8], kg[8];
#pragma unroll
        for (int i = 0; i < 8; ++i) { const int idx = t8 + 256 * i, rr = idx >> 5, cc = idx & 31; const bf16_t* b_ = P + (size_t)(row0 + rr) * LDP + cc * 8;
            qg[i] = *(const bf16x8*)(b_ + 12288 + h * 256); kg[i] = *(const bf16x8*)(b_ + h * 256); }
        __syncthreads();
#pragma unroll
        for (int i = 0; i < 8; ++i) { const int idx = t8 + 256 * i, rr = idx >> 5, cc = idx & 31; *(LAS bf16x8*)(Lq + rr * QSTR + cc * 16) = qg[i]; *(LAS bf16x8*)(Lk + rr * QSTR + cc * 16) = kg[i]; }
        __syncthreads();
        f32x16 acc = {};
#pragma unroll 4
        for (int s = 0; s < 16; ++s) acc = __builtin_amdgcn_mfma_f32_32x32x16_bf16(rowfrag(Lk, QSTR, 32 * kb, 16 * s, r32, hi), rowfrag(Lq, QSTR, 32 * qb, 16 * s, r32, hi), acc, 0, 0, 0);
        const int a = 32 * qb + r32;
        const float ef = __builtin_amdgcn_exp2f((float)(a - 63) * lgf), eb = __builtin_amdgcn_exp2f((float)(-a) * lgb);
        bf16_t* af = ATT + ((size_t)h * 260 + cid) * ATT_TILE + (size_t)a * 64; bf16_t* ab = af + ATT_DIR;
#pragma unroll
        for (int g4 = 0; g4 < 4; ++g4) {
            float vf[4], vb[4];
#pragma unroll
            for (int i = 0; i < 4; ++i) { const int b = 32 * kb + 8 * g4 + 4 * hi + i, df = a - b; const float sc = acc[4 * g4 + i];
                vf[i] = (df >= 0) ? sc * ef : 0.f; vb[i] = (df < 0) ? sc * eb : 0.f; }
            u32x2 wf, wb; wf.x = cvt_pk_bf16(vf[0], vf[1]); wf.y = cvt_pk_bf16(vf[2], vf[3]); wb.x = cvt_pk_bf16(vb[0], vb[1]); wb.y = cvt_pk_bf16(vb[2], vb[3]);
            *(u32x2*)(af + 32 * kb + 8 * g4 + 4 * hi) = wf; *(u32x2*)(ab + 32 * kb + 8 * g4 + 4 * hi) = wb;
        }
    }
}
struct RetCtx { const bf16_t* P; const bf16_t* Ad; bf16_t* Ob; float lg2, cdec; int dir, h, ebI, qcol0, kcol0, vcol0; unsigned Lb; };
__device__ __forceinline__ void ret_step_o(LAS unsigned char* L, const RetCtx& c, int step, bf16x8 (&G)[10], bf16x8 (&atc)[4], bf16x8 (&atn)[4], int t8, int wid, int lane) {
    using namespace ret;
    const int r32 = lane & 31, hi = lane >> 5, qb = (wid & 3) >> 1, xb = wid & 1;
    const int cid = step_cid(c.dir, step), row0 = cid_row(cid);
    const int stc = (step & 1) ? ST1 : ST0;
    __syncthreads();
#pragma unroll
    for (int i = 0; i < 8; ++i) { const int idx = t8 + 256 * i, rr = idx >> 5, cc = idx & 31; *(LAS bf16x8*)(L + QS + rr * QSTR + cc * 16) = G[i]; }
    float lg2s = c.lg2; asm volatile("" : "+v"(lg2s));
    int t8o = t8; asm volatile("" : "+v"(t8o));
#pragma unroll
    for (int i = 0; i < 2; ++i) { const int idx = t8 + 256 * i, rr = idx >> 3, cc = idx & 7;
        const int rro = (t8o >> 3) + 32 * i;
        const u32x4 w = *reinterpret_cast<const u32x4*>(&G[8 + i]); u32x4 s; const float f = __builtin_amdgcn_exp2f((float)(c.dir ? rro : 63 - rro) * lg2s);
        s.x = cvt_pk_bf16(bf_lo(w.x) * f, bf_hi(w.x) * f); s.y = cvt_pk_bf16(bf_lo(w.y) * f, bf_hi(w.y) * f);
        s.z = cvt_pk_bf16(bf_lo(w.z) * f, bf_hi(w.z) * f); s.w = cvt_pk_bf16(bf_lo(w.w) * f, bf_hi(w.w) * f);
        *(LAS u32x4*)(L + VS + rr * VSTR + cc * 16) = s; }
    __syncthreads();
    { const int sn = (step + 2 < NSTEP) ? step + 2 : NSTEP - 1; const int rown = cid_row(step_cid(c.dir, sn));
#pragma unroll
        for (int i = 0; i < 8; ++i) { const int idx = t8 + 256 * i, rr = idx >> 5, cc = idx & 31; G[i] = *(const bf16x8*)(c.P + (size_t)(rown + rr) * LDP + c.qcol0 + cc * 8); }
#pragma unroll
        for (int i = 0; i < 2; ++i) { const int idx = t8 + 256 * i, rr = idx >> 3, cc = idx & 7; G[8 + i] = *(const bf16x8*)(c.P + (size_t)(rown + rr) * LDP + c.vcol0 + cc * 8); } }
    { const int sn = (step + 1 < NSTEP) ? step + 1 : NSTEP - 1; const bf16_t* ap = c.Ad + (size_t)step_cid(c.dir, sn) * ATT_TILE + (size_t)(32 * qb + r32) * 64 + 8 * hi;
        atn[0] = *(const bf16x8*)ap; atn[1] = *(const bf16x8*)(ap + 16); atn[2] = *(const bf16x8*)(ap + 32); atn[3] = *(const bf16x8*)(ap + 48); }
    f32x16 acc1 = {};
#pragma unroll 4
    for (int s = 0; s < 16; ++s) acc1 = __builtin_amdgcn_mfma_f32_32x32x16_bf16(rowfrag(L + stc, QSTR, 32 * xb, 16 * s, r32, hi), rowfrag(L + QS, QSTR, 32 * qb, 16 * s, r32, hi), acc1, 0, 0, 0);
    { int r32o = r32; asm volatile("" : "+v"(r32o)); const int a = 32 * qb + r32o;
      const float qd = __builtin_amdgcn_exp2f((float)(c.dir ? 64 - a : a + 1) * lg2s);
#pragma unroll
      for (int r = 0; r < 16; ++r) acc1[r] *= qd; }
    const unsigned vb1_ = tr_lane_base(c.Lb + VS, VSTR, lane) + (unsigned)(64 * xb);
    s16x4 vl0, vh0, vl1, vh1, vl2, vh2, vl3, vh3;
    TR2(vl0, vh0, vb1_, 0 * VSTR, VSTR); TR2(vl1, vh1, vb1_, 16 * VSTR, VSTR); TR2(vl2, vh2, vb1_, 32 * VSTR, VSTR); TR2(vl3, vh3, vb1_, 48 * VSTR, VSTR);
    tr_wait();
    acc1 = __builtin_amdgcn_mfma_f32_32x32x16_bf16(TRPK(vl0, vh0), atc[0], acc1, 0, 0, 0);
    acc1 = __builtin_amdgcn_mfma_f32_32x32x16_bf16(TRPK(vl1, vh1), atc[1], acc1, 0, 0, 0);
    acc1 = __builtin_amdgcn_mfma_f32_32x32x16_bf16(TRPK(vl2, vh2), atc[2], acc1, 0, 0, 0);
    acc1 = __builtin_amdgcn_mfma_f32_32x32x16_bf16(TRPK(vl3, vh3), atc[3], acc1, 0, 0, 0);
    bf16_t* op = c.Ob + (size_t)(row0 + 32 * qb + r32) * 8192 + c.h * 512 + c.ebI * 64 + 32 * xb + 4 * hi;
#pragma unroll
    for (int g4 = 0; g4 < 4; ++g4) { u32x2 w; w.x = cvt_pk_bf16(acc1[4 * g4], acc1[4 * g4 + 1]); w.y = cvt_pk_bf16(acc1[4 * g4 + 2], acc1[4 * g4 + 3]); *(u32x2*)(op + 8 * g4) = w; }
}
__device__ __forceinline__ void ret_step_s(LAS unsigned char* L, const RetCtx& c, int step, bf16x8 (&G)[8], f32x16& S00, f32x16& S01, f32x16& S10, f32x16& S11, int t8, int wid, int lane) {
    using namespace ret;
    const int r32 = lane & 31, hi = lane >> 5, sw = wid & 3;
    const int stn = (step & 1) ? ST0 : ST1;
    __syncthreads();
#pragma unroll
    for (int i = 0; i < 8; ++i) { const int idx = t8 + 256 * i, rr = idx >> 5, cc = idx & 31; *(LAS bf16x8*)(L + KS + rr * KSTR + cc * 16) = G[i]; }
    __syncthreads();
    { const int sn = (step + 2 < NSTEP) ? step + 2 : NSTEP - 1; const int rown = cid_row(step_cid(c.dir, sn));
#pragma unroll
        for (int i = 0; i < 8; ++i) { const int idx = t8 + 256 * i, rr = idx >> 5, cc = idx & 31; G[i] = *(const bf16x8*)(c.P + (size_t)(rown + rr) * LDP + c.kcol0 + cc * 8); } }
    S00 *= c.cdec; S01 *= c.cdec; S10 *= c.cdec; S11 *= c.cdec;
    const unsigned vbase = tr_lane_base(c.Lb + VS, VSTR, lane);
    const unsigned kbase = tr_lane_base(c.Lb + KS, KSTR, lane) + (unsigned)(128 * sw);
#define RET_SUPD(S0_) do { s16x4 ka0, kb0, kc0, kd0, va0, vb0, vc0, vd0; \
    TR2(ka0, kb0, kbase, (16 * (S0_)) * KSTR, KSTR); TR2(kc0, kd0, kbase, (16 * (S0_)) * KSTR + 64, KSTR); TR2(va0, vb0, vbase, (16 * (S0_)) * VSTR, VSTR); TR2(vc0, vd0, vbase, (16 * (S0_)) * VSTR + 64, VSTR); \
    tr_wait(); \
    { const bf16x8 k0_ = TRPK(ka0, kb0), k1_ = TRPK(kc0, kd0), v0_ = TRPK(va0, vb0), v1_ = TRPK(vc0, vd0); \
      S00 = __builtin_amdgcn_mfma_f32_32x32x16_bf16(k0_, v0_, S00, 0, 0, 0); S01 = __builtin_amdgcn_mfma_f32_32x32x16_bf16(k0_, v1_, S01, 0, 0, 0); \
      S10 = __builtin_amdgcn_mfma_f32_32x32x16_bf16(k1_, v0_, S10, 0, 0, 0); S11 = __builtin_amdgcn_mfma_f32_32x32x16_bf16(k1_, v1_, S11, 0, 0, 0); } \
    __builtin_amdgcn_sched_barrier(0); } while (0)
    RET_SUPD(0); RET_SUPD(1); RET_SUPD(2); RET_SUPD(3);
#undef RET_SUPD
#define RET_STW(S_, T_, EB_) do { _Pragma("unroll") for (int g4 = 0; g4 < 4; ++g4) { u32x2 w; w.x = cvt_pk_bf16(S_[4 * g4], S_[4 * g4 + 1]); w.y = cvt_pk_bf16(S_[4 * g4 + 2], S_[4 * g4 + 3]); \
        *(LAS u32x2*)(L + stn + (32 * (EB_) + r32) * QSTR + (64 * sw + 32 * (T_) + 8 * g4 + 4 * hi) * 2) = w; } } while (0)
    RET_STW(S00, 0, 0); RET_STW(S01, 0, 1); RET_STW(S10, 1, 0); RET_STW(S11, 1, 1);
#undef RET_STW
}
__device__ __forceinline__ void retention_phase(LAS unsigned char* L, const Params& p) {
    using namespace ret;
    const int tid = threadIdx.x, wid = __builtin_amdgcn_readfirstlane(tid >> 6), lane = tid & 63, r32 = lane & 31, hi = lane >> 5, t8 = tid & 255;
    for (int item = blockIdx.x; item < 256; item += gridDim.x) {
        const int grp = (item & 7) * 4 + (item >> 6), ebI = (item >> 3) & 7, h = grp >> 1, dir = grp & 1;
        RetCtx c;
        c.P = (const bf16_t*)(p.ws + WS_P); c.Ad = (const bf16_t*)(p.ws + WS_G) + (dir ? ATT_DIR : 0) + (size_t)h * 260 * ATT_TILE; c.Ob = (bf16_t*)(p.ws + (dir ? WS_OB : WS_OF));
        c.lg2 = p.in[I_RT_LD][dir * 16 + h] * L2E; c.cdec = __builtin_amdgcn_exp2f(64.0f * c.lg2);
        c.dir = dir; c.h = h; c.ebI = ebI; c.qcol0 = 12288 + h * 256; c.kcol0 = h * 256; c.vcol0 = 4096 + h * 512 + ebI * 64; c.Lb = (unsigned)(uintptr_t)L;
        __syncthreads();
        for (int i = tid; i < 33792 / 16; i += NTHREADS) *(LAS u32x4*)(L + ST0 + i * 16) = (u32x4){0u, 0u, 0u, 0u};
        const int row_0 = cid_row(step_cid(dir, 0)), row_1 = cid_row(step_cid(dir, 1));
        if (wid < 4) {
            bf16x8 gA[10], gB[10], atA[4], atB[4] = {};
            { const int qb = (wid & 3) >> 1; const bf16_t* ap = c.Ad + (size_t)step_cid(dir, 0) * ATT_TILE + (size_t)(32 * qb + r32) * 64 + 8 * hi;
              atA[0] = *(const bf16x8*)ap; atA[1] = *(const bf16x8*)(ap + 16); atA[2] = *(const bf16x8*)(ap + 32); atA[3] = *(const bf16x8*)(ap + 48); }
#pragma unroll
            for (int i = 0; i < 8; ++i) { const int idx = t8 + 256 * i, rr = idx >> 5, cc = idx & 31; gA[i] = *(const bf16x8*)(c.P + (size_t)(row_0 + rr) * LDP + c.qcol0 + cc * 8); }
#pragma unroll
            for (int i = 0; i < 2; ++i) { const int idx = t8 + 256 * i, rr = idx >> 3, cc = idx & 7; gA[8 + i] = *(const bf16x8*)(c.P + (size_t)(row_0 + rr) * LDP + c.vcol0 + cc * 8); }
            asm volatile("" ::: "memory");
#pragma unroll
            for (int i = 0; i < 8; ++i) { const int idx = t8 + 256 * i, rr = idx >> 5, cc = idx & 31; gB[i] = *(const bf16x8*)(c.P + (size_t)(row_1 + rr) * LDP + c.qcol0 + cc * 8); }
#pragma unroll
            for (int i = 0; i < 2; ++i) { const int idx = t8 + 256 * i, rr = idx >> 3, cc = idx & 7; gB[8 + i] = *(const bf16x8*)(c.P + (size_t)(row_1 + rr) * LDP + c.vcol0 + cc * 8); }
            for (int step = 0; step < NSTEP; step += 2) {
                ret_step_o(L, c, step, gA, atA, atB, t8, wid, lane);
                ret_step_o(L, c, step + 1, gB, atB, atA, t8, wid, lane);
            }
        } else {
            bf16x8 gA[8], gB[8];
            f32x16 S00 = {}, S01 = {}, S10 = {}, S11 = {};
#pragma unroll
            for (int i = 0; i < 8; ++i) { const int idx = t8 + 256 * i, rr = idx >> 5, cc = idx & 31; gA[i] = *(const bf16x8*)(c.P + (size_t)(row_0 + rr) * LDP + c.kcol0 + cc * 8); }
            asm volatile("" ::: "memory");
#pragma unroll
            for (int i = 0; i < 8; ++i) { const int idx = t8 + 256 * i, rr = idx >> 5, cc = idx & 31; gB[i] = *(const bf16x8*)(c.P + (size_t)(row_1 + rr) * LDP + c.kcol0 + cc * 8); }
            for (int step = 0; step < NSTEP; step += 2) {
                ret_step_s(L, c, step, gA, S00, S01, S10, S11, t8, wid, lane);
                ret_step_s(L, c, step + 1, gB, S00, S01, S10, S11, t8, wid, lane);
            }
        }
    }
}
__device__ __forceinline__ void retnorm_phase(const Params& p) {
    const bf16_t* OF = (const bf16_t*)(p.ws + WS_OF); const bf16_t* OB = (const bf16_t*)(p.ws + WS_OB); const bf16_t* P = (const bf16_t*)(p.ws + WS_P); bf16_t* G = (bf16_t*)(p.ws + WS_G);
    const int wid = threadIdx.x >> 6, lane = threadIdx.x & 63;
    for (int unit0 = (blockIdx.x * 8 + wid) * 4; unit0 < MROWS * 16; unit0 += gridDim.x * 32) {
        u32x4 a[4], b[4], z[4];
#pragma unroll
        for (int j = 0; j < 4; ++j) { const int unit = unit0 + j, row = unit >> 4, h = unit & 15; const size_t off = (size_t)row * 8192 + h * 512 + lane * 8;
            a[j] = *(const u32x4*)(OF + off); b[j] = *(const u32x4*)(OB + off); z[j] = *(const u32x4*)(P + (size_t)row * RT_INW + 16384 + h * 512 + lane * 8); }
#pragma unroll
        for (int j = 0; j < 4; ++j) { const int unit = unit0 + j, row = unit >> 4, h = unit & 15; const size_t off = (size_t)row * 8192 + h * 512 + lane * 8;
            float o[8];
            o[0] = bf_lo(a[j].x) + bf_lo(b[j].x); o[1] = bf_hi(a[j].x) + bf_hi(b[j].x); o[2] = bf_lo(a[j].y) + bf_lo(b[j].y); o[3] = bf_hi(a[j].y) + bf_hi(b[j].y);
            o[4] = bf_lo(a[j].z) + bf_lo(b[j].z); o[5] = bf_hi(a[j].z) + bf_hi(b[j].z); o[6] = bf_lo(a[j].w) + bf_lo(b[j].w); o[7] = bf_hi(a[j].w) + bf_hi(b[j].w);
            float s = ((o[0] + o[1]) + (o[2] + o[3])) + ((o[4] + o[5]) + (o[6] + o[7]));
#pragma unroll
            for (int x = 32; x >= 1; x >>= 1) s += __shfl_xor(s, x);
            const float mu = s * (1.0f / 512.0f);
            float q = 0.f;
#pragma unroll
            for (int k = 0; k < 8; ++k) { o[k] -= mu; q += o[k] * o[k]; }
#pragma unroll
            for (int x = 32; x >= 1; x >>= 1) q += __shfl_xor(q, x);
            const float rstd = 1.0f / sqrtf(q * (1.0f / 512.0f) + LN_EPS);
            u32x4 w;
            w.x = cvt_pk_bf16(o[0] * rstd * silu_f(bf_lo(z[j].x)), o[1] * rstd * silu_f(bf_hi(z[j].x))); w.y = cvt_pk_bf16(o[2] * rstd * silu_f(bf_lo(z[j].y)), o[3] * rstd * silu_f(bf_hi(z[j].y)));
            w.z = cvt_pk_bf16(o[4] * rstd * silu_f(bf_lo(z[j].z)), o[5] * rstd * silu_f(bf_hi(z[j].z))); w.w = cvt_pk_bf16(o[6] * rstd * silu_f(bf_lo(z[j].w)), o[7] * rstd * silu_f(bf_hi(z[j].w)));
            *(u32x4*)(G + off) = w; }
    }
}

__device__ __forceinline__ int s5_row(int dir, int n) { return n < NCTX ? (dir ? SEQ + NCTX - 1 - n : SEQ + n) : (dir ? SEQ - 1 - (n - NCTX) : n - NCTX); }
__device__ __forceinline__ bf16x8 pack8(const float* v) { u32x4 w; w.x = cvt_pk_bf16(v[0], v[1]); w.y = cvt_pk_bf16(v[2], v[3]); w.z = cvt_pk_bf16(v[4], v[5]); w.w = cvt_pk_bf16(v[6], v[7]); return *reinterpret_cast<bf16x8*>(&w); }
__device__ __forceinline__ void s5_scan_phase(LAS unsigned char* L, const Params& p) {
    const bf16_t* P = (const bf16_t*)(p.ws + WS_P);
    const int tid = threadIdx.x, wid = __builtin_amdgcn_readfirstlane(tid >> 6), lane = tid & 63, pl = lane & 31, hi = lane >> 5;
    const int dir = wid >> 2, seg = wid & 3;
    constexpr int NBS = (MROWS / 32) / 4;
    bf16_t* Y = (bf16_t*)(p.ws + WS_OF) + (size_t)dir * SEQ * DM;
    LAS unsigned char* T = L + wid * 10240;
    LAS float* EX = (LAS float*)(L + 81920);
    const unsigned Tb = (unsigned)(uintptr_t)T;
    for (int g = blockIdx.x; g < 256; g += gridDim.x) {
        const float dt = expf(p.in[I_S5_LDT][dir * 256 + g]);
        float lr[2], li[2], l16r[2], l16i[2], lsr[2], lsi[2]; bf16x8 Bre[2], Bim[2];
#pragma unroll
        for (int pb = 0; pb < 2; ++pb) {
            const int pp = pb * 32 + pl;
            const float are = p.in[I_S5_ARE][(size_t)(dir * 256 + g) * 64 + pp], aim = p.in[I_S5_AIM][(size_t)(dir * 256 + g) * 64 + pp];
            const float er = expf(are * dt); float sn, cs; sincosf(aim * dt, &sn, &cs);
            lr[pb] = er * cs; li[pb] = er * sn;
            { const float e16 = expf(are * dt * 16.0f); float s16, c16; sincosf(aim * dt * 16.0f, &s16, &c16); l16r[pb] = e16 * c16; l16i[pb] = e16 * s16; }
            { const float es = expf(are * dt * (float)(NBS * 32)); float ss, cs2; sincosf(aim * dt * (float)(NBS * 32), &ss, &cs2); lsr[pb] = es * cs2; lsi[pb] = es * ss; }
            const float den = are * are + aim * aim, nr = lr[pb] - 1.0f, ni = li[pb];
            const float cr = (nr * are + ni * aim) / den, ci = (ni * are - nr * aim) / den;
            float br_[8], bi_[8];
#pragma unroll
            for (int j = 0; j < 8; ++j) { const size_t bo = ((size_t)g * 64 + pp) * 16 + 8 * hi + j; const float br = p.in[I_S5_BRE][bo], bi = p.in[I_S5_BIM][bo];
                br_[j] = cr * br - ci * bi; bi_[j] = cr * bi + ci * br; }
            Bre[pb] = pack8(br_); Bim[pb] = pack8(bi_);
        }
        const int slot_proc = 16 * ((pl >> 2) & 1) + (pl & 3) + 4 * (pl >> 3);
        const int nb0 = seg * NBS;
        float cinr[2] = {0.f, 0.f}, cini[2] = {0.f, 0.f};
        if (seg < 3) {
            bf16x8 uf = *(const bf16x8*)(P + (size_t)s5_row(dir, nb0 * 32 + slot_proc) * S5_INW + 16 * g + 8 * hi);
            for (int nb = nb0; nb < nb0 + NBS; ++nb) {
                const bf16x8 ucur = uf;
                if (nb + 1 < nb0 + NBS) uf = *(const bf16x8*)(P + (size_t)s5_row(dir, nb * 32 + 32 + slot_proc) * S5_INW + 16 * g + 8 * hi);
#pragma unroll
                for (int pb = 0; pb < 2; ++pb) {
                    const f32x16 xr = __builtin_amdgcn_mfma_f32_32x32x16_bf16(ucur, Bre[pb], f32x16{}, 0, 0, 0);
                    const f32x16 xi = __builtin_amdgcn_mfma_f32_32x32x16_bf16(ucur, Bim[pb], f32x16{}, 0, 0, 0);
                    const float a = lr[pb], b = li[pb];
                    float cr = hi ? 0.f : cinr[pb], ci = hi ? 0.f : cini[pb];
#pragma unroll
                    for (int r = 0; r < 16; ++r) { const float nr = fmaf(a, cr, fmaf(-b, ci, xr[r])), ni = fmaf(a, ci, fmaf(b, cr, xi[r])); cr = nr; ci = ni; }
                    const float e0r = __shfl(cr, pl), e0i = __shfl(ci, pl), e1r = __shfl(cr, pl + 32), e1i = __shfl(ci, pl + 32);
                    cinr[pb] = e1r + l16r[pb] * e0r - l16i[pb] * e0i; cini[pb] = e1i + l16r[pb] * e0i + l16i[pb] * e0r;
                }
            }
            if (hi == 0) {
#pragma unroll
                for (int pb = 0; pb < 2; ++pb) { EX[(((dir * 4 + seg) * 2 + pb) * 2 + 0) * 32 + pl] = cinr[pb]; EX[(((dir * 4 + seg) * 2 + pb) * 2 + 1) * 32 + pl] = cini[pb]; }
            }
        }
        __syncthreads();
#pragma unroll
        for (int pb = 0; pb < 2; ++pb) {
            float xr = 0.f, xi = 0.f;
            for (int s = 0; s < seg; ++s) { const float er = EX[(((dir * 4 + s) * 2 + pb) * 2 + 0) * 32 + pl], ei = EX[(((dir * 4 + s) * 2 + pb) * 2 + 1) * 32 + pl];
                const float nr = lsr[pb] * xr - lsi[pb] * xi + er, ni = lsr[pb] * xi + lsi[pb] * xr + ei; xr = nr; xi = ni; }
            cinr[pb] = xr; cini[pb] = xi;
        }
        bf16x8 Cf[8];
#pragma unroll
        for (int s = 0; s < 8; ++s) { float cv[8];
#pragma unroll
            for (int j = 0; j < 8; ++j) { const int k = 16 * s + 8 * hi + j, x = k >> 6, pp = k & 63; const size_t co = ((size_t)g * 16 + (pl & 15)) * 64 + pp;
                const float v = x ? -p.in[I_S5_CIM][co] : p.in[I_S5_CRE][co]; cv[j] = (pl < 16) ? v : 0.f; }
            Cf[s] = pack8(cv); }
        bf16x8 uf = *(const bf16x8*)(P + (size_t)s5_row(dir, nb0 * 32 + slot_proc) * S5_INW + 16 * g + 8 * hi);
        for (int nb = nb0; nb < nb0 + NBS; ++nb) {
            const int n0 = nb * 32;
            const bf16x8 ucur = uf;
            if (nb + 1 < nb0 + NBS) uf = *(const bf16x8*)(P + (size_t)s5_row(dir, n0 + 32 + slot_proc) * S5_INW + 16 * g + 8 * hi);
            f32x16 xr[2], xi[2];
#pragma unroll
            for (int pb = 0; pb < 2; ++pb) {
                xr[pb] = __builtin_amdgcn_mfma_f32_32x32x16_bf16(ucur, Bre[pb], f32x16{}, 0, 0, 0);
                xi[pb] = __builtin_amdgcn_mfma_f32_32x32x16_bf16(ucur, Bim[pb], f32x16{}, 0, 0, 0);
            }
#pragma unroll
            for (int pb = 0; pb < 2; ++pb) {
                const float a = lr[pb], b = li[pb];
                float cr = cinr[pb], ci = cini[pb];
#pragma unroll
                for (int r = 0; r < 16; ++r) { const float nr = fmaf(a, cr, fmaf(-b, ci, xr[pb][r])), ni = fmaf(a, ci, fmaf(b, cr, xi[pb][r])); cr = nr; ci = ni; }
                const float e0r = __shfl(cr, pl), e0i = __shfl(ci, pl);
                cr = hi ? e0r : cinr[pb]; ci = hi ? e0i : cini[pb];
#pragma unroll
                for (int r = 0; r < 16; ++r) { const float nr = fmaf(a, cr, fmaf(-b, ci, xr[pb][r])), ni = fmaf(a, ci, fmaf(b, cr, xi[pb][r])); cr = nr; ci = ni; xr[pb][r] = nr; xi[pb][r] = ni; }
                cinr[pb] = __shfl(cr, pl + 32); cini[pb] = __shfl(ci, pl + 32);
            }
            if (n0 >= NCTX) {
#pragma unroll
                for (int pb = 0; pb < 2; ++pb) {
                    u32x4 w0, w1;
                    w0.x = cvt_pk_bf16(xr[pb][0], xr[pb][1]); w0.y = cvt_pk_bf16(xr[pb][2], xr[pb][3]); w0.z = cvt_pk_bf16(xr[pb][4], xr[pb][5]); w0.w = cvt_pk_bf16(xr[pb][6], xr[pb][7]);
                    w1.x = cvt_pk_bf16(xr[pb][8], xr[pb][9]); w1.y = cvt_pk_bf16(xr[pb][10], xr[pb][11]); w1.z = cvt_pk_bf16(xr[pb][12], xr[pb][13]); w1.w = cvt_pk_bf16(xr[pb][14], xr[pb][15]);
                    LAS unsigned char* d = T + (pb * 32 + pl) * 80 + 32 * hi;
                    *(LAS u32x4*)d = w0; *(LAS u32x4*)(d + 16) = w1;
                    w0.x = cvt_pk_bf16(xi[pb][0], xi[pb][1]); w0.y = cvt_pk_bf16(xi[pb][2], xi[pb][3]); w0.z = cvt_pk_bf16(xi[pb][4], xi[pb][5]); w0.w = cvt_pk_bf16(xi[pb][6], xi[pb][7]);
                    w1.x = cvt_pk_bf16(xi[pb][8], xi[pb][9]); w1.y = cvt_pk_bf16(xi[pb][10], xi[pb][11]); w1.z = cvt_pk_bf16(xi[pb][12], xi[pb][13]); w1.w = cvt_pk_bf16(xi[pb][14], xi[pb][15]);
                    d += 64 * 80;
                    *(LAS u32x4*)d = w0; *(LAS u32x4*)(d + 16) = w1;
                }
                asm volatile("s_waitcnt lgkmcnt(0)" ::: "memory");
                s16x4 tl[8], th[8];
#pragma unroll
                for (int s = 0; s < 8; ++s) trfrag_issue(tl[s], th[s], Tb, 80, 16 * s, 0, lane);
                tr_wait();
                f32x16 y = {};
#pragma unroll
                for (int s = 0; s < 8; ++s) y = __builtin_amdgcn_mfma_f32_32x32x16_bf16(Cf[s], TRPK(tl[s], th[s]), y, 0, 0, 0);
                { bf16_t* yp = Y + (size_t)s5_row(dir, n0 + pl) * DM + 16 * g + 4 * hi;
                  u32x2 w0, w1; w0.x = cvt_pk_bf16(y[0], y[1]); w0.y = cvt_pk_bf16(y[2], y[3]); w1.x = cvt_pk_bf16(y[4], y[5]); w1.y = cvt_pk_bf16(y[6], y[7]);
                  *(u32x2*)yp = w0; *(u32x2*)(yp + 8) = w1; }
                asm volatile("s_waitcnt lgkmcnt(0)" ::: "memory");
            }
        }
        __syncthreads();
    }
}
__device__ __forceinline__ void s5_prep_phase(LAS unsigned char* lds, const Params& p) {
    const bf16_t* YF = (const bf16_t*)(p.ws + WS_OF); const bf16_t* YB = YF + (size_t)SEQ * DM; const bf16_t* P = (const bf16_t*)(p.ws + WS_P);
    bf16_t* A2 = (bf16_t*)(p.ws + WS_OB);
    LAS float* dsk = (LAS float*)lds;
    __syncthreads();
    for (int k = threadIdx.x; k < 1024; k += NTHREADS) *(LAS f32x4*)(dsk + 4 * k) = *(const f32x4*)(p.in[I_S5_D] + 4 * k);
    __syncthreads();
    const size_t nchunk = (size_t)SEQ * (DM / 8), stride = (size_t)gridDim.x * NTHREADS;
    for (size_t ch0 = (size_t)blockIdx.x * NTHREADS + threadIdx.x; ch0 < nchunk; ch0 += 4 * stride) {
        u32x4 a[4], b[4], u[4];
#pragma unroll
        for (int j = 0; j < 4; ++j) { const size_t ch = ch0 + j * stride; if (ch < nchunk) { const int row = (int)(ch >> 9), col = (int)(ch & 511) * 8;
            a[j] = *(const u32x4*)(YF + (size_t)row * DM + col); b[j] = *(const u32x4*)(YB + (size_t)row * DM + col); u[j] = *(const u32x4*)(P + (size_t)row * S5_INW + col); } }
#pragma unroll
        for (int j = 0; j < 4; ++j) { const size_t ch = ch0 + j * stride; if (ch < nchunk) { const int row = (int)(ch >> 9), col = (int)(ch & 511) * 8;
            const f32x4 d0 = *(const LAS f32x4*)(dsk + col), d1 = *(const LAS f32x4*)(dsk + col + 4);
            float v[8];
            v[0] = bf_lo(a[j].x) + bf_lo(b[j].x) + d0[0] * bf_lo(u[j].x); v[1] = bf_hi(a[j].x) + bf_hi(b[j].x) + d0[1] * bf_hi(u[j].x);
            v[2] = bf_lo(a[j].y) + bf_lo(b[j].y) + d0[2] * bf_lo(u[j].y); v[3] = bf_hi(a[j].y) + bf_hi(b[j].y) + d0[3] * bf_hi(u[j].y);
            v[4] = bf_lo(a[j].z) + bf_lo(b[j].z) + d1[0] * bf_lo(u[j].z); v[5] = bf_hi(a[j].z) + bf_hi(b[j].z) + d1[1] * bf_hi(u[j].z);
            v[6] = bf_lo(a[j].w) + bf_lo(b[j].w) + d1[2] * bf_lo(u[j].w); v[7] = bf_hi(a[j].w) + bf_hi(b[j].w) + d1[3] * bf_hi(u[j].w);
#pragma unroll
            for (int k = 0; k < 8; ++k) { const float x = v[k], zz = 0.7978845608028654f * (x + 0.044715f * x * x * x); const float t = 1.0f - 2.0f * __builtin_amdgcn_rcpf(__expf(2.0f * zz) + 1.0f); v[k] = 0.5f * x * (1.0f + t); }
            u32x4 w; w.x = cvt_pk_bf16(v[0], v[1]); w.y = cvt_pk_bf16(v[2], v[3]); w.z = cvt_pk_bf16(v[4], v[5]); w.w = cvt_pk_bf16(v[6], v[7]);
            *(u32x4*)(A2 + (size_t)row * DM + col) = w; } }
    }
}

constexpr int N_PHASES = 21;
typedef const __attribute__((address_space(4))) Params* KParamsPtr;
__global__ void __launch_bounds__(NTHREADS, 2) mega_fwd(Params p) {
    extern __shared__ __attribute__((aligned(16))) unsigned char lds_raw[];
    LAS unsigned char* L = (LAS unsigned char*)lds_raw;
    const int tid = threadIdx.x;
    if (tid < 4) ((LAS unsigned*)(L + MISC_OFF))[tid] = 0u;
    __syncthreads();
    const int lo = p.ph_lo, hi = p.ph_hi;
    XcdBarrier bar; bar.bar = (unsigned*)(p.ws + WS_CTL); bar.x = 0; bar.st = (volatile LAS unsigned*)(L + MISC_OFF);
    if (hi - lo > 1) bar = xcd_barrier_post((unsigned*)(p.ws + WS_CTL), (volatile LAS unsigned*)(L + MISC_OFF));
#ifndef PH_MASK
#define PH_MASK 0x1fffff
#endif
#define IN(k) (((PH_MASK >> (k)) & 1) && lo <= (k) && (k) < hi)
#define SEAM(k) do { if (IN((k) + 1)) xcd_barrier(bar); } while (0)
#ifndef REP_MASK
#define REP_MASK 0
#endif
#define REP(k) (((REP_MASK) >> (k)) & 1)
#define PHASE(k, ...) if (IN(k)) { _Pragma("nounroll") for (int rep_ = 0; rep_ <= REP(k); ++rep_) { { LOADP(); __VA_ARGS__ } if (rep_ < REP(k)) xcd_barrier(bar); } SEAM(k); }
    const int GR = gridDim.x, BX = blockIdx.x;
#define LOADP() Params lp; { KParamsPtr q_ = (KParamsPtr)__builtin_amdgcn_kernarg_segment_ptr(); asm volatile("" : "+s"(q_)); __builtin_memcpy(&lp, q_, sizeof(Params)); } \
    const float* mod = (const float*)(lp.ws + WS_MOD); const bf16_t* Wb = (const bf16_t*)(lp.ws + WS_W); float* X = (float*)(lp.ws + WS_X); \
    bf16_t* H = (bf16_t*)(lp.ws + WS_H); bf16_t* Pb = (bf16_t*)(lp.ws + WS_P); bf16_t* G = (bf16_t*)(lp.ws + WS_G); \
    const float* ropeA = (const float*)(lp.ws + WS_ROPEA); const float* ropeB = (const float*)(lp.ws + WS_ROPEB); \
    (void)mod; (void)Wb; (void)X; (void)H; (void)Pb; (void)G; (void)ropeA; (void)ropeB;
#define DYN_ORDER(S_, MM, NN, GIDX) pg8::DynOrder S_; S_.init((MM), (NN), (unsigned*)(lp.ws + WS_CTL + 16384 + (GIDX) * 2048), (volatile LAS int*)(L + 131072), (int)xb_xcc_id()); S_.prime()
#define RUN_IN(WOFF, NN, EPI, GIDX) do { pg8::Gemm g_{H, Wb + (WOFF), MROWS, (NN), DM}; DYN_ORDER(S_, MROWS, (NN), (GIDX)); \
        pg8::gemm_phase<decltype(EPI), pg8::DynOrder, true, true>(L, g_, S_, EPI); } while (0)
#define RUN_OUT(LAYER, WOFF, KK, CTX) do { pg8::Gemm g_{G, Wb + (WOFF), SEQ, DM, (KK)}; \
        pg8::EpiOut E_{H, DM, (float*)(lp.ws + WS_YS)}; \
        pg8::DynOrder S_; S_.init(SEQ, DM, (unsigned*)(lp.ws + WS_CTL + 16384 + (4 + (LAYER)) * 2048), (volatile LAS int*)(L + 131072), (int)xb_xcc_id(), (CTX) ? 16 : 0, SEQ / 256, (KK) / 64 / 16); S_.prime(); \
        pg8::gemm_phase<pg8::EpiOut, pg8::DynOrder, true, true>(L, g_, S_, E_); } while (0)

    PHASE(0, p0_prologue(L, lp);)
    PHASE(1, p1_modulate(L, lp);)
    PHASE(2, pg8::EpiIn<0> E{Pb, WA_INW, ropeA, ropeB, SEQ}; RUN_IN(W_WA_IN, WA_INW, E, 0); cvt_tail(L, lp, 0);)
    PHASE(3, mixerA_phase(lds_raw, lp);)
    PHASE(4, RUN_OUT(0, W_WA_OUT, 4096, true);)
    PHASE(5, ln_phase(L, lp, 0, MROWS, X, true, true);)
    PHASE(6, pg8::EpiIn<1> E{Pb, RT_INW, ropeA, ropeB, SEQ}; RUN_IN(W_RT_IN, RT_INW, E, 1); cvt_tail(L, lp, 1);)
    PHASE(7, retatt_phase(L, lp); xcd_barrier(bar); retention_phase(L, lp);)
    PHASE(8, retnorm_phase(lp);)
    PHASE(9, RUN_OUT(1, W_RT_OUT, 8192, true);)
    PHASE(10, ln_phase(L, lp, 1, MROWS, X, true, true);)
    PHASE(11, pg8::EpiIn<2> E{Pb, NA_INW, ropeA, ropeB, SEQ}; RUN_IN(W_NA_IN, NA_INW, E, 2); cvt_tail(L, lp, 2);)
    PHASE(12, mixerC_phase(lds_raw, lp);)
    PHASE(13, RUN_OUT(2, W_NA_OUT, 4096, true);)
    PHASE(14, ln_phase(L, lp, 2, MROWS, X, true, true);)
    PHASE(15, pg8::EpiIn<3> E{Pb, S5_INW, ropeA, ropeB, SEQ};
        { EpiCPlain EC_{Pb + (size_t)SEQ * S5_INW, S5_INW}; for (int it_ = BX; it_ < 256; it_ += GR) ctx_gemm64(L, H + (size_t)SEQ * DM, Wb + W_S5_IN, DM, it_, EC_); }
        { pg8::Gemm g_{H, Wb + W_S5_IN, SEQ, S5_INW, DM}; DYN_ORDER(S_, SEQ, S5_INW, 3); pg8::gemm_phase<pg8::EpiIn<3>, pg8::DynOrder, true, true>(L, g_, S_, E); })
    PHASE(16, s5_scan_phase(L, lp);)
    PHASE(17, s5_prep_phase(L, lp);)
    PHASE(18, const bf16_t* A2 = (const bf16_t*)(lp.ws + WS_OB);
        pg8::Gemm g_{A2, Wb + W_S5_GLU, SEQ, DM, DM}; DYN_ORDER(S_, SEQ, DM, 8);
        pg8::EpiGlu E{A2, DM, Pb, S5_INW, 4096, lp.in[I_S5_BGLU], G, DM};
        pg8::gemm_phase<pg8::EpiGlu, pg8::DynOrder, true, true>(L, g_, S_, E);)
    PHASE(19, RUN_OUT(3, W_S5_OUT, 4096, false);)
    PHASE(20, ln_phase(L, lp, 3, SEQ, lp.out, false, false);)
#undef IN
#undef SEAM
#undef RUN_IN
#undef RUN_OUT
#undef DYN_ORDER
#undef LOADP
}

#ifdef DUMP_PH
__global__ void dump_x(const float* X, float* out, size_t n) { for (size_t i = (size_t)blockIdx.x * blockDim.x + threadIdx.x; i < n; i += (size_t)gridDim.x * blockDim.x) out[i] = X[i]; }
__global__ void dump_b(const bf16_t* X, float* out, size_t n) { for (size_t i = (size_t)blockIdx.x * blockDim.x + threadIdx.x; i < n; i += (size_t)gridDim.x * blockDim.x) out[i] = bf2f(X[i]); }
#ifndef DUMP_OFF
#define DUMP_OFF WS_X
#endif
#ifndef DUMP_BF
#define DUMP_BF 0
#endif
#endif
#ifndef MK_N_LAUNCHES
#define MK_N_LAUNCHES 1
#endif
extern "C" void kernel_launch(void* const* d_in, const int* in_sizes, int n_in, void* d_out, int out_size, void* d_ws, size_t ws_size, hipStream_t stream) {
    static int grid = 0;
    if (grid == 0) {
        if (n_in != 29 || out_size != SEQ * DM || ws_size < WS_END) { fprintf(stderr, "kernel_launch: unexpected shapes: n_in %d out %d ws %zu (need %zu)\n", n_in, out_size, ws_size, (size_t)WS_END); grid = -1; return; }
        int dev = 0, cus = 0, per_cu = 0;
        if (hipGetDevice(&dev) != hipSuccess || hipDeviceGetAttribute(&cus, hipDeviceAttributeMultiprocessorCount, dev) != hipSuccess) { grid = -1; return; }
        if (hipFuncSetAttribute((const void*)mega_fwd, hipFuncAttributeMaxDynamicSharedMemorySize, LDS_BYTES) != hipSuccess) { fprintf(stderr, "kernel_launch: hipFuncSetAttribute failed\n"); grid = -1; return; }
        if (hipOccupancyMaxActiveBlocksPerMultiprocessor(&per_cu, (const void*)mega_fwd, NTHREADS, LDS_BYTES) != hipSuccess || per_cu < 1) { fprintf(stderr, "kernel_launch: occupancy query reports %d\n", per_cu); per_cu = 1; }
        (void)hipGetLastError();
        grid = cus;
    }
    if (grid < 0) return;
    if (hipMemsetAsync((char*)d_ws + WS_CTL, 0, 65536, stream) != hipSuccess) return;
    Params a{};
    for (int i = 0; i < 29; ++i) a.in[i] = (const float*)d_in[i];
    a.out = (float*)d_out; a.ws = (unsigned char*)d_ws;
    if (MK_N_LAUNCHES == 1) { a.ph_lo = 0; a.ph_hi = N_PHASES; hipLaunchKernelGGL(mega_fwd, dim3(grid), dim3(NTHREADS), LDS_BYTES, stream, a); }
#ifdef DUMP_PH
    else { for (int ph = 0; ph < DUMP_PH; ++ph) { a.ph_lo = ph; a.ph_hi = ph + 1; hipLaunchKernelGGL(mega_fwd, dim3(grid), dim3(NTHREADS), LDS_BYTES, stream, a); }
           if (DUMP_BF) hipLaunchKernelGGL(dump_b, dim3(2048), dim3(256), 0, stream, (const bf16_t*)((char*)d_ws + DUMP_OFF), (float*)d_out, (size_t)SEQ * DM);
           else hipLaunchKernelGGL(dump_x, dim3(2048), dim3(256), 0, stream, (const float*)((char*)d_ws + DUMP_OFF), (float*)d_out, (size_t)SEQ * DM); }
#else
    else for (int ph = 0; ph < N_PHASES; ++ph) { a.ph_lo = ph; a.ph_hi = ph + 1; hipLaunchKernelGGL(mega_fwd, dim3(grid), dim3(NTHREADS), LDS_BYTES, stream, a); }
#endif
    const hipError_t le = hipPeekAtLastError();
    if (le != hipSuccess) fprintf(stderr, "kernel_launch: launch failed: %s\n", hipGetErrorName(le));
}
```

```cpp
#include <hip/hip_runtime.h>
#include <cstdio>
#include <cstdint>
#include <cmath>

#define LAS __attribute__((address_space(3)))
typedef unsigned short bf16_t;
typedef short bf16x8 __attribute__((ext_vector_type(8)));
typedef short s16x4 __attribute__((ext_vector_type(4)));
typedef float f32x2 __attribute__((ext_vector_type(2)));
typedef float f32x4 __attribute__((ext_vector_type(4)));
typedef float f32x16 __attribute__((ext_vector_type(16)));
typedef unsigned u32x2 __attribute__((ext_vector_type(2)));
typedef unsigned u32x4 __attribute__((ext_vector_type(4)));

constexpr int DM = 4096, SEQ = 16384, NCTX = 256, MROWS = SEQ + NCTX;
constexpr int WA_INW = 10240, RT_INW = 24576, NA_INW = 16384, S5_INW = 8192;
constexpr float DN_ALPHA = 1.6817928305074292f;
constexpr float LN_EPS = 1e-6f;
constexpr float L2E = 1.4426950408889634f;
constexpr int NTHREADS = 512;
constexpr int LDS_BYTES = 163840;
constexpr int MISC_OFF = 163824;

constexpr size_t WS_CTL = 0;
constexpr size_t WS_MOD = 65536;
constexpr size_t WS_ROPEA = WS_MOD + 4ull * 2 * 3 * DM * 4;
constexpr size_t WS_ROPEB = WS_ROPEA + 320ull * 32 * 8;
constexpr size_t WS_W = WS_ROPEB + 16384ull * 128 * 8;
constexpr size_t W_WA_IN = 0, W_WA_OUT = W_WA_IN + 10240ull * 4096, W_RT_IN = W_WA_OUT + 4096ull * 4096, W_RT_OUT = W_RT_IN + 24576ull * 4096,
                 W_NA_IN = W_RT_OUT + 4096ull * 8192, W_NA_OUT = W_NA_IN + 16384ull * 4096, W_S5_IN = W_NA_OUT + 4096ull * 4096,
                 W_S5_GLU = W_S5_IN + 8192ull * 4096, W_S5_OUT = W_S5_GLU + 4096ull * 4096, W_END = W_S5_OUT + 4096ull * 4096;
constexpr size_t WS_X = WS_W + W_END * 2;
constexpr size_t WS_H = WS_X + (size_t)MROWS * DM * 4;
constexpr size_t WS_P = WS_H + (size_t)MROWS * DM * 2;
constexpr size_t WS_G = WS_P + (size_t)MROWS * 24576 * 2;
constexpr size_t WS_OF = WS_G + (size_t)MROWS * 8192 * 2;
constexpr size_t WS_OB = WS_OF + (size_t)MROWS * 8192 * 2;
constexpr size_t WS_YS = WS_OB + (size_t)MROWS * 8192 * 2;
constexpr size_t WS_END = WS_YS + 16ull * 256 * DM * 4;

typedef __bf16 bf16v2_t __attribute__((ext_vector_type(2)));
__device__ __forceinline__ unsigned cvt_pk_bf16(float lo, float hi) { bf16v2_t v; v[0] = (__bf16)lo; v[1] = (__bf16)hi; return __builtin_bit_cast(unsigned, v); }
__device__ __forceinline__ float bf_lo(unsigned w) { return __uint_as_float(w << 16); }
__device__ __forceinline__ float bf_hi(unsigned w) { return __uint_as_float(w & 0xffff0000u); }
__device__ __forceinline__ float bf2f(bf16_t b) { return __uint_as_float(((unsigned)b) << 16); }
__device__ __forceinline__ bf16_t f2bf(float f) { return (bf16_t)(cvt_pk_bf16(f, 0.f) & 0xffffu); }
__device__ __forceinline__ float silu_f(float v) { return v * __builtin_amdgcn_rcpf(1.0f + __expf(-v)); }
__device__ __forceinline__ float sigmoid_f(float v) { return __builtin_amdgcn_rcpf(1.0f + __expf(-v)); }

#define XB_TMO      128
#define XB_XCNT(j)  (256  + 64 * (j))
#define XB_XSUB(j)  (1280 + 64 * (j))
#define XB_XGEN(j)  (2304 + 64 * (j))
#define XB_TOP      3328
#define XB_TOPGEN   3392
#define XCD_BAR_WORDS 3456
#define XB_SPIN_CAP (1u << 18)
#define LAS __attribute__((address_space(3)))

__device__ __forceinline__ unsigned xb_ld(unsigned* p)              { return __hip_atomic_load(p, __ATOMIC_RELAXED, __HIP_MEMORY_SCOPE_AGENT); }
__device__ __forceinline__ unsigned xb_add(unsigned* p, unsigned v) { return __hip_atomic_fetch_add(p, v, __ATOMIC_RELAXED, __HIP_MEMORY_SCOPE_AGENT); }
__device__ __forceinline__ unsigned xb_xcc_id() { return (unsigned)__builtin_amdgcn_s_getreg((3 << 11) | 20) & 0xFu; }
#define XB_SPIN(cond, bar) do { unsigned _sp = 0; while (cond) { __builtin_amdgcn_s_sleep(1); \
    if ((++_sp & 255u) == 0u) { if (xb_ld(&(bar)[XB_TMO])) break; if (_sp > XB_SPIN_CAP) { atomicAdd(&(bar)[XB_TMO], 1u); break; } } } } while (0)

struct XcdBarrier {
    unsigned* bar; unsigned x;
    volatile LAS unsigned* st;
};

__device__ __forceinline__ XcdBarrier xcd_barrier_post(unsigned* bar, volatile LAS unsigned* st) {
    XcdBarrier b; b.bar = bar; b.x = xb_xcc_id(); b.st = st;
    if (threadIdx.x == 0) (void)xb_add(&bar[XB_XCNT(b.x)], 1u);
    return b;
}
__device__ __forceinline__ void xcd_barrier_complete(unsigned* bar, unsigned x, unsigned& nloc, unsigned& nx) {
    const unsigned G = gridDim.x * gridDim.y * gridDim.z;
    unsigned sum, cnt, mine, sp = 0u;
    for (;;) {
        sum = 0u; cnt = 0u; mine = 0u;
#pragma unroll
        for (unsigned j = 0; j < 16; ++j) { const unsigned c = xb_ld(&bar[XB_XCNT(j)]); sum += c; cnt += (c > 0u) ? 1u : 0u; mine = (j == x) ? c : mine; }
        if (sum == G) break;
        __builtin_amdgcn_s_sleep(1);
        if ((++sp & 255u) == 0u) { if (xb_ld(&bar[XB_TMO])) break; if (sp > XB_SPIN_CAP) { atomicAdd(&bar[XB_TMO], 1u); break; } }
    }
    nloc = mine > 0u ? mine : 1u; nx = cnt > 0u ? cnt : 1u;
}

__device__ __forceinline__ void xcd_barrier(const XcdBarrier& b) {
    asm volatile("s_waitcnt vmcnt(0)" ::: "memory");
    __syncthreads();
    if (threadIdx.x == 0) {
        unsigned* bar = b.bar;
        __builtin_amdgcn_s_waitcnt(0);
        unsigned nloc = b.st[0], nx = b.st[1];
        if (nloc == 0u) { xcd_barrier_complete(bar, b.x, nloc, nx); b.st[0] = nloc; b.st[1] = nx; }
        const unsigned old = xb_add(&bar[XB_XSUB(b.x)], 1u);
        const unsigned gen = old / nloc;
        if (old + 1u == (gen + 1u) * nloc) {
            __builtin_amdgcn_fence(__ATOMIC_RELEASE, "agent");
            asm volatile("s_waitcnt vmcnt(0)" ::: "memory");
            const unsigned og = xb_add(&bar[XB_TOP], 1u);
            const unsigned tg = og / nx;
            if (og + 1u == (tg + 1u) * nx) xb_add(&bar[XB_TOPGEN], 1u);
            else XB_SPIN(xb_ld(&bar[XB_TOPGEN]) == tg, bar);
            __builtin_amdgcn_fence(__ATOMIC_ACQUIRE, "agent");
            xb_add(&bar[XB_XGEN(b.x)], 1u);
            asm volatile("s_waitcnt vmcnt(0)" ::: "memory");
        } else {
            XB_SPIN(xb_ld(&bar[XB_XGEN(b.x)]) == gen, bar);
            __builtin_amdgcn_fence(__ATOMIC_ACQUIRE, "agent");
            asm volatile("s_waitcnt vmcnt(0)" ::: "memory");
        }
    }
    __syncthreads();
}

namespace pg8 {
#define PG8_LAS __attribute__((address_space(3)))
typedef unsigned short bf16_t;
typedef short bf16x8 __attribute__((ext_vector_type(8)));
typedef float f32x4 __attribute__((ext_vector_type(4)));
typedef unsigned u32x4 __attribute__((ext_vector_type(4)));
constexpr int BM = 256, BK = 64, HALF = 128, HTB = HALF * BK * 2  , STAGE_BYTES = 8 * HTB, NXCD = 8, WGM = 8;

__host__ __device__ __forceinline__ int lds_byte(int r, int c) { const int st = (r >> 4) * 2 + (c >> 5), rr = r & 15, cc = c & 31, ob = rr * 64 + cc * 2; return st * 1024 + (ob ^ (((ob >> 9) & 1) << 5)); }
__host__ __device__ __forceinline__ void stage_rc(int b, int& R, int& C) { const int st = b / 1024, sb = b % 1024, swz = sb ^ (((sb >> 9) & 1) << 5); R = (st >> 1) * 16 + swz / 64; C = (st & 1) * 32 + (swz % 64) / 2; }
__host__ __device__ __forceinline__ int perm32(int rho) { const int n = rho >> 4, i = rho & 15; return 8 * (i >> 2) + 4 * n + (i & 3); }

struct Unit { int pm, pn, koff, nkt, ks; };
struct Gemm { const bf16_t* A; const bf16_t* Bt; int M, N, K; };

struct StaticOrder {
    int nM, nN, nwg, G, c;
    __host__ __device__ void init(int M, int N, int G_, int c_) { nM = M / BM; nN = N / BM; nwg = nM * nN; G = G_; c = c_; }
    __host__ __device__ bool next(int i, Unit& u) const {
        const long L = (long)i * G + c; if (L >= nwg) return false;
        int wgid = (int)L; { const int q = nwg / NXCD, r = nwg % NXCD, xcd = wgid % NXCD, off = wgid / NXCD; wgid = (xcd < r ? xcd * (q + 1) : r * (q + 1) + (xcd - r) * q) + off; }
        const int nig = WGM * nN, gid = wgid / nig, fm = gid * WGM, gsz = (nM - fm) < WGM ? (nM - fm) : WGM;
        u.pm = fm + ((wgid % nig) % gsz); u.pn = (wgid % nig) / gsz; u.koff = 0; u.nkt = 0; u.ks = -1; return true;
    }
    __device__ __forceinline__ void a_ready(const Unit&) const {}
    __device__ __forceinline__ void done(const Unit&) const {}
};

struct DynOrder {
    int nM, nN, nwg, q, xcd;
    int qm, nks, pm_sub, sub_nkt;
    unsigned* ctr;
    volatile PG8_LAS int* slots;
    mutable int nf;
    __device__ void init(int M, int N, unsigned* ctr_, volatile PG8_LAS int* slots_, int xcd_, int nks_ = 0, int pm_sub_ = 0, int sub_nkt_ = 0) {
        nM = M / BM; nN = N / BM; nwg = nM * nN; qm = nwg / NXCD; nks = nks_; pm_sub = pm_sub_; sub_nkt = sub_nkt_; q = qm + (nN * nks_) / NXCD; ctr = ctr_; slots = slots_; xcd = xcd_ & 7; nf = 0; }
    __device__ __forceinline__ int fetch() const {
        for (int a = 0; a < NXCD; ++a) { const int x = (xcd + a) & 7;
            const unsigned k = __hip_atomic_fetch_add(ctr + 64 * x, 1u, __ATOMIC_RELAXED, __HIP_MEMORY_SCOPE_AGENT);
            if (k < (unsigned)qm) return x * qm + (int)k;
            if (k < (unsigned)q) return nwg + x * (q - qm) + (int)k - qm; }
        return -1;
    }
    __device__ __forceinline__ void prime() const { if (threadIdx.x == 0) { slots[0] = fetch(); slots[1] = fetch(); slots[2] = fetch(); } nf = 3; __syncthreads(); }
    __device__ __forceinline__ bool next(int i, Unit& u) const {
        const int wgid = __builtin_amdgcn_readfirstlane(slots[i & 3]);
        const bool sub = wgid >= nwg;
        const int s = sub ? wgid - nwg : 0, nk1 = nks > 0 ? nks : 1, spn = s / nk1, sks = s - spn * nk1;
        const int wm = (wgid < 0 || sub) ? 0 : wgid;
        const int x = wm / qm, k = wm - x * qm, full = WGM * nN, kk = k - full;
        Unit r;
        r.pm = sub ? pm_sub : (k < full ? WGM * x + (k % WGM) : NXCD * WGM); r.pn = sub ? spn : (k < full ? k / WGM : x * (qm - full) + kk);
        r.ks = sub ? sks : -1; r.nkt = sub ? sub_nkt : 0; r.koff = sub ? sks * sub_nkt * BK * 2 : 0;
        u = r;
        return wgid >= 0;
    }
    __device__ __forceinline__ void a_ready(const Unit&) const {}
    __device__ __forceinline__ void done(const Unit&) const { if (threadIdx.x == 0) slots[nf & 3] = fetch(); ++nf; }
};

typedef __bf16 bf16v2_t __attribute__((ext_vector_type(2)));
__device__ __forceinline__ unsigned cvt_pk_bf16(float lo, float hi) { bf16v2_t v; v[0] = (__bf16)lo; v[1] = (__bf16)hi; return __builtin_bit_cast(unsigned, v); }
__device__ __forceinline__ float e_silu(float v) { return v * __builtin_amdgcn_rcpf(1.0f + __expf(-v)); }

template <int LT> struct EpiIn {
    static constexpr bool PERM = true, AFTER_DRAIN = false;
    static constexpr int c1 = LT == 0 ? 1024 : LT == 1 ? 4096 : LT == 2 ? 8192 : 4096, c2 = LT == 0 ? 2048 : LT == 1 ? 12288 : LT == 2 ? 12288 : 8192, c3 = LT == 0 ? 6144 : LT == 1 ? 16384 : LT == 2 ? 12288 : 8192;
    static constexpr int m0 = LT == 0 ? 2 : LT == 1 ? 3 : 0, m1 = LT == 3 ? 1 : 0, m2 = LT == 0 ? 2 : LT == 1 ? 3 : LT == 2 ? 0 : 1, m3 = LT == 1 ? 0 : 1;
    bf16_t* O; int ldc;
    const float* ropeA; const float* ropeB;
    int seq_rows;
    __device__ __forceinline__ void operator()(const f32x4 (&acc)[2][2][4][2], const Unit& u, int wr, int wc, int fr, int fq) const {
        const int colt = u.pn * BM;
        int mode; float scl;
        if (colt < c1) { mode = m0; scl = (LT == 1) ? 0.0625f : 1.0f; } else if (colt < c2) { mode = m1; scl = (LT == 2) ? 0.08838834764831845f : 1.0f; }
        else if (colt < c3) { mode = m2; scl = (LT == 0) ? 0.08838834764831845f : 1.0f; } else { mode = m3; scl = 1.0f; }
        if (u.pm * BM >= seq_rows && mode >= 2) mode = 0;
        const int row0 = u.pm * BM + wr * 64 + fr, col0 = colt + wc * 32 + 8 * fq;
        if (mode >= 2) {
            f32x4 cs[2][2][2];
#define RP_ISSUE(b_) do { const int bj_ = (b_) >> 2, ai_ = ((b_) >> 1) & 1, mp_ = (b_) & 1; \
            _Pragma("unroll") for (int r_ = 0; r_ < 2; ++r_) { const int row_ = row0 + ai_ * HALF + (2 * mp_ + r_) * 16, col_ = col0 + bj_ * HALF; const float* tb_; \
                if (mode == 2) { const int jj0_ = (col_ & 127) >> 1; const int idx_ = (jj0_ < 32) ? (row_ >> 6) : 256 + (row_ & 63); tb_ = ropeA + ((size_t)idx_ * 32 + (jj0_ & 31)) * 2; } \
                else           { const int jj0_ = (col_ & 255) >> 1; tb_ = ropeB + ((size_t)row_ * 128 + jj0_) * 2; } \
                cs[(b_) & 1][r_][0] = *(const f32x4*)tb_; cs[(b_) & 1][r_][1] = *(const f32x4*)(tb_ + 4); } } while (0)
            RP_ISSUE(0);
#pragma unroll
            for (int b = 0; b < 8; ++b) {
                const int bj = b >> 2, ai = (b >> 1) & 1, mp = b & 1;
                if (b + 1 < 8) RP_ISSUE(b + 1);
#pragma unroll
                for (int r = 0; r < 2; ++r) {
                    const int m = 2 * mp + r, row = row0 + ai * HALF + m * 16;
                    const f32x4 v0 = acc[ai][bj][m][0], v1 = acc[ai][bj][m][1], cs0 = cs[b & 1][r][0], cs1 = cs[b & 1][r][1];
                    f32x4 w0, w1;
                    w0[0] = v0[0] * cs0[0] - v0[1] * cs0[1]; w0[1] = v0[1] * cs0[0] + v0[0] * cs0[1];
                    w0[2] = v0[2] * cs0[2] - v0[3] * cs0[3]; w0[3] = v0[3] * cs0[2] + v0[2] * cs0[3];
                    w1[0] = v1[0] * cs1[0] - v1[1] * cs1[1]; w1[1] = v1[1] * cs1[0] + v1[0] * cs1[1];
                    w1[2] = v1[2] * cs1[2] - v1[3] * cs1[3]; w1[3] = v1[3] * cs1[2] + v1[2] * cs1[3];
                    w0 *= scl; w1 *= scl;
                    u32x4 w; w.x = cvt_pk_bf16(w0[0], w0[1]); w.y = cvt_pk_bf16(w0[2], w0[3]); w.z = cvt_pk_bf16(w1[0], w1[1]); w.w = cvt_pk_bf16(w1[2], w1[3]);
                    *(u32x4*)(O + (size_t)row * ldc + col0 + bj * HALF) = w;
                }
            }
#undef RP_ISSUE
            return;
        }
#pragma unroll
        for (int ai = 0; ai < 2; ++ai)
#pragma unroll
            for (int m = 0; m < 4; ++m) {
                const int row = row0 + ai * HALF + m * 16;
                bf16_t* rowp = O + (size_t)row * ldc + col0;
#pragma unroll
                for (int bj = 0; bj < 2; ++bj) {
                    f32x4 v0 = acc[ai][bj][m][0], v1 = acc[ai][bj][m][1];
                    const int col = col0 + bj * HALF;
                    if (mode == 1) {
#pragma unroll
                        for (int j = 0; j < 4; ++j) { v0[j] = e_silu(v0[j]); v1[j] = e_silu(v1[j]); }
                    } else { v0 *= scl; v1 *= scl; }
                    u32x4 w; w.x = cvt_pk_bf16(v0[0], v0[1]); w.y = cvt_pk_bf16(v0[2], v0[3]); w.z = cvt_pk_bf16(v1[0], v1[1]); w.w = cvt_pk_bf16(v1[2], v1[3]);
                    *(u32x4*)(rowp + bj * HALF) = w;
                }
            }
    }
};

struct EpiOut {
    static constexpr bool PERM = true, AFTER_DRAIN = false;
    bf16_t* Y; int ldc;
    float* slab;
    __device__ __forceinline__ void operator()(const f32x4 (&acc)[2][2][4][2], const Unit& u, int wr, int wc, int fr, int fq) const {
        const int col0 = u.pn * BM + wc * 32 + 8 * fq;
        if (u.ks >= 0) {
            float* sp = slab + (size_t)u.ks * 256 * ldc + col0;
#pragma unroll
            for (int ai = 0; ai < 2; ++ai)
#pragma unroll
                for (int m = 0; m < 4; ++m) { float* rowp = sp + (size_t)(wr * 64 + fr + ai * HALF + m * 16) * ldc;
#pragma unroll
                    for (int bj = 0; bj < 2; ++bj) { *(f32x4*)(rowp + bj * HALF) = acc[ai][bj][m][0]; *(f32x4*)(rowp + bj * HALF + 4) = acc[ai][bj][m][1]; } }
            return;
        }
        const int row0 = u.pm * BM + wr * 64 + fr;
#pragma unroll
        for (int ai = 0; ai < 2; ++ai)
#pragma unroll
            for (int m = 0; m < 4; ++m) {
                bf16_t* rowp = Y + (size_t)(row0 + ai * HALF + m * 16) * ldc + col0;
#pragma unroll
                for (int bj = 0; bj < 2; ++bj) { const f32x4 v0 = acc[ai][bj][m][0], v1 = acc[ai][bj][m][1];
                    u32x4 w; w.x = cvt_pk_bf16(v0[0], v0[1]); w.y = cvt_pk_bf16(v0[2], v0[3]); w.z = cvt_pk_bf16(v1[0], v1[1]); w.w = cvt_pk_bf16(v1[2], v1[3]);
                    *(u32x4*)(rowp + bj * HALF) = w; }
            }
    }
};

struct EpiGlu {
    static constexpr bool PERM = true, AFTER_DRAIN = false;
    const bf16_t* A2; int lda; const bf16_t* P; int ldp; int szcol; const float* bglu; bf16_t* G; int ldg;
    __device__ __forceinline__ void operator()(const f32x4 (&acc)[2][2][4][2], const Unit& u, int wr, int wc, int fr, int fq) const {
        const int row0 = u.pm * BM + wr * 64 + fr, col0 = u.pn * BM + wc * 32 + 8 * fq;
        u32x4 av[2][2], zv[2][2];
#define GLU_ISSUE(b_) do { const int bj_ = (b_) >> 2, ai_ = ((b_) >> 1) & 1, mp_ = (b_) & 1; \
            _Pragma("unroll") for (int r_ = 0; r_ < 2; ++r_) { const int row_ = row0 + ai_ * HALF + (2 * mp_ + r_) * 16, col_ = col0 + bj_ * HALF; \
                av[(b_) & 1][r_] = *(const u32x4*)(A2 + (size_t)row_ * lda + col_); zv[(b_) & 1][r_] = *(const u32x4*)(P + (size_t)row_ * ldp + szcol + col_); } } while (0)
        f32x4 bb[2][2];
#pragma unroll
        for (int bj = 0; bj < 2; ++bj) { bb[bj][0] = *(const f32x4*)(bglu + col0 + bj * HALF); bb[bj][1] = *(const f32x4*)(bglu + col0 + bj * HALF + 4); }
        GLU_ISSUE(0);
#pragma unroll
        for (int bj = 0; bj < 2; ++bj) asm volatile("" : "+v"(bb[bj][0]), "+v"(bb[bj][1]));
#pragma unroll
        for (int b = 0; b < 8; ++b) {
            const int bj = b >> 2, ai = (b >> 1) & 1, mp = b & 1, col = col0 + bj * HALF;
            if (b + 1 < 8) GLU_ISSUE(b + 1);
            const f32x4 b0 = bb[bj][0], b1 = bb[bj][1];
#pragma unroll
            for (int r = 0; r < 2; ++r) {
                const int m = 2 * mp + r, row = row0 + ai * HALF + m * 16;
                const u32x4 a = av[b & 1][r], z = zv[b & 1][r];
                const f32x4 t0 = acc[ai][bj][m][0] + b0, t1 = acc[ai][bj][m][1] + b1;
                float q[8];
                q[0] = __uint_as_float(a.x << 16) * __uint_as_float(z.x << 16) * __builtin_amdgcn_rcpf(1.0f + __expf(-t0[0]));
                q[1] = __uint_as_float(a.x & 0xffff0000u) * __uint_as_float(z.x & 0xffff0000u) * __builtin_amdgcn_rcpf(1.0f + __expf(-t0[1]));
                q[2] = __uint_as_float(a.y << 16) * __uint_as_float(z.y << 16) * __builtin_amdgcn_rcpf(1.0f + __expf(-t0[2]));
                q[3] = __uint_as_float(a.y & 0xffff0000u) * __uint_as_float(z.y & 0xffff0000u) * __builtin_amdgcn_rcpf(1.0f + __expf(-t0[3]));
                q[4] = __uint_as_float(a.z << 16) * __uint_as_float(z.z << 16) * __builtin_amdgcn_rcpf(1.0f + __expf(-t1[0]));
                q[5] = __uint_as_float(a.z & 0xffff0000u) * __uint_as_float(z.z & 0xffff0000u) * __builtin_amdgcn_rcpf(1.0f + __expf(-t1[1]));
                q[6] = __uint_as_float(a.w << 16) * __uint_as_float(z.w << 16) * __builtin_amdgcn_rcpf(1.0f + __expf(-t1[2]));
                q[7] = __uint_as_float(a.w & 0xffff0000u) * __uint_as_float(z.w & 0xffff0000u) * __builtin_amdgcn_rcpf(1.0f + __expf(-t1[3]));
                u32x4 w; w.x = cvt_pk_bf16(q[0], q[1]); w.y = cvt_pk_bf16(q[2], q[3]); w.z = cvt_pk_bf16(q[4], q[5]); w.w = cvt_pk_bf16(q[6], q[7]);
                *(u32x4*)(G + (size_t)row * ldg + col) = w;
            }
        }
#undef GLU_ISSUE
    }
};

template <class Epi, class Sched, bool ALIGN_EPI = false, bool SP2 = false>
__device__ __forceinline__ void gemm_phase(PG8_LAS unsigned char* lds, const Gemm g, const Sched& S, const Epi& E) {
    const int tid = threadIdx.x, wid = __builtin_amdgcn_readfirstlane(tid >> 6), lane = tid & 63, wr = wid >> 2, wc = wid & 3, fr = lane & 15, fq = lane >> 4;
    const int K = g.K, nt = K / BK;
    unsigned voffA[2], voffB[2];
#pragma unroll
    for (int i = 0; i < 2; ++i) { int R, C; stage_rc(tid * 16 + i * 8192, R, C); const int Rb = Epi::PERM ? ((R & ~31) + perm32(R & 31)) : R;
        voffA[i] = (unsigned)(R * K + C) * 2u; voffB[i] = (unsigned)(Rb * K + C) * 2u; }
    const size_t kstep = (size_t)(BK * 2);
    const size_t hstep = (size_t)HALF * K * 2;
    const size_t tstep = 2 * hstep;
    const unsigned ldsw = (unsigned)wid * 1024u;
    const int aoff = lds_byte(wr * 64 + fr, fq * 8), boff = lds_byte(wc * 32 + fr, fq * 8);
#define PG8_SA(b, h) (((b) * 2 + (h)) * HTB)
#define PG8_SB(b, h) ((4 + (b) * 2 + (h)) * HTB)
#define PG8_STAGE(bufoff, gbase, voff) do { _Pragma("unroll") for (int _i = 0; _i < 2; ++_i) \
        __builtin_amdgcn_global_load_lds((const unsigned*)((const char*)(gbase) + (voff)[_i]), (PG8_LAS unsigned*)(lds + (bufoff) + ldsw + _i * 8192), 16, 0, 0); } while (0)
#define PG8_LDA(dst, b, h) do { _Pragma("unroll") for (int m = 0; m < 4; ++m) _Pragma("unroll") for (int k = 0; k < 2; ++k) dst[m][k] = *(const PG8_LAS bf16x8*)(lds + PG8_SA(b, h) + aoff + m * 2048 + k * 1024); } while (0)
#define PG8_LDB(dst, b, h) do { _Pragma("unroll") for (int n = 0; n < 2; ++n) _Pragma("unroll") for (int k = 0; k < 2; ++k) dst[n][k] = *(const PG8_LAS bf16x8*)(lds + PG8_SB(b, h) + boff + n * 2048 + k * 1024); } while (0)
#define PG8_MMA(ai, bj, At, Bt) do { __builtin_amdgcn_s_setprio(1); _Pragma("unroll") for (int m = 0; m < 4; ++m) _Pragma("unroll") for (int n = 0; n < 2; ++n) _Pragma("unroll") for (int k = 0; k < 2; ++k) \
        acc[ai][bj][m][n] = __builtin_amdgcn_mfma_f32_16x16x32_bf16(Bt[n][k], At[m][k], acc[ai][bj][m][n], 0, 0, 0); __builtin_amdgcn_s_setprio(0); } while (0)
#define PG8_WAIT_V(n) asm volatile("s_waitcnt vmcnt(" #n ")" ::: "memory")
#define PG8_WAIT_L(n) asm volatile("s_waitcnt lgkmcnt(" #n ")" ::: "memory")
#define PG8_BAR __builtin_amdgcn_s_barrier()
#define PG8_SCHED __builtin_amdgcn_sched_barrier(0)
    Unit cur, nxt; int ui = 0;
    if (!S.next(0, cur)) return;
    f32x4 acc[2][2][4][2];
#pragma unroll
    for (int a = 0; a < 2; ++a)
#pragma unroll
        for (int b = 0; b < 2; ++b)
#pragma unroll
            for (int m = 0; m < 4; ++m)
#pragma unroll
                for (int n = 0; n < 2; ++n) acc[a][b][m][n] = (f32x4){0.f, 0.f, 0.f, 0.f};
    bf16x8 At[4][2], B0[2][2], B1[2][2];
    const char* cA = (const char*)g.A + (size_t)cur.pm * tstep + cur.koff; const char* cB = (const char*)g.Bt + (size_t)cur.pn * tstep + cur.koff;
    int ntc = cur.nkt ? cur.nkt : nt;
    S.a_ready(cur);
    if constexpr (SP2) {
        PG8_STAGE(PG8_SB(0, 0), cB, voffB); PG8_STAGE(PG8_SB(0, 1), cB + hstep, voffB); PG8_STAGE(PG8_SA(0, 0), cA, voffA); PG8_STAGE(PG8_SA(0, 1), cA + hstep, voffA);
        if (wr == 1) PG8_BAR;
        PG8_WAIT_V(2); PG8_BAR;
        PG8_STAGE(PG8_SB(1, 0), cB + kstep, voffB); PG8_STAGE(PG8_SA(1, 0), cA + kstep, voffA); PG8_STAGE(PG8_SB(1, 1), cB + hstep + kstep, voffB);
        PG8_WAIT_V(6); PG8_BAR;
    } else {
        PG8_STAGE(PG8_SB(0, 0), cB, voffB); PG8_STAGE(PG8_SA(0, 0), cA, voffA); PG8_STAGE(PG8_SB(0, 1), cB + hstep, voffB); PG8_STAGE(PG8_SA(0, 1), cA + hstep, voffA);
        if (wr == 1) PG8_BAR;
        PG8_WAIT_V(4); PG8_BAR;
        PG8_STAGE(PG8_SB(1, 0), cB + kstep, voffB); PG8_STAGE(PG8_SA(1, 0), cA + kstep, voffA); PG8_STAGE(PG8_SB(1, 1), cB + hstep + kstep, voffB);
        PG8_WAIT_V(6); PG8_BAR;
    }
    for (;;) {
        const bool has_next = S.next(ui + 1, nxt);
        const char* nA = has_next ? (const char*)g.A + (size_t)nxt.pm * tstep + nxt.koff : cA; const char* nB = has_next ? (const char*)g.Bt + (size_t)nxt.pn * tstep + nxt.koff : cB;
        for (int t = 0; t < ntc; t += 2) {
            const bool last = (t == ntc - 2);
            const char* a1 = cA + (size_t)(t + 1) * kstep;
            const char* a2 = last ? nA : cA + (size_t)(t + 2) * kstep; const char* b2 = last ? nB : cB + (size_t)(t + 2) * kstep;
            const char* a3 = a2 + kstep; const char* b3 = b2 + kstep;
            if (last && has_next) S.a_ready(nxt);
            if constexpr (SP2) {
            PG8_LDB(B0, 0, 0); PG8_LDB(B1, 0, 1); PG8_SCHED; PG8_LDA(At, 0, 0); PG8_STAGE(PG8_SA(1, 1), a1 + hstep, voffA);
            PG8_WAIT_V(8); PG8_WAIT_L(0); PG8_BAR; PG8_MMA(0, 0, At, B0); PG8_MMA(0, 1, At, B1); PG8_BAR; PG8_SCHED;
            PG8_LDA(At, 0, 1); PG8_STAGE(PG8_SB(0, 0), b2, voffB); PG8_STAGE(PG8_SB(0, 1), b2 + hstep, voffB); PG8_STAGE(PG8_SA(0, 0), a2, voffA);
            PG8_WAIT_V(8); PG8_WAIT_L(0); PG8_BAR; PG8_MMA(1, 0, At, B0); PG8_MMA(1, 1, At, B1); PG8_BAR; PG8_SCHED;
            PG8_LDB(B0, 1, 0); PG8_LDB(B1, 1, 1); PG8_SCHED; PG8_LDA(At, 1, 0); PG8_STAGE(PG8_SA(0, 1), a2 + hstep, voffA);
            PG8_WAIT_V(8); PG8_WAIT_L(0); PG8_BAR; PG8_MMA(0, 0, At, B0); PG8_MMA(0, 1, At, B1); PG8_BAR; PG8_SCHED;
            PG8_LDA(At, 1, 1); PG8_STAGE(PG8_SB(1, 0), b3, voffB); PG8_STAGE(PG8_SB(1, 1), b3 + hstep, voffB); PG8_STAGE(PG8_SA(1, 0), a3, voffA);
            PG8_WAIT_V(8); PG8_WAIT_L(0); PG8_BAR; PG8_MMA(1, 0, At, B0); PG8_MMA(1, 1, At, B1); PG8_BAR; PG8_SCHED;
            } else {
            PG8_LDB(B0, 0, 0); PG8_SCHED; PG8_LDA(At, 0, 0); PG8_STAGE(PG8_SA(1, 1), a1 + hstep, voffA);
            PG8_WAIT_L(8); PG8_BAR; PG8_WAIT_L(0); PG8_MMA(0, 0, At, B0); PG8_BAR; PG8_SCHED;
            PG8_LDB(B1, 0, 1); PG8_STAGE(PG8_SB(0, 0), b2, voffB);
            PG8_BAR; PG8_WAIT_L(0); PG8_MMA(0, 1, At, B1); PG8_BAR;
            PG8_LDA(At, 0, 1); PG8_STAGE(PG8_SA(0, 0), a2, voffA);
            PG8_BAR; PG8_WAIT_L(0); PG8_MMA(1, 0, At, B0); PG8_BAR; PG8_SCHED;
            PG8_STAGE(PG8_SB(0, 1), b2 + hstep, voffB);
            PG8_WAIT_V(6); PG8_BAR; PG8_MMA(1, 1, At, B1); PG8_BAR;
            PG8_LDB(B0, 1, 0); PG8_SCHED; PG8_LDA(At, 1, 0); PG8_STAGE(PG8_SA(0, 1), a2 + hstep, voffA);
            PG8_WAIT_L(8); PG8_BAR; PG8_WAIT_L(0); PG8_MMA(0, 0, At, B0); PG8_BAR; PG8_SCHED;
            PG8_LDB(B1, 1, 1); PG8_STAGE(PG8_SB(1, 0), b3, voffB);
            PG8_BAR; PG8_WAIT_L(0); PG8_MMA(0, 1, At, B1); PG8_BAR;
            PG8_LDA(At, 1, 1); PG8_STAGE(PG8_SA(1, 0), a3, voffA);
            PG8_BAR; PG8_WAIT_L(0); PG8_MMA(1, 0, At, B0); PG8_BAR; PG8_SCHED;
            PG8_STAGE(PG8_SB(1, 1), b3 + hstep, voffB);
            PG8_WAIT_V(6); PG8_BAR; PG8_MMA(1, 1, At, B1); PG8_BAR;
            }
        }
        if constexpr (ALIGN_EPI) { if (wr == 0) PG8_BAR; }
        if constexpr (!Epi::AFTER_DRAIN) { E(acc, cur, wr, wc, fr, fq); S.done(cur); }
        if (!has_next) break;
#pragma unroll
        for (int a = 0; a < 2; ++a)
#pragma unroll
            for (int b = 0; b < 2; ++b)
#pragma unroll
                for (int m = 0; m < 4; ++m)
#pragma unroll
                    for (int n = 0; n < 2; ++n) acc[a][b][m][n] = (f32x4){0.f, 0.f, 0.f, 0.f};
        cur = nxt; cA = nA; cB = nB; ++ui; ntc = cur.nkt ? cur.nkt : nt;
        if constexpr (ALIGN_EPI) { if (wr == 1) PG8_BAR; }
    }
    PG8_WAIT_V(0);
    if constexpr (!ALIGN_EPI) { if (wr == 0) PG8_BAR; }
    PG8_BAR;
    if constexpr (Epi::AFTER_DRAIN) { E.fused(acc, cur, wr, wc, fr, fq, lds, wid, lane); S.done(cur); }
#undef PG8_SA
#undef PG8_SB
#undef PG8_STAGE
#undef PG8_LDA
#undef PG8_LDB
#undef PG8_MMA
#undef PG8_WAIT_V
#undef PG8_WAIT_L
#undef PG8_BAR
#undef PG8_SCHED
}
}
struct Params { const float* in[29]; float* out; unsigned char* ws; int ph_lo, ph_hi; };
enum { I_X = 0, I_C, I_CTX, I_CCTX, I_MODW, I_MODB, I_LNG, I_LNB, I_WA_IN, I_WA_OUT, I_WA_SINK, I_RT_IN, I_RT_OUT, I_RT_LD, I_NA_IN, I_NA_OUT, I_NA_RPB,
       I_S5_IN, I_S5_ARE, I_S5_AIM, I_S5_LDT, I_S5_BRE, I_S5_BIM, I_S5_CRE, I_S5_CIM, I_S5_D, I_S5_GLU, I_S5_BGLU, I_S5_OUT };

__device__ __forceinline__ int dst_col(int pmode, int n) {
    if (pmode == 1) {
        if (n < 1024 || (n >= 2048 && n < 6144)) { const int c = n & 127, hlf = c & 64, d = c & 63; return (n - c) + hlf + ((d < 32) ? 2 * d : 2 * (d - 32) + 1); }
        return n;
    }
    if (pmode == 2) {
        if (n < 4096 || (n >= 12288 && n < 16384)) { const int c = n & 255; return (n - c) + ((c < 128) ? 2 * c : 2 * (c - 128) + 1); }
        return n;
    }
    return n;
}
__device__ __forceinline__ void cvt_tile(LAS unsigned char* lds, const float* __restrict__ W, bf16_t* __restrict__ Bt, int K, int N, int pmode, int tile) {
    const int tid = threadIdx.x;
    const int ntn = N / 256, tk = tile / ntn, tn = tile % ntn, k0 = tk * 64, n0 = tn * 256;
    LAS float* T = (LAS float*)lds;
    { const int n4 = tid & 63, ks = tid >> 6;
      const int d0 = dst_col(pmode, n0 + 4 * n4) - n0, d1 = dst_col(pmode, n0 + 4 * n4 + 1) - n0, d2 = dst_col(pmode, n0 + 4 * n4 + 2) - n0, d3 = dst_col(pmode, n0 + 4 * n4 + 3) - n0;
      f32x4 v[8];
#pragma unroll
      for (int i = 0; i < 8; ++i) v[i] = __builtin_nontemporal_load((const f32x4*)(W + (size_t)(k0 + ks + 8 * i) * N + n0 + 4 * n4));
#pragma unroll
      for (int i = 0; i < 8; ++i) { LAS float* r = T + (ks + 8 * i) * 257; r[d0] = v[i][0]; r[d1] = v[i][1]; r[d2] = v[i][2]; r[d3] = v[i][3]; } }
    __syncthreads();
    { const int nr = tid >> 1, kh = (tid & 1) * 32;
      float v[32];
#pragma unroll
      for (int j = 0; j < 32; ++j) v[j] = T[(kh + j) * 257 + nr];
      bf16_t* dp = Bt + (size_t)(n0 + nr) * K + k0 + kh;
#pragma unroll
      for (int q = 0; q < 4; ++q) { u32x4 w; w.x = cvt_pk_bf16(v[8 * q], v[8 * q + 1]); w.y = cvt_pk_bf16(v[8 * q + 2], v[8 * q + 3]); w.z = cvt_pk_bf16(v[8 * q + 4], v[8 * q + 5]); w.w = cvt_pk_bf16(v[8 * q + 6], v[8 * q + 7]);
          *(u32x4*)(dp + 8 * q) = w; } }
    __syncthreads();
}
__device__ __forceinline__ void mod_unit(LAS unsigned char* lds, const Params& p, int unit) {
    const int tid = threadIdx.x, i = unit / 192, cb = unit % 192;
    LAS float* S0 = (LAS float*)lds; LAS float* S1 = S0 + 4096; LAS float* PT = S1 + 4096;
    for (int k = tid; k < 4096; k += NTHREADS) { S0[k] = silu_f(p.in[I_C][k]); S1[k] = silu_f(p.in[I_CCTX][k]); }
    __syncthreads();
    const int cg = tid & 15, kl = tid >> 4;
    const float* Wp = p.in[I_MODW] + (size_t)i * 4096 * 12288 + cb * 64 + cg * 4;
    f32x4 a0 = {0.f, 0.f, 0.f, 0.f}, a1 = {0.f, 0.f, 0.f, 0.f};
    for (int kk = 0; kk < 128; kk += 8) {
        f32x4 w[8];
#pragma unroll
        for (int j = 0; j < 8; ++j) w[j] = __builtin_nontemporal_load((const f32x4*)(Wp + (size_t)(kl + 32 * (kk + j)) * 12288));
#pragma unroll
        for (int j = 0; j < 8; ++j) { const int k = kl + 32 * (kk + j); a0 += w[j] * S0[k]; a1 += w[j] * S1[k]; }
    }
#pragma unroll
    for (int j = 0; j < 4; ++j) { PT[kl * 128 + cg * 4 + j] = a0[j]; PT[kl * 128 + 64 + cg * 4 + j] = a1[j]; }
    __syncthreads();
    if (tid < 128) {
        float s = 0.f;
        for (int k = 0; k < 32; ++k) s += PT[k * 128 + tid];
        const int v = tid >> 6, col = cb * 64 + (tid & 63);
        ((float*)(p.ws + WS_MOD))[(size_t)(i * 2 + v) * 12288 + col] = s + p.in[I_MODB][(size_t)i * 12288 + col];
    }
    __syncthreads();
}
__device__ __forceinline__ void rope_unit(const Params& p, int unit) {
    const int e = unit * 4096 + threadIdx.x * 8;
    if (unit < 512) {
        float* T = (float*)(p.ws + WS_ROPEB);
#pragma unroll
        for (int q = 0; q < 8; ++q) { const int idx = e + q, t = idx >> 7, j = idx & 127;
            const double ang = (double)t * exp(-(double)j * (9.210340371976184 / 128.0)); double s, c; sincos(ang, &s, &c);
            T[(size_t)idx * 2] = (float)c; T[(size_t)idx * 2 + 1] = (float)s; }
    } else {
        float* T = (float*)(p.ws + WS_ROPEA);
#pragma unroll
        for (int q = 0; q < 8; ++q) { const int idx = (unit - 512) * 4096 + threadIdx.x * 8 + q;
            if (idx < 320 * 32) { const int i = idx >> 5, j = idx & 31; const int pos = (i < 256) ? i : i - 256;
                const double ang = (double)pos * exp(-(double)j * (9.210340371976184 / 32.0)); double s, c; sincos(ang, &s, &c);
                T[(size_t)idx * 2] = (float)c; T[(size_t)idx * 2 + 1] = (float)s; } }
    }
}
constexpr int CVT_T0 = 0, CVT_T1 = CVT_T0 + 64 * 40, CVT_T2 = CVT_T1 + 64 * 16, CVT_T3 = CVT_T2 + 128 * 16;
constexpr int P0_MOD0 = 0, P0_CVT0 = 768, P0_ROPE0 = P0_CVT0 + CVT_T3, P0_END = P0_ROPE0 + 515;
__device__ __forceinline__ void p0_prologue(LAS unsigned char* lds, const Params& p) {
    bf16_t* Wb = (bf16_t*)(p.ws + WS_W);
    for (int u = blockIdx.x; u < P0_END; u += gridDim.x) {
        if (u < P0_CVT0) mod_unit(lds, p, u);
        else if (u < P0_ROPE0) {
            const int t = u - P0_CVT0;
            if      (t < CVT_T1) cvt_tile(lds, p.in[I_WA_IN],  Wb + W_WA_IN,  4096, 10240, 1, t - CVT_T0);
            else if (t < CVT_T2) cvt_tile(lds, p.in[I_WA_OUT], Wb + W_WA_OUT, 4096, 4096,  0, t - CVT_T1);
            else                 cvt_tile(lds, p.in[I_RT_OUT], Wb + W_RT_OUT, 8192, 4096,  0, t - CVT_T2);
        } else rope_unit(p, u - P0_ROPE0);
    }
}
#define CVT_DESC(t_, SRC, DST, NN, PM, N0) do { const float* W_; size_t wo_; int tile_; \
    if (which == 0) { W_ = wp0; wo_ = W_RT_IN; NN = 24576; PM = 2; tile_ = (t_); } \
    else if (which == 1) { const bool a_ = (t_) < 64 * 64; W_ = a_ ? wp0 : wp1; wo_ = a_ ? W_NA_IN : W_NA_OUT; NN = a_ ? 16384 : 4096; PM = 0; tile_ = a_ ? (t_) : (t_) - 64 * 64; } \
    else { const bool a_ = (t_) < 64 * 32, b_ = (t_) < 64 * 32 + 64 * 16; W_ = a_ ? wp0 : b_ ? wp1 : wp2; wo_ = a_ ? W_S5_IN : b_ ? W_S5_GLU : W_S5_OUT; \
        NN = a_ ? 8192 : 4096; PM = 0; tile_ = a_ ? (t_) : b_ ? (t_) - 64 * 32 : (t_) - 64 * 32 - 64 * 16; } \
    const int ntn_ = NN >> 8, tk_ = tile_ / ntn_, tn_ = tile_ - tk_ * ntn_; \
    SRC = W_ + (size_t)(tk_ * 64) * NN + tn_ * 256; DST = Wb + wo_ + (size_t)(tn_ * 256) * 4096 + tk_ * 64; N0 = tn_ * 256; } while (0)
#define CVT_TAKE(dst_) do { int r_ = -1; \
    if (!(early && __hip_atomic_load(ctr, __ATOMIC_RELAXED, __HIP_MEMORY_SCOPE_AGENT) >= limit)) { \
        const unsigned t_ = __hip_atomic_fetch_add(ctr, 1u, __ATOMIC_RELAXED, __HIP_MEMORY_SCOPE_AGENT); if (t_ < (unsigned)ntile) r_ = (int)t_; } \
    dst_ = r_; } while (0)
__device__ __forceinline__ void cvt_tail(LAS unsigned char* lds, const Params& p, int which, bool early = false) {
    bf16_t* Wb = (bf16_t*)(p.ws + WS_W);
    unsigned* ctr = (unsigned*)(p.ws + WS_CTL + 16384 + 9 * 2048 + which * 256);
    volatile LAS int* slot = (volatile LAS int*)(lds + 131072 + 64);
    const int ntile = (which == 0) ? 64 * 96 : (which == 1) ? 64 * 64 + 64 * 16 : 64 * 32 + 2 * 64 * 16;
    const unsigned limit = early ? (unsigned)(ntile - ntile / 6) : 0xffffffffu;
    const int tid = threadIdx.x, n4 = tid & 63, ks = tid >> 6, nr = tid >> 1, kh = (tid & 1) * 32;
    LAS float* T = (LAS float*)lds;
    const float* wp0 = (which == 0) ? p.in[I_RT_IN] : (which == 1) ? p.in[I_NA_IN] : p.in[I_S5_IN];
    const float* wp1 = (which == 1) ? p.in[I_NA_OUT] : p.in[I_S5_GLU];
    const float* wp2 = p.in[I_S5_OUT];
    asm volatile("" : "+s"(wp0), "+s"(wp1), "+s"(wp2));
    __syncthreads();
    if (tid == 0) CVT_TAKE(slot[0]);
    __syncthreads();
    int t = __builtin_amdgcn_readfirstlane(slot[0]);
    if (t < 0) return;
    const float* src; bf16_t* dst; int N, pmode, n0;
    CVT_DESC(t, src, dst, N, pmode, n0);
    f32x4 v[8];
#pragma unroll
    for (int i = 0; i < 8; ++i) v[i] = __builtin_nontemporal_load((const f32x4*)(src + (size_t)(ks + 8 * i) * N + 4 * n4));
    for (;;) {
        if (tid == 0) CVT_TAKE(slot[1]);
        { const int d0 = dst_col(pmode, n0 + 4 * n4) - n0, d1 = dst_col(pmode, n0 + 4 * n4 + 1) - n0, d2 = dst_col(pmode, n0 + 4 * n4 + 2) - n0, d3 = dst_col(pmode, n0 + 4 * n4 + 3) - n0;
#pragma unroll
          for (int i = 0; i < 8; ++i) { LAS float* r = T + (ks + 8 * i) * 257; r[d0] = v[i][0]; r[d1] = v[i][1]; r[d2] = v[i][2]; r[d3] = v[i][3]; } }
        __syncthreads();
        const int tn = __builtin_amdgcn_readfirstlane(slot[1]);
        bf16_t* dcur = dst;
        if (tn >= 0) {
            CVT_DESC(tn, src, dst, N, pmode, n0);
#pragma unroll
            for (int i = 0; i < 8; ++i) v[i] = __builtin_nontemporal_load((const f32x4*)(src + (size_t)(ks + 8 * i) * N + 4 * n4));
        }
        { float w_[32];
#pragma unroll
          for (int j = 0; j < 32; ++j) w_[j] = T[(kh + j) * 257 + nr];
          bf16_t* dp = dcur + (size_t)nr * 4096 + kh;
#pragma unroll
          for (int q = 0; q < 4; ++q) { u32x4 w; w.x = cvt_pk_bf16(w_[8 * q], w_[8 * q + 1]); w.y = cvt_pk_bf16(w_[8 * q + 2], w_[8 * q + 3]); w.z = cvt_pk_bf16(w_[8 * q + 4], w_[8 * q + 5]); w.w = cvt_pk_bf16(w_[8 * q + 6], w_[8 * q + 7]);
              *(u32x4*)(dp + 8 * q) = w; } }
        __syncthreads();
        if (tn < 0) break;
    }
}
#undef CVT_DESC
#undef CVT_TAKE

__device__ __forceinline__ void p1_modulate(LAS unsigned char* lds, const Params& p) {
    const float* mod = (const float*)(p.ws + WS_MOD);
    bf16_t* H = (bf16_t*)(p.ws + WS_H);
    LAS float* Lm = (LAS float*)lds;
    __syncthreads();
    for (int k = threadIdx.x; k < 2048; k += NTHREADS) { *(LAS f32x4*)(Lm + 4 * k) = *(const f32x4*)(mod + 4 * k); *(LAS f32x4*)(Lm + 8192 + 4 * k) = *(const f32x4*)(mod + 12288 + 4 * k); }
    __syncthreads();
    const size_t nchunk = (size_t)MROWS * (DM / 8), stride = (size_t)gridDim.x * NTHREADS;
    for (size_t ch0 = (size_t)blockIdx.x * NTHREADS + threadIdx.x; ch0 < nchunk; ch0 += 4 * stride) {
        f32x4 x0[4], x1[4];
#pragma unroll
        for (int j = 0; j < 4; ++j) { const size_t ch = ch0 + j * stride; if (ch < nchunk) { const int row = (int)(ch >> 9), col = (int)(ch & 511) * 8;
            const float* src = (row >= SEQ) ? p.in[I_CTX] + (size_t)(row - SEQ) * DM + col : p.in[I_X] + (size_t)row * DM + col; x0[j] = *(const f32x4*)src; x1[j] = *(const f32x4*)(src + 4); } }
#pragma unroll
        for (int j = 0; j < 4; ++j) { const size_t ch = ch0 + j * stride; if (ch < nchunk) { const int row = (int)(ch >> 9), col = (int)(ch & 511) * 8;
            LAS float* md = Lm + ((row >= SEQ) ? 8192 : 0);
            const f32x4 sh0 = *(const LAS f32x4*)(md + col), sh1 = *(const LAS f32x4*)(md + col + 4), sc0 = *(const LAS f32x4*)(md + 4096 + col), sc1 = *(const LAS f32x4*)(md + 4096 + col + 4);
            const f32x4 h0 = x0[j] * (sc0 + 1.0f) + sh0, h1 = x1[j] * (sc1 + 1.0f) + sh1;
            u32x4 w; w.x = cvt_pk_bf16(h0[0], h0[1]); w.y = cvt_pk_bf16(h0[2], h0[3]); w.z = cvt_pk_bf16(h1[0], h1[1]); w.w = cvt_pk_bf16(h1[2], h1[3]);
            *(u32x4*)(H + (size_t)row * DM + col) = w; } }
    }
}

typedef _Float16 f16v2_t __attribute__((ext_vector_type(2)));
__device__ __forceinline__ unsigned pk_f16(float lo, float hi) { f16v2_t v; v[0] = (_Float16)lo; v[1] = (_Float16)hi; return __builtin_bit_cast(unsigned, v); }
__device__ __forceinline__ float f16_lo(unsigned w) { return (float)__builtin_bit_cast(_Float16, (unsigned short)(w & 0xffffu)); }
__device__ __forceinline__ float f16_hi(unsigned w) { return (float)__builtin_bit_cast(_Float16, (unsigned short)(w >> 16)); }
__device__ __forceinline__ f32x4 unpk_f16x4(u32x2 w) { f32x4 r; r[0] = f16_lo(w.x); r[1] = f16_hi(w.x); r[2] = f16_lo(w.y); r[3] = f16_hi(w.y); return r; }
__device__ __forceinline__ void ln_phase(LAS unsigned char* lds, const Params& p, int layer, int nrows, float* Xout, bool write_h, bool ctx_slabs) {
    const int wid = threadIdx.x >> 6, lane = threadIdx.x & 63;
    unsigned short* Xh = (unsigned short*)(p.ws + WS_X);
    const float* g = p.in[I_LNG] + (size_t)layer * DM; const float* b = p.in[I_LNB] + (size_t)layer * DM;
    const float* modc = (const float*)(p.ws + WS_MOD) + (size_t)layer * 2 * 12288;
    const float* modn = (const float*)(p.ws + WS_MOD) + (size_t)(layer + 1) * 2 * 12288;
    bf16_t* H = (bf16_t*)(p.ws + WS_H);
    const int nrows_w = ctx_slabs ? SEQ : nrows;
    if (ctx_slabs) {
        LAS float* red = (LAS float*)(lds + 90112);
        for (int cr = blockIdx.x; cr < NCTX; cr += gridDim.x) {
            const int row = SEQ + cr;
            const float* gate = modc + 12288 + 8192; const float* md = modn + 12288;
            const float* ys = (const float*)(p.ws + WS_YS) + (size_t)cr * DM;
            f32x4 t[2]; float s = 0.f;
#pragma unroll
            for (int j = 0; j < 2; ++j) { const int col = wid * 512 + j * 256 + lane * 4;
                f32x4 yk[16];
#pragma unroll
                for (int ks = 0; ks < 16; ++ks) yk[ks] = *(const f32x4*)(ys + (size_t)ks * 256 * DM + col);
                const f32x4 y = ((yk[0] + yk[1]) + (yk[2] + yk[3])) + ((yk[4] + yk[5]) + (yk[6] + yk[7])) + (((yk[8] + yk[9]) + (yk[10] + yk[11])) + ((yk[12] + yk[13]) + (yk[14] + yk[15])));
                const f32x4 xv = (layer == 0) ? *(const f32x4*)(p.in[I_CTX] + (size_t)cr * DM + col) : unpk_f16x4(*(const u32x2*)(Xh + (size_t)row * DM + col));
                t[j] = xv * DN_ALPHA + *(const f32x4*)(gate + col) * y;
                s += (t[j][0] + t[j][1]) + (t[j][2] + t[j][3]); }
#pragma unroll
            for (int o = 32; o >= 1; o >>= 1) s += __shfl_xor(s, o);
            __syncthreads();
            if (lane == 0) red[wid] = s;
            __syncthreads();
            float tot = 0.f;
#pragma unroll
            for (int w = 0; w < 8; ++w) tot += red[w];
            const float mean = tot * (1.0f / DM);
            float q = 0.f;
#pragma unroll
            for (int j = 0; j < 2; ++j) { const f32x4 d = t[j] - mean; q += (d[0] * d[0] + d[1] * d[1]) + (d[2] * d[2] + d[3] * d[3]); }
#pragma unroll
            for (int o = 32; o >= 1; o >>= 1) q += __shfl_xor(q, o);
            if (lane == 0) red[8 + wid] = q;
            __syncthreads();
            float qt = 0.f;
#pragma unroll
            for (int w = 0; w < 8; ++w) qt += red[8 + w];
            const float rstd = 1.0f / sqrtf(qt * (1.0f / DM) + LN_EPS);
#pragma unroll
            for (int j = 0; j < 2; ++j) { const int col = wid * 512 + j * 256 + lane * 4;
                const f32x4 y = (t[j] - mean) * rstd * *(const f32x4*)(g + col) + *(const f32x4*)(b + col);
                if (write_h) { u32x2 xw; xw.x = pk_f16(y[0], y[1]); xw.y = pk_f16(y[2], y[3]); *(u32x2*)(Xh + (size_t)row * DM + col) = xw; } else *(f32x4*)(Xout + (size_t)row * DM + col) = y;
                if (write_h) { const f32x4 h = y * (*(const f32x4*)(md + 4096 + col) + 1.0f) + *(const f32x4*)(md + col);
                    u32x2 w; w.x = cvt_pk_bf16(h[0], h[1]); w.y = cvt_pk_bf16(h[2], h[3]); *(u32x2*)(H + (size_t)row * DM + col) = w; } }
        }
    }
    LAS float* Lv = (LAS float*)lds;
    __syncthreads();
    for (int k = threadIdx.x; k < 1024; k += NTHREADS) {
        *(LAS f32x4*)(Lv + 4 * k) = *(const f32x4*)(modc + 8192 + 4 * k); *(LAS f32x4*)(Lv + 4096 + 4 * k) = *(const f32x4*)(g + 4 * k); *(LAS f32x4*)(Lv + 8192 + 4 * k) = *(const f32x4*)(b + 4 * k);
        if (write_h) { *(LAS f32x4*)(Lv + 12288 + 4 * k) = *(const f32x4*)(modn + 4 * k); *(LAS f32x4*)(Lv + 16384 + 4 * k) = *(const f32x4*)(modn + 4096 + 4 * k); } }
    __syncthreads();
    for (int row = blockIdx.x * 8 + wid; row < nrows_w; row += gridDim.x * 8) {
        const bool ctx = row >= SEQ;
        const float* xr = ctx ? p.in[I_CTX] + (size_t)(row - SEQ) * DM : p.in[I_X] + (size_t)row * DM;
        const float* gate = modc + (ctx ? 12288 : 0) + 8192;
        const float* gr = g; const float* br = b; const float* md = modn + (ctx ? 12288 : 0);
        int lane4 = lane * 4; asm volatile("" : "+v"(lane4));
        f32x4 v[16]; u32x2 yv[16];
        if (layer == 0) {
#pragma unroll
            for (int i = 0; i < 16; ++i) { v[i] = *(const f32x4*)(xr + i * 256 + lane * 4); yv[i] = *(const u32x2*)(H + (size_t)row * DM + i * 256 + lane * 4); }
        } else {
            u32x2 xh[16];
#pragma unroll
            for (int i = 0; i < 16; ++i) { xh[i] = *(const u32x2*)(Xh + (size_t)row * DM + i * 256 + lane * 4); yv[i] = *(const u32x2*)(H + (size_t)row * DM + i * 256 + lane * 4); }
#pragma unroll
            for (int i = 0; i < 16; ++i) v[i] = unpk_f16x4(xh[i]);
        }
        float s = 0.f;
#pragma unroll
        for (int i = 0; i < 16; ++i) { const f32x4 gt = *(const LAS f32x4*)(Lv + i * 256 + lane4);
            v[i][0] = v[i][0] * DN_ALPHA + gt[0] * bf_lo(yv[i].x); v[i][1] = v[i][1] * DN_ALPHA + gt[1] * bf_hi(yv[i].x);
            v[i][2] = v[i][2] * DN_ALPHA + gt[2] * bf_lo(yv[i].y); v[i][3] = v[i][3] * DN_ALPHA + gt[3] * bf_hi(yv[i].y);
            s += (v[i][0] + v[i][1]) + (v[i][2] + v[i][3]); }
#pragma unroll
        for (int o = 32; o >= 1; o >>= 1) s += __shfl_xor(s, o);
        const float mean = s * (1.0f / DM);
        float q = 0.f;
#pragma unroll
        for (int i = 0; i < 16; ++i) { const f32x4 d = v[i] - mean; q += (d[0] * d[0] + d[1] * d[1]) + (d[2] * d[2] + d[3] * d[3]); }
#pragma unroll
        for (int o = 32; o >= 1; o >>= 1) q += __shfl_xor(q, o);
        const float rstd = 1.0f / sqrtf(q * (1.0f / DM) + LN_EPS);
        float* xo = Xout + (size_t)row * DM;
#pragma unroll
        for (int i = 0; i < 16; ++i) {
            const int col = i * 256 + lane4;
            const f32x4 gv = *(const LAS f32x4*)(Lv + 4096 + col), bv = *(const LAS f32x4*)(Lv + 8192 + col);
            const f32x4 y = (v[i] - mean) * rstd * gv + bv;
            if (write_h) { u32x2 xw; xw.x = pk_f16(y[0], y[1]); xw.y = pk_f16(y[2], y[3]); *(u32x2*)(Xh + (size_t)row * DM + col) = xw; } else *(f32x4*)(xo + col) = y;
            if (write_h) {
                const f32x4 sh = *(const LAS f32x4*)(Lv + 12288 + col), sc = *(const LAS f32x4*)(Lv + 16384 + col);
                const f32x4 h = y * (sc + 1.0f) + sh;
                u32x2 w; w.x = cvt_pk_bf16(h[0], h[1]); w.y = cvt_pk_bf16(h[2], h[3]);
                *(u32x2*)(H + (size_t)row * DM + col) = w;
            }
        }
    }
}

namespace att {
#define KSWZ(row, colB) ((row) * 256 + ((colB) ^ ((((row) & 7) | ((((row) >> 4) & 1) << 3)) << 4)))
__device__ __forceinline__ int crow(int r, int hi) { return (r & 3) + 8 * (r >> 2) + 4 * hi; }
__device__ __forceinline__ void qkt(f32x16& p0, f32x16& p1, const bf16_t* Ks, const bf16x8* qr, int r32, int hi) {
  p0 = f32x16{}; p1 = f32x16{};
#pragma unroll
  for (int d0 = 0; d0 < 8; ++d0) { const int cb = (d0 * 16 + hi * 8) * 2;
    const bf16x8 b0 = *reinterpret_cast<const bf16x8*>((const char*)Ks + KSWZ(r32, cb));
    const bf16x8 b1 = *reinterpret_cast<const bf16x8*>((const char*)Ks + KSWZ(32 + r32, cb));
    p0 = __builtin_amdgcn_mfma_f32_32x32x16_bf16(b0, qr[d0], p0, 0, 0, 0);
    p1 = __builtin_amdgcn_mfma_f32_32x32x16_bf16(b1, qr[d0], p1, 0, 0, 0); }
}
__device__ __forceinline__ int v_st(int k, int c) { const int kk = (k & ~0xC) | ((k & 4) << 1) | ((k & 8) >> 1); return ((kk >> 3) * 4 + (c >> 5)) * 512 + ((kk & 7) * 32 + (c & 31)) * 2; }
__device__ __forceinline__ int v_rd_base(int lane) { return ((lane & 3) << 3) | (((lane >> 2) & 3) << 6) | (((lane >> 4) & 1) << 5) | (((lane >> 5) & 1) << 8); }
constexpr int v_rd_off(int d0, int ks, int half) { return d0 * 512 + ks * 4096 + half * 2048; }
template <int OFF> __device__ __forceinline__ s16x4 tr_read(int vb) {
  s16x4 r; asm volatile("ds_read_b64_tr_b16 %0, %1 offset:%2" : "=&v"(r) : "v"(vb), "i"(OFF) : "memory"); return r;
}
#define PK(L, H) (bf16x8){L[0], L[1], L[2], L[3], H[0], H[1], H[2], H[3]}
template <int D0> __device__ __forceinline__ void pv_reads(int vb, s16x4 (&f)[8], bool k0, bool k3) {
  if (k0) { f[0] = tr_read<v_rd_off(D0, 0, 0)>(vb); f[1] = tr_read<v_rd_off(D0, 0, 1)>(vb); }
  f[2] = tr_read<v_rd_off(D0, 1, 0)>(vb); f[3] = tr_read<v_rd_off(D0, 1, 1)>(vb); f[4] = tr_read<v_rd_off(D0, 2, 0)>(vb); f[5] = tr_read<v_rd_off(D0, 2, 1)>(vb);
  if (k3) { f[6] = tr_read<v_rd_off(D0, 3, 0)>(vb); f[7] = tr_read<v_rd_off(D0, 3, 1)>(vb); }
}
__device__ __forceinline__ void pv_mma(f32x16& od, const s16x4 (&f)[8], bf16x8 pa0, bf16x8 pa1, bf16x8 pa2, bf16x8 pa3, bool k0, bool k3) {
  if (k0) od = __builtin_amdgcn_mfma_f32_32x32x16_bf16(pa0, PK(f[0], f[1]), od, 0, 0, 0);
  od = __builtin_amdgcn_mfma_f32_32x32x16_bf16(pa1, PK(f[2], f[3]), od, 0, 0, 0);
  od = __builtin_amdgcn_mfma_f32_32x32x16_bf16(pa2, PK(f[4], f[5]), od, 0, 0, 0);
  if (k3) od = __builtin_amdgcn_mfma_f32_32x32x16_bf16(pa3, PK(f[6], f[7]), od, 0, 0, 0);
}
#define PV_WAIT1(k0_, k3_) do { if ((k0_) && (k3_)) asm volatile("s_waitcnt lgkmcnt(8)" ::: "memory"); else asm volatile("s_waitcnt lgkmcnt(6)" ::: "memory"); __builtin_amdgcn_sched_barrier(0); } while (0)
__device__ __forceinline__ void pv_all(f32x16 (&o)[4], int vb, bf16x8 pa0, bf16x8 pa1, bf16x8 pa2, bf16x8 pa3, bool k0, bool k3) {
  s16x4 fa[8] = {}, fb[8] = {};
  pv_reads<0>(vb, fa, k0, k3); pv_reads<1>(vb, fb, k0, k3);
  PV_WAIT1(k0, k3); pv_mma(o[0], fa, pa0, pa1, pa2, pa3, k0, k3);
  pv_reads<2>(vb, fa, k0, k3);
  PV_WAIT1(k0, k3); pv_mma(o[1], fb, pa0, pa1, pa2, pa3, k0, k3);
  pv_reads<3>(vb, fb, k0, k3);
  PV_WAIT1(k0, k3); pv_mma(o[2], fa, pa0, pa1, pa2, pa3, k0, k3);
  asm volatile("s_waitcnt lgkmcnt(0)" ::: "memory"); __builtin_amdgcn_sched_barrier(0);
  pv_mma(o[3], fb, pa0, pa1, pa2, pa3, k0, k3);
}
#undef PV_WAIT1
#undef PK

template <int MODE>
__device__ __forceinline__ void attn_unit(unsigned char* lds, const bf16_t* __restrict__ P,
                                          int qrow_w, int qcol, int kcol, int vcol, int n_local, int local_row0,
                                          int qtok0, int wrow, int wcol0, int a_lo, float sink, const float* rpbs,
                                          bf16_t* __restrict__ G, int gcol, int szcol) {
  constexpr int ldp = (MODE == 0) ? WA_INW : NA_INW, ldg = DM;
  const int tid = threadIdx.x, wid = tid >> 6, lane = tid & 63, r32 = lane & 31, hi = lane >> 5;
  bf16_t* V_lds = (bf16_t*)lds;
  float* wsx = (float*)(lds + 65536) + wid * 64; float* li_l = wsx; float* al_l = wsx + 32;
  float m_reg = -1e30f, l_reg = 0.f; f32x16 o[4] = {}; bf16x8 qr[8];
  const bf16_t* Qw = P + (size_t)(qrow_w + r32) * ldp + qcol + hi * 8;
#pragma unroll
  for (int d0 = 0; d0 < 8; ++d0) qr[d0] = *reinterpret_cast<const bf16x8*>(Qw + d0 * 16);
  const int sr = tid >> 4, sc = (tid & 15) * 8, vst0 = v_st(sr, sc), vst1 = v_st(32 + sr, sc);
  const int vb0 = (int)(uintptr_t)V_lds + v_rd_base(lane);
  const int nt = 4 + n_local;
  bf16x8 vs0, vs1, ks0, ks1;
#define TROW(i) ((i) < 4 ? SEQ + 64 * (i) : local_row0 + 64 * ((i) - 4))
#define SLOAD(k0) do { const bf16_t* b_ = P + (size_t)((k0) + sr) * ldp + sc; \
    vs0 = *reinterpret_cast<const bf16x8*>(b_ + vcol); vs1 = *reinterpret_cast<const bf16x8*>(b_ + (size_t)32 * ldp + vcol); \
    ks0 = *reinterpret_cast<const bf16x8*>(b_ + kcol); ks1 = *reinterpret_cast<const bf16x8*>(b_ + (size_t)32 * ldp + kcol); } while (0)
#define SWRITE(b) do { char* vb_ = (char*)lds + (b) * 32768; *(bf16x8*)(vb_ + vst0) = vs0; *(bf16x8*)(vb_ + vst1) = vs1; \
    *(bf16x8*)(vb_ + 16384 + KSWZ(sr, sc * 2)) = ks0; *(bf16x8*)(vb_ + 16384 + KSWZ(32 + sr, sc * 2)) = ks1; } while (0)
  __syncthreads();
  SLOAD(TROW(0)); SWRITE(0); SLOAD(TROW(1));
  __syncthreads();
  for (int i = 0; i < nt; ++i) {
    const int cb = i & 1;
    if (i + 1 < nt) SWRITE(cb ^ 1);
    if (i + 2 < nt) SLOAD(TROW(i + 2));
    const bf16_t* K_cur = (const bf16_t*)(lds + cb * 32768 + 16384); const int vb_cur = vb0 + cb * 32768;
    bool active = true; int arow = 0;
    if (MODE == 1 && i >= 4) { arow = a_lo + (i - 4); const int rs = min(max(wrow - 4, 0), 248); active = (arow >= rs) && (arow < rs + 8); }
    if (active) {
      const bool nA = !(MODE == 1 && i >= 4 && wcol0 != 0), nD = !(MODE == 1 && i >= 4 && wcol0 == 0);
      f32x16 p0, p1; qkt(p0, p1, K_cur, qr, r32, hi);
      if (i >= 4) {
        if (MODE == 0) {
          const int dbase = (qtok0 + r32) - (local_row0 + 64 * (i - 4));
          const int tdiff = (qtok0 >> 6) - ((local_row0 >> 6) + (i - 4));
          if (tdiff >= 2 || tdiff <= -2)
#pragma unroll
          for (int r = 0; r < 16; ++r) { const int d0 = dbase - crow(r, hi), d1 = d0 - 32;
            if (d0 > 128 || d0 < -128) p0[r] = -1e30f; if (d1 > 128 || d1 < -128) p1[r] = -1e30f; }
        } else {
          const int c = wcol0 + r32, cs = min(max(c - 8, 0), 48);
          const unsigned baddr = (unsigned)(uintptr_t)rpbs + (unsigned)(((arow - wrow + 7) * 31 + 15 - c + 4 * hi) * 4);
          const int tv = 4 * hi - cs;
#define NB_RD(dst, OFF) asm volatile("ds_read_b32 %0, %1 offset:%2" : "=v"(dst) : "v"(baddr), "i"(OFF) : "memory")
#define NB_HALF(P_, BASEKEY) do { float b0_, b1_, b2_, b3_, b4_, b5_, b6_, b7_, b8_, b9_, b10_, b11_, b12_, b13_, b14_, b15_; \
            NB_RD(b0_, ((BASEKEY) + 0) * 4); NB_RD(b1_, ((BASEKEY) + 1) * 4); NB_RD(b2_, ((BASEKEY) + 2) * 4); NB_RD(b3_, ((BASEKEY) + 3) * 4); \
            NB_RD(b4_, ((BASEKEY) + 8) * 4); NB_RD(b5_, ((BASEKEY) + 9) * 4); NB_RD(b6_, ((BASEKEY) + 10) * 4); NB_RD(b7_, ((BASEKEY) + 11) * 4); \
            NB_RD(b8_, ((BASEKEY) + 16) * 4); NB_RD(b9_, ((BASEKEY) + 17) * 4); NB_RD(b10_, ((BASEKEY) + 18) * 4); NB_RD(b11_, ((BASEKEY) + 19) * 4); \
            NB_RD(b12_, ((BASEKEY) + 24) * 4); NB_RD(b13_, ((BASEKEY) + 25) * 4); NB_RD(b14_, ((BASEKEY) + 26) * 4); NB_RD(b15_, ((BASEKEY) + 27) * 4); \
            asm volatile("s_waitcnt lgkmcnt(0)" ::: "memory"); __builtin_amdgcn_sched_barrier(0); \
            const float bb_[16] = {b0_, b1_, b2_, b3_, b4_, b5_, b6_, b7_, b8_, b9_, b10_, b11_, b12_, b13_, b14_, b15_}; \
            _Pragma("unroll") for (int r = 0; r < 16; ++r) { const int key_ = (BASEKEY) + (r & 3) + 8 * (r >> 2); P_[r] = ((unsigned)(key_ + tv) < 16u) ? P_[r] + bb_[r] : -1e30f; } } while (0)
#define NB_QUAD(P_, R0, KEY0) do { float b0_, b1_, b2_, b3_; \
            NB_RD(b0_, ((KEY0) + 0) * 4); NB_RD(b1_, ((KEY0) + 1) * 4); NB_RD(b2_, ((KEY0) + 2) * 4); NB_RD(b3_, ((KEY0) + 3) * 4); \
            asm volatile("s_waitcnt lgkmcnt(0)" ::: "memory"); __builtin_amdgcn_sched_barrier(0); \
            const float bb_[4] = {b0_, b1_, b2_, b3_}; \
            _Pragma("unroll") for (int r = 0; r < 4; ++r) { const int key_ = (KEY0) + r; P_[(R0) + r] = ((unsigned)(key_ + tv) < 16u) ? P_[(R0) + r] + bb_[r] : -1e30f; } } while (0)
          if (nA) NB_HALF(p0, 0); else NB_QUAD(p0, 12, 24);
          if (nD) NB_HALF(p1, 32); else NB_QUAD(p1, 0, 32);
#undef NB_RD
#undef NB_HALF
#undef NB_QUAD
        }
      }
      float pmax = fmaxf(fmaxf(p0[12], p0[13]), fmaxf(p0[14], p0[15]));
#pragma unroll
      for (int r = 0; r < 4; ++r) pmax = fmaxf(pmax, p1[r]);
      if (nA) {
#pragma unroll
        for (int r = 0; r < 12; ++r) pmax = fmaxf(pmax, p0[r]); }
      if (nD) {
#pragma unroll
        for (int r = 4; r < 16; ++r) pmax = fmaxf(pmax, p1[r]); }
      { auto rr = __builtin_amdgcn_permlane32_swap(__float_as_uint(pmax), __float_as_uint(pmax), false, false);
        pmax = fmaxf(__uint_as_float(rr[0]), __uint_as_float(rr[1])); }
      const bool resc = !__all(pmax - m_reg <= 8.0f);
      float alpha = 1.0f;
      if (resc) { const float mn_ = fmaxf(m_reg, pmax); alpha = __builtin_amdgcn_exp2f((m_reg - mn_) * L2E); m_reg = mn_; }
      const float mnC = -m_reg * L2E;
      float ps = 0.f;
#pragma unroll
      for (int r = 12; r < 16; ++r) { p0[r] = __builtin_amdgcn_exp2f(fmaf(p0[r], L2E, mnC)); p1[r - 12] = __builtin_amdgcn_exp2f(fmaf(p1[r - 12], L2E, mnC)); ps += p0[r] + p1[r - 12]; }
      if (nA) {
#pragma unroll
        for (int r = 0; r < 12; ++r) { p0[r] = __builtin_amdgcn_exp2f(fmaf(p0[r], L2E, mnC)); ps += p0[r]; }
      } else {
#pragma unroll
        for (int r = 8; r < 12; ++r) p0[r] = 0.f; }
      if (nD) {
#pragma unroll
        for (int r = 4; r < 16; ++r) { p1[r] = __builtin_amdgcn_exp2f(fmaf(p1[r], L2E, mnC)); ps += p1[r]; }
      } else {
#pragma unroll
        for (int r = 4; r < 8; ++r) p1[r] = 0.f; }
      { auto rr = __builtin_amdgcn_permlane32_swap(__float_as_uint(ps), __float_as_uint(ps), false, false);
        ps = __uint_as_float(rr[0]) + __uint_as_float(rr[1]); }
      l_reg = l_reg * alpha + ps;
      bf16x8 pa0, pa1, pa2, pa3;
#define PK4(Pv, BASE, OUT) do { unsigned a0 = cvt_pk_bf16(Pv[BASE + 0], Pv[BASE + 1]), a1 = cvt_pk_bf16(Pv[BASE + 2], Pv[BASE + 3]);   \
    unsigned b0 = cvt_pk_bf16(Pv[BASE + 4], Pv[BASE + 5]), b1 = cvt_pk_bf16(Pv[BASE + 6], Pv[BASE + 7]);                              \
    auto r0 = __builtin_amdgcn_permlane32_swap(a0, b0, false, false); auto r1 = __builtin_amdgcn_permlane32_swap(a1, b1, false, false); \
    u32x4 w = {r0[0], r1[0], r0[1], r1[1]}; OUT = *reinterpret_cast<bf16x8*>(&w); } while (0)
      pa0 = bf16x8{}; pa3 = bf16x8{};
      if (nA) PK4(p0, 0, pa0);
      PK4(p0, 8, pa1); PK4(p1, 0, pa2);
      if (nD) PK4(p1, 8, pa3);
#undef PK4
      if (resc) {
        if (hi == 0) al_l[r32] = alpha;
        asm volatile("s_waitcnt lgkmcnt(0)" ::: "memory");
#pragma unroll
        for (int r = 0; r < 16; ++r) { const float a = al_l[crow(r, hi)];
#pragma unroll
          for (int d = 0; d < 4; ++d) o[d][r] *= a; }
      }
      pv_all(o, vb_cur, pa0, pa1, pa2, pa3, nA, nD);
    }
    __syncthreads();
  }
  if (MODE == 0) l_reg += __builtin_amdgcn_exp2f((sink - m_reg) * L2E);
  if (hi == 0) li_l[r32] = l_reg;
  asm volatile("s_waitcnt lgkmcnt(0)" ::: "memory");
  char* ot = (char*)lds + 73728 + wid * 8704;
#pragma unroll
  for (int r = 0; r < 16; ++r) { const float rl = __builtin_amdgcn_rcpf(li_l[crow(r, hi)]); bf16_t* orow = (bf16_t*)(ot + crow(r, hi) * 272) + r32;
#pragma unroll
    for (int d0 = 0; d0 < 4; ++d0) orow[d0 * 32] = f2bf(o[d0][r] * rl); }
  asm volatile("s_waitcnt lgkmcnt(0)" ::: "memory");
#pragma unroll
  for (int i = 0; i < 8; ++i) { const int id = lane + 64 * i, row = id >> 4, pc = id & 15;
    const u32x4 ov = *(const u32x4*)(ot + row * 272 + pc * 16);
    const u32x4 zv = *(const u32x4*)(P + (size_t)(qrow_w + row) * ldp + szcol + pc * 8);
    u32x4 w;
    w.x = cvt_pk_bf16(bf_lo(ov.x) * bf_lo(zv.x), bf_hi(ov.x) * bf_hi(zv.x)); w.y = cvt_pk_bf16(bf_lo(ov.y) * bf_lo(zv.y), bf_hi(ov.y) * bf_hi(zv.y));
    w.z = cvt_pk_bf16(bf_lo(ov.z) * bf_lo(zv.z), bf_hi(ov.z) * bf_hi(zv.z)); w.w = cvt_pk_bf16(bf_lo(ov.w) * bf_lo(zv.w), bf_hi(ov.w) * bf_hi(zv.w));
    *(u32x4*)(G + (size_t)(qrow_w + row) * ldg + gcol + pc * 8) = w; }
#undef TROW
#undef SLOAD
#undef SWRITE
}
}

__device__ __forceinline__ void mixerA_phase(unsigned char* lds, const Params& p) {
  const bf16_t* P = (const bf16_t*)(p.ws + WS_P); bf16_t* G = (bf16_t*)(p.ws + WS_G);
  const int wid = threadIdx.x >> 6;
  for (int u = blockIdx.x; u < 8 * 260; u += gridDim.x) {
    const int kvh = u & 7, j = u >> 3;
    const int hq = kvh * 4 + (wid >> 1);
    const float sink = p.in[I_WA_SINK][hq];
    int qrow_w, n_local = 0, local_row0 = 0, qtok0 = 0;
    if (j < 256) { qrow_w = 64 * j + 32 * (wid & 1); qtok0 = qrow_w; const int lo = max(j - 2, 0), hi_ = min(j + 2, 255); n_local = hi_ - lo + 1; local_row0 = 64 * lo; }
    else { qrow_w = SEQ + 64 * (j - 256) + 32 * (wid & 1); }
    att::attn_unit<0>(lds, P, qrow_w, 2048 + hq * 128, kvh * 128, 1024 + kvh * 128, n_local, local_row0, qtok0, 0, 0, 0, sink, nullptr,
                      G, hq * 128, 6144 + hq * 128);
  }
}
__device__ __forceinline__ void mixerC_phase(unsigned char* lds, const Params& p) {
  const bf16_t* P = (const bf16_t*)(p.ws + WS_P); bf16_t* G = (bf16_t*)(p.ws + WS_G);
  const int wid = threadIdx.x >> 6;
  float* rpbs = (float*)(lds + 69632);
  for (int u = blockIdx.x; u < 32 * 65; u += gridDim.x) {
    const int h = u & 31, rg = u >> 5;
    __syncthreads();
    if (threadIdx.x < 465) rpbs[threadIdx.x] = p.in[I_NA_RPB][h * 465 + threadIdx.x];
    int qrow_w, n_local = 0, local_row0 = 0, wrow = 0, wcol0 = 0, a_lo = 0;
    if (rg < 64) { wrow = 4 * rg + (wid >> 1); wcol0 = 32 * (wid & 1); qrow_w = 64 * wrow + wcol0;
      a_lo = min(max(4 * rg - 4, 0), 248); const int a_hi = min(max(4 * rg + 3 - 4, 0), 248) + 7; n_local = a_hi - a_lo + 1; local_row0 = 64 * a_lo; }
    else { qrow_w = SEQ + 32 * wid; }
    att::attn_unit<1>(lds, P, qrow_w, 8192 + h * 128, h * 128, 4096 + h * 128, n_local, local_row0, 0, wrow, wcol0, a_lo, 0.f, rpbs,
                      G, h * 128, 12288 + h * 128);
  }
}

__device__ __forceinline__ bf16x8 rowfrag(LAS unsigned char* base, int stride, int row0, int k0, int r32, int hi) {
    return *(const LAS bf16x8*)(base + (row0 + r32) * stride + (k0 + 8 * hi) * 2);
}
__device__ __forceinline__ void trfrag_issue(s16x4& lo, s16x4& hh, unsigned base_addr, int stride, int k0, int n0, int lane) {
    const int hi = lane >> 5, blk = (lane >> 4) & 1, q = (lane & 15) >> 2, pp = lane & 3;
    const unsigned a0 = base_addr + (unsigned)((k0 + 8 * hi + q) * stride + (n0 + 16 * blk + 4 * pp) * 2);
    const unsigned a1 = a0 + (unsigned)(4 * stride);
    asm volatile("ds_read_b64_tr_b16 %0, %1" : "=&v"(lo) : "v"(a0) : "memory");
    asm volatile("ds_read_b64_tr_b16 %0, %1" : "=&v"(hh) : "v"(a1) : "memory");
}
__device__ __forceinline__ void tr_wait() { asm volatile("s_waitcnt lgkmcnt(0)" ::: "memory"); __builtin_amdgcn_sched_barrier(0); }
#define TR2(lo_, hh_, base_, OFF_, STRIDE_) asm volatile("ds_read_b64_tr_b16 %0, %2 offset:%3\n\tds_read_b64_tr_b16 %1, %2 offset:%4" : "=&v"(lo_), "=&v"(hh_) : "v"(base_), "i"(OFF_), "i"((OFF_) + 4 * (STRIDE_)) : "memory")
__device__ __forceinline__ unsigned tr_lane_base(unsigned tile_addr, int stride, int lane) { const int hi = lane >> 5, blk = (lane >> 4) & 1, q = (lane & 15) >> 2, pp = lane & 3; return tile_addr + (unsigned)((8 * hi + q) * stride + (16 * blk + 4 * pp) * 2); }
#define TRPK(L_, H_) (bf16x8){L_[0], L_[1], L_[2], L_[3], H_[0], H_[1], H_[2], H_[3]}
__device__ __forceinline__ int crow16(int r, int hi) { return (r & 3) + 8 * (r >> 2) + 4 * hi; }

typedef float f32x4c __attribute__((ext_vector_type(4)));
template <class EpiC>
__device__ __forceinline__ void ctx_gemm64(LAS unsigned char* L, const bf16_t* __restrict__ A, const bf16_t* __restrict__ Bt, int K, int item, const EpiC& E) {
    constexpr int STR = 528, WOFF = 64 * 528;
    const int tid = threadIdx.x, lane = tid & 63, wid = tid >> 6, li = lane & 15, q = lane >> 4;
    const int rb = item & 3, cb = item >> 2, ar = wid & 3, nb2 = (wid >> 2) * 2;
    const bf16_t* Ab = A + (size_t)(64 * rb) * K; const bf16_t* Wb_ = Bt + (size_t)(64 * cb) * K;
    f32x4c acc0 = {0.f, 0.f, 0.f, 0.f}, acc1 = {0.f, 0.f, 0.f, 0.f};
    bf16x8 gA[8], gB[8];
#define CG_LOAD(R_, kc) do { _Pragma("unroll") for (int i = 0; i < 4; ++i) { const int id = tid + NTHREADS * i; \
        R_[i] = *(const bf16x8*)(Ab + (size_t)(id >> 5) * K + (kc) + (id & 31) * 8); R_[4 + i] = *(const bf16x8*)(Wb_ + (size_t)(id >> 5) * K + (kc) + (id & 31) * 8); } } while (0)
#define CG_WRITE(R_) do { _Pragma("unroll") for (int i = 0; i < 4; ++i) { const int id = tid + NTHREADS * i; \
        *(LAS bf16x8*)(L + (id >> 5) * STR + (id & 31) * 16) = R_[i]; *(LAS bf16x8*)(L + WOFF + (id >> 5) * STR + (id & 31) * 16) = R_[4 + i]; } } while (0)
    CG_LOAD(gA, 0); CG_LOAD(gB, 256);
    const int nch = K / 256;
    for (int c = 0; c < nch; ++c) {
        __syncthreads();
        if (c & 1) CG_WRITE(gB); else CG_WRITE(gA);
        __syncthreads();
        if (c + 2 < nch) { if (c & 1) CG_LOAD(gB, (c + 2) * 256); else CG_LOAD(gA, (c + 2) * 256); }
#pragma unroll
        for (int s = 0; s < 8; ++s) {
            const bf16x8 af = *(const LAS bf16x8*)(L + (16 * ar + li) * STR + (32 * s + 8 * q) * 2);
            const bf16x8 w0 = *(const LAS bf16x8*)(L + WOFF + (16 * nb2 + li) * STR + (32 * s + 8 * q) * 2), w1 = *(const LAS bf16x8*)(L + WOFF + (16 * nb2 + 16 + li) * STR + (32 * s + 8 * q) * 2);
            acc0 = __builtin_amdgcn_mfma_f32_16x16x32_bf16(w0, af, acc0, 0, 0, 0); acc1 = __builtin_amdgcn_mfma_f32_16x16x32_bf16(w1, af, acc1, 0, 0, 0);
        }
    }
#undef CG_LOAD
#undef CG_WRITE
    __syncthreads();
    E(acc0, 64 * cb + 16 * nb2 + 4 * q, 64 * rb + 16 * ar + li); E(acc1, 64 * cb + 16 * nb2 + 16 + 4 * q, 64 * rb + 16 * ar + li);
}
struct EpiCPlain {
    bf16_t* Pc; int ldp;
    __device__ __forceinline__ void operator()(f32x4c acc, int n, int row) const {
        u32x2 w; w.x = cvt_pk_bf16(acc[0], acc[1]); w.y = cvt_pk_bf16(acc[2], acc[3]);
        *(u32x2*)(Pc + (size_t)row * ldp + n) = w;
    }
};

namespace ret {
constexpr int QS = 0, KS = 33792, VS = 70656, ST0 = 82944, ST1 = 116736;
constexpr int QSTR = 528, KSTR = 576, VSTR = 192;
constexpr int NSTEP = 260, LDP = RT_INW;
constexpr size_t ATT_TILE = 64 * 64, ATT_DIR = (size_t)16 * 260 * ATT_TILE;
__device__ __forceinline__ int cid_row(int cid) { return cid < 4 ? SEQ + 64 * cid : 64 * (cid - 4); }
__device__ __forceinline__ int step_cid(int dir, int step) { return dir ? (step < 4 ? 3 - step : 263 - step) : step; }
}
__device__ __forceinline__ void retatt_phase(LAS unsigned char* L, const Params& p) {
    using namespace ret;
    const bf16_t* P = (const bf16_t*)(p.ws + WS_P); bf16_t* ATT = (bf16_t*)(p.ws + WS_G);
    const int tid = threadIdx.x, wid = __builtin_amdgcn_readfirstlane(tid >> 6), lane = tid & 63, r32 = lane & 31, hi = lane >> 5;
    const int hb = wid >> 2, t8 = tid & 255, w4 = wid & 3, qb = w4 >> 1, kb = w4 & 1;
    LAS unsigned char* Lq = L + hb * 67584; LAS unsigned char* Lk = Lq + 33792;
    for (int pair = blockIdx.x; pair < 2080; pair += gridDim.x) {
        const int u = 2 * pair + hb, h = u / 260, cid = u - h * 260, row0 = cid_row(cid);
        const float lgf = p.in[I_RT_LD][h] * L2E, lgb = p.in[I_RT_LD][16 + h] * L2E;
        bf16x8 qg[8], kg[8];
#pragma unroll
        for (int i = 0; i < 8; ++i) { const int idx = t8 + 256 * i, rr = idx >> 5, cc = idx & 31; const bf16_t* b_ = P + (size_t)(row0 + rr) * LDP + cc * 8;
            qg[i] = *(const bf16x8*)(b_ + 12288 + h * 256); kg[i] = *(const bf16x8*)(b_ + h * 256); }
        __syncthreads();
#pragma unroll
        for (int i = 0; i < 8; ++i) { const int idx = t8 + 256 * i, rr = idx >> 5, cc = idx & 31; *(LAS bf16x8*)(Lq + rr * QSTR + cc * 16) = qg[i]; *(LAS bf16x8*)(Lk + rr * QSTR + cc * 16) = kg[i]; }
        __syncthreads();
        f32x16 acc = {};
#pragma unroll 4
        for (int s = 0; s < 16; ++s) acc = __builtin_amdgcn_mfma_f32_32x32x16_bf16(rowfrag(Lk, QSTR, 32 * kb, 16 * s, r32, hi), rowfrag(Lq, QSTR, 32 * qb, 16 * s, r32, hi), acc, 0, 0, 0);
        const int a = 32 * qb + r32;
        const float ef = __builtin_amdgcn_exp2f((float)(a - 63) * lgf), eb = __builtin_amdgcn_exp2f((float)(-a) * lgb);
        bf16_t* af = ATT + ((size_t)h * 260 + cid) * ATT_TILE + (size_t)a * 64; bf16_t* ab = af + ATT_DIR;
#pragma unroll
        for (int g4 = 0; g4 < 4; ++g4) {
            float vf[4], vb[4];
#pragma unroll
            for (int i = 0; i < 4; ++i) { const int b = 32 * kb + 8 * g4 + 4 * hi + i, df = a - b; const float sc = acc[4 * g4 + i];
                vf[i] = (df >= 0) ? sc * ef : 0.f; vb[i] = (df < 0) ? sc * eb : 0.f; }
            u32x2 wf, wb; wf.x = cvt_pk_bf16(vf[0], vf[1]); wf.y = cvt_pk_bf16(vf[2], vf[3]); wb.x = cvt_pk_bf16(vb[0], vb[1]); wb.y = cvt_pk_bf16(vb[2], vb[3]);
            *(u32x2*)(af + 32 * kb + 8 * g4 + 4 * hi) = wf; *(u32x2*)(ab + 32 * kb + 8 * g4 + 4 * hi) = wb;
        }
    }
}
struct RetCtx { const bf16_t* P; const bf16_t* Ad; bf16_t* Ob; float lg2, cdec; int dir, h, ebI, qcol0, kcol0, vcol0; unsigned Lb; };
__device__ __forceinline__ void ret_step_o(LAS unsigned char* L, const RetCtx& c, int step, bf16x8 (&G)[10], bf16x8 (&atc)[4], bf16x8 (&atn)[4], int t8, int wid, int lane) {
    using namespace ret;
    const int r32 = lane & 31, hi = lane >> 5, qb = (wid & 3) >> 1, xb = wid & 1;
    const int cid = step_cid(c.dir, step), row0 = cid_row(cid);
    const int stc = (step & 1) ? ST1 : ST0;
    __syncthreads();
#pragma unroll
    for (int i = 0; i < 8; ++i) { const int idx = t8 + 256 * i, rr = idx >> 5, cc = idx & 31; *(LAS bf16x8*)(L + QS + rr * QSTR + cc * 16) = G[i]; }
    float lg2s = c.lg2; asm volatile("" : "+v"(lg2s));
    int t8o = t8; asm volatile("" : "+v"(t8o));
#pragma unroll
    for (int i = 0; i < 2; ++i) { const int idx = t8 + 256 * i, rr = idx >> 3, cc = idx & 7;
        const int rro = (t8o >> 3) + 32 * i;
        const u32x4 w = *reinterpret_cast<const u32x4*>(&G[8 + i]); u32x4 s; const float f = __builtin_amdgcn_exp2f((float)(c.dir ? rro : 63 - rro) * lg2s);
        s.x = cvt_pk_bf16(bf_lo(w.x) * f, bf_hi(w.x) * f); s.y = cvt_pk_bf16(bf_lo(w.y) * f, bf_hi(w.y) * f);
        s.z = cvt_pk_bf16(bf_lo(w.z) * f, bf_hi(w.z) * f); s.w = cvt_pk_bf16(bf_lo(w.w) * f, bf_hi(w.w) * f);
        *(LAS u32x4*)(L + VS + rr * VSTR + cc * 16) = s; }
    __syncthreads();
    { const int sn = (step + 2 < NSTEP) ? step + 2 : NSTEP - 1; const int rown = cid_row(step_cid(c.dir, sn));
#pragma unroll
        for (int i = 0; i < 8; ++i) { const int idx = t8 + 256 * i, rr = idx >> 5, cc = idx & 31; G[i] = *(const bf16x8*)(c.P + (size_t)(rown + rr) * LDP + c.qcol0 + cc * 8); }
#pragma unroll
        for (int i = 0; i < 2; ++i) { const int idx = t8 + 256 * i, rr = idx >> 3, cc = idx & 7; G[8 + i] = *(const bf16x8*)(c.P + (size_t)(rown + rr) * LDP + c.vcol0 + cc * 8); } }
    { const int sn = (step + 1 < NSTEP) ? step + 1 : NSTEP - 1; const bf16_t* ap = c.Ad + (size_t)step_cid(c.dir, sn) * ATT_TILE + (size_t)(32 * qb + r32) * 64 + 8 * hi;
        atn[0] = *(const bf16x8*)ap; atn[1] = *(const bf16x8*)(ap + 16); atn[2] = *(const bf16x8*)(ap + 32); atn[3] = *(const bf16x8*)(ap + 48); }
    f32x16 acc1 = {};
#pragma unroll 4
    for (int s = 0; s < 16; ++s) acc1 = __builtin_amdgcn_mfma_f32_32x32x16_bf16(rowfrag(L + stc, QSTR, 32 * xb, 16 * s, r32, hi), rowfrag(L + QS, QSTR, 32 * qb, 16 * s, r32, hi), acc1, 0, 0, 0);
    { int r32o = r32; asm volatile("" : "+v"(r32o)); const int a = 32 * qb + r32o;
      const float qd = __builtin_amdgcn_exp2f((float)(c.dir ? 64 - a : a + 1) * lg2s);
#pragma unroll
      for (int r = 0; r < 16; ++r) acc1[r] *= qd; }
    const unsigned vb1_ = tr_lane_base(c.Lb + VS, VSTR, lane) + (unsigned)(64 * xb);
    s16x4 vl0, vh0, vl1, vh1, vl2, vh2, vl3, vh3;
    TR2(vl0, vh0, vb1_, 0 * VSTR, VSTR); TR2(vl1, vh1, vb1_, 16 * VSTR, VSTR); TR2(vl2, vh2, vb1_, 32 * VSTR, VSTR); TR2(vl3, vh3, vb1_, 48 * VSTR, VSTR);
    tr_wait();
    acc1 = __builtin_amdgcn_mfma_f32_32x32x16_bf16(TRPK(vl0, vh0), atc[0], acc1, 0, 0, 0);
    acc1 = __builtin_amdgcn_mfma_f32_32x32x16_bf16(TRPK(vl1, vh1), atc[1], acc1, 0, 0, 0);
    acc1 = __builtin_amdgcn_mfma_f32_32x32x16_bf16(TRPK(vl2, vh2), atc[2], acc1, 0, 0, 0);
    acc1 = __builtin_amdgcn_mfma_f32_32x32x16_bf16(TRPK(vl3, vh3), atc[3], acc1, 0, 0, 0);
    bf16_t* op = c.Ob + (size_t)(row0 + 32 * qb + r32) * 8192 + c.h * 512 + c.ebI * 64 + 32 * xb + 4 * hi;
#pragma unroll
    for (int g4 = 0; g4 < 4; ++g4) { u32x2 w; w.x = cvt_pk_bf16(acc1[4 * g4], acc1[4 * g4 + 1]); w.y = cvt_pk_bf16(acc1[4 * g4 + 2], acc1[4 * g4 + 3]); *(u32x2*)(op + 8 * g4) = w; }
}
__device__ __forceinline__ void ret_step_s(LAS unsigned char* L, const RetCtx& c, int step, bf16x8 (&G)[8], f32x16& S00, f32x16& S01, f32x16& S10, f32x16& S11, int t8, int wid, int lane) {
    using namespace ret;
    const int r32 = lane & 31, hi = lane >> 5, sw = wid & 3;
    const int stn = (step & 1) ? ST0 : ST1;
    __syncthreads();
#pragma unroll
    for (int i = 0; i < 8; ++i) { const int idx = t8 + 256 * i, rr = idx >> 5, cc = idx & 31; *(LAS bf16x8*)(L + KS + rr * KSTR + cc * 16) = G[i]; }
    __syncthreads();
    { const int sn = (step + 2 < NSTEP) ? step + 2 : NSTEP - 1; const int rown = cid_row(step_cid(c.dir, sn));
#pragma unroll
        for (int i = 0; i < 8; ++i) { const int idx = t8 + 256 * i, rr = idx >> 5, cc = idx & 31; G[i] = *(const bf16x8*)(c.P + (size_t)(rown + rr) * LDP + c.kcol0 + cc * 8); } }
    S00 *= c.cdec; S01 *= c.cdec; S10 *= c.cdec; S11 *= c.cdec;
    const unsigned vbase = tr_lane_base(c.Lb + VS, VSTR, lane);
    const unsigned kbase = tr_lane_base(c.Lb + KS, KSTR, lane) + (unsigned)(128 * sw);
#define RET_SUPD(S0_) do { s16x4 ka0, kb0, kc0, kd0, va0, vb0, vc0, vd0; \
    TR2(ka0, kb0, kbase, (16 * (S0_)) * KSTR, KSTR); TR2(kc0, kd0, kbase, (16 * (S0_)) * KSTR + 64, KSTR); TR2(va0, vb0, vbase, (16 * (S0_)) * VSTR, VSTR); TR2(vc0, vd0, vbase, (16 * (S0_)) * VSTR + 64, VSTR); \
    tr_wait(); \
    { const bf16x8 k0_ = TRPK(ka0, kb0), k1_ = TRPK(kc0, kd0), v0_ = TRPK(va0, vb0), v1_ = TRPK(vc0, vd0); \
      S00 = __builtin_amdgcn_mfma_f32_32x32x16_bf16(k0_, v0_, S00, 0, 0, 0); S01 = __builtin_amdgcn_mfma_f32_32x32x16_bf16(k0_, v1_, S01, 0, 0, 0); \
      S10 = __builtin_amdgcn_mfma_f32_32x32x16_bf16(k1_, v0_, S10, 0, 0, 0); S11 = __builtin_amdgcn_mfma_f32_32x32x16_bf16(k1_, v1_, S11, 0, 0, 0); } \
    __builtin_amdgcn_sched_barrier(0); } while (0)
    RET_SUPD(0); RET_SUPD(1); RET_SUPD(2); RET_SUPD(3);
#undef RET_SUPD
#define RET_STW(S_, T_, EB_) do { _Pragma("unroll") for (int g4 = 0; g4 < 4; ++g4) { u32x2 w; w.x = cvt_pk_bf16(S_[4 * g4], S_[4 * g4 + 1]); w.y = cvt_pk_bf16(S_[4 * g4 + 2], S_[4 * g4 + 3]); \
        *(LAS u32x2*)(L + stn + (32 * (EB_) + r32) * QSTR + (64 * sw + 32 * (T_) + 8 * g4 + 4 * hi) * 2) = w; } } while (0)
    RET_STW(S00, 0, 0); RET_STW(S01, 0, 1); RET_STW(S10, 1, 0); RET_STW(S11, 1, 1);
#undef RET_STW
}
__device__ __forceinline__ void retention_phase(LAS unsigned char* L, const Params& p) {
    using namespace ret;
    const int tid = threadIdx.x, wid = __builtin_amdgcn_readfirstlane(tid >> 6), lane = tid & 63, r32 = lane & 31, hi = lane >> 5, t8 = tid & 255;
    for (int item = blockIdx.x; item < 256; item += gridDim.x) {
        const int grp = (item & 7) * 4 + (item >> 6), ebI = (item >> 3) & 7, h = grp >> 1, dir = grp & 1;
        RetCtx c;
        c.P = (const bf16_t*)(p.ws + WS_P); c.Ad = (const bf16_t*)(p.ws + WS_G) + (dir ? ATT_DIR : 0) + (size_t)h * 260 * ATT_TILE; c.Ob = (bf16_t*)(p.ws + (dir ? WS_OB : WS_OF));
        c.lg2 = p.in[I_RT_LD][dir * 16 + h] * L2E; c.cdec = __builtin_amdgcn_exp2f(64.0f * c.lg2);
        c.dir = dir; c.h = h; c.ebI = ebI; c.qcol0 = 12288 + h * 256; c.kcol0 = h * 256; c.vcol0 = 4096 + h * 512 + ebI * 64; c.Lb = (unsigned)(uintptr_t)L;
        __syncthreads();
        for (int i = tid; i < 33792 / 16; i += NTHREADS) *(LAS u32x4*)(L + ST0 + i * 16) = (u32x4){0u, 0u, 0u, 0u};
        const int row_0 = cid_row(step_cid(dir, 0)), row_1 = cid_row(step_cid(dir, 1));
        if (wid < 4) {
            bf16x8 gA[10], gB[10], atA[4], atB[4] = {};
            { const int qb = (wid & 3) >> 1; const bf16_t* ap = c.Ad + (size_t)step_cid(dir, 0) * ATT_TILE + (size_t)(32 * qb + r32) * 64 + 8 * hi;
              atA[0] = *(const bf16x8*)ap; atA[1] = *(const bf16x8*)(ap + 16); atA[2] = *(const bf16x8*)(ap + 32); atA[3] = *(const bf16x8*)(ap + 48); }
#pragma unroll
            for (int i = 0; i < 8; ++i) { const int idx = t8 + 256 * i, rr = idx >> 5, cc = idx & 31; gA[i] = *(const bf16x8*)(c.P + (size_t)(row_0 + rr) * LDP + c.qcol0 + cc * 8); }
#pragma unroll
            for (int i = 0; i < 2; ++i) { const int idx = t8 + 256 * i, rr = idx >> 3, cc = idx & 7; gA[8 + i] = *(const bf16x8*)(c.P + (size_t)(row_0 + rr) * LDP + c.vcol0 + cc * 8); }
            asm volatile("" ::: "memory");
#pragma unroll
            for (int i = 0; i < 8; ++i) { const int idx = t8 + 256 * i, rr = idx >> 5, cc = idx & 31; gB[i] = *(const bf16x8*)(c.P + (size_t)(row_1 + rr) * LDP + c.qcol0 + cc * 8); }
#pragma unroll
            for (int i = 0; i < 2; ++i) { const int idx = t8 + 256 * i, rr = idx >> 3, cc = idx & 7; gB[8 + i] = *(const bf16x8*)(c.P + (size_t)(row_1 + rr) * LDP + c.vcol0 + cc * 8); }
            for (int step = 0; step < NSTEP; step += 2) {
                ret_step_o(L, c, step, gA, atA, atB, t8, wid, lane);
                ret_step_o(L, c, step + 1, gB, atB, atA, t8, wid, lane);
            }
        } else {
            bf16x8 gA[8], gB[8];
            f32x16 S00 = {}, S01 = {}, S10 = {}, S11 = {};
#pragma unroll
            for (int i = 0; i < 8; ++i) { const int idx = t8 + 256 * i, rr = idx >> 5, cc = idx & 31; gA[i] = *(const bf16x8*)(c.P + (size_t)(row_0 + rr) * LDP + c.kcol0 + cc * 8); }
            asm volatile("" ::: "memory");
#pragma unroll
            for (int i = 0; i < 8; ++i) { const int idx = t8 + 256 * i, rr = idx >> 5, cc = idx & 31; gB[i] = *(const bf16x8*)(c.P + (size_t)(row_1 + rr) * LDP + c.kcol0 + cc * 8); }
            for (int step = 0; step < NSTEP; step += 2) {
                ret_step_s(L, c, step, gA, S00, S01, S10, S11, t8, wid, lane);
                ret_step_s(L, c, step + 1, gB, S00, S01, S10, S11, t8, wid, lane);
            }
        }
    }
}
__device__ __forceinline__ void retnorm_phase(const Params& p) {
    const bf16_t* OF = (const bf16_t*)(p.ws + WS_OF); const bf16_t* OB = (const bf16_t*)(p.ws + WS_OB); const bf16_t* P = (const bf16_t*)(p.ws + WS_P); bf16_t* G = (bf16_t*)(p.ws + WS_G);
    const int wid = threadIdx.x >> 6, lane = threadIdx.x & 63;
    for (int unit0 = (blockIdx.x * 8 + wid) * 4; unit0 < MROWS * 16; unit0 += gridDim.x * 32) {
        u32x4 a[4], b[4], z[4];
#pragma unroll
        for (int j = 0; j < 4; ++j) { const int unit = unit0 + j, row = unit >> 4, h = unit & 15; const size_t off = (size_t)row * 8192 + h * 512 + lane * 8;
            a[j] = __builtin_nontemporal_load((const u32x4*)(OF + off)); b[j] = __builtin_nontemporal_load((const u32x4*)(OB + off)); z[j] = __builtin_nontemporal_load((const u32x4*)(P + (size_t)row * RT_INW + 16384 + h * 512 + lane * 8)); }
#pragma unroll
        for (int j = 0; j < 4; ++j) { const int unit = unit0 + j, row = unit >> 4, h = unit & 15; const size_t off = (size_t)row * 8192 + h * 512 + lane * 8;
            float o[8];
            o[0] = bf_lo(a[j].x) + bf_lo(b[j].x); o[1] = bf_hi(a[j].x) + bf_hi(b[j].x); o[2] = bf_lo(a[j].y) + bf_lo(b[j].y); o[3] = bf_hi(a[j].y) + bf_hi(b[j].y);
            o[4] = bf_lo(a[j].z) + bf_lo(b[j].z); o[5] = bf_hi(a[j].z) + bf_hi(b[j].z); o[6] = bf_lo(a[j].w) + bf_lo(b[j].w); o[7] = bf_hi(a[j].w) + bf_hi(b[j].w);
            float s = ((o[0] + o[1]) + (o[2] + o[3])) + ((o[4] + o[5]) + (o[6] + o[7]));
#pragma unroll
            for (int x = 32; x >= 1; x >>= 1) s += __shfl_xor(s, x);
            const float mu = s * (1.0f / 512.0f);
            float q = 0.f;
#pragma unroll
            for (int k = 0; k < 8; ++k) { o[k] -= mu; q += o[k] * o[k]; }
#pragma unroll
            for (int x = 32; x >= 1; x >>= 1) q += __shfl_xor(q, x);
            const float rstd = 1.0f / sqrtf(q * (1.0f / 512.0f) + LN_EPS);
            u32x4 w;
            w.x = cvt_pk_bf16(o[0] * rstd * silu_f(bf_lo(z[j].x)), o[1] * rstd * silu_f(bf_hi(z[j].x))); w.y = cvt_pk_bf16(o[2] * rstd * silu_f(bf_lo(z[j].y)), o[3] * rstd * silu_f(bf_hi(z[j].y)));
            w.z = cvt_pk_bf16(o[4] * rstd * silu_f(bf_lo(z[j].z)), o[5] * rstd * silu_f(bf_hi(z[j].z))); w.w = cvt_pk_bf16(o[6] * rstd * silu_f(bf_lo(z[j].w)), o[7] * rstd * silu_f(bf_hi(z[j].w)));
            *(u32x4*)(G + off) = w; }
    }
}

__device__ __forceinline__ int s5_row(int dir, int n) { return n < NCTX ? (dir ? SEQ + NCTX - 1 - n : SEQ + n) : (dir ? SEQ - 1 - (n - NCTX) : n - NCTX); }
__device__ __forceinline__ bf16x8 pack8(const float* v) { u32x4 w; w.x = cvt_pk_bf16(v[0], v[1]); w.y = cvt_pk_bf16(v[2], v[3]); w.z = cvt_pk_bf16(v[4], v[5]); w.w = cvt_pk_bf16(v[6], v[7]); return *reinterpret_cast<bf16x8*>(&w); }
__device__ __forceinline__ void s5_scan_phase(LAS unsigned char* L, const Params& p) {
    const bf16_t* P = (const bf16_t*)(p.ws + WS_P);
    const int tid = threadIdx.x, wid = __builtin_amdgcn_readfirstlane(tid >> 6), lane = tid & 63, pl = lane & 31, hi = lane >> 5;
    const int dir = wid >> 2, seg = wid & 3;
    constexpr int NBS = (MROWS / 32) / 4;
    bf16_t* Y = (bf16_t*)(p.ws + WS_OF) + (size_t)dir * SEQ * DM;
    LAS unsigned char* T = L + wid * 10240;
    LAS float* EX = (LAS float*)(L + 81920);
    const unsigned Tb = (unsigned)(uintptr_t)T;
    for (int g = blockIdx.x; g < 256; g += gridDim.x) {
        const float dt = expf(p.in[I_S5_LDT][dir * 256 + g]);
        float lr[2], li[2], l16r[2], l16i[2], lsr[2], lsi[2]; bf16x8 Bre[2], Bim[2];
#pragma unroll
        for (int pb = 0; pb < 2; ++pb) {
            const int pp = pb * 32 + pl;
            const float are = p.in[I_S5_ARE][(size_t)(dir * 256 + g) * 64 + pp], aim = p.in[I_S5_AIM][(size_t)(dir * 256 + g) * 64 + pp];
            const float er = expf(are * dt); float sn, cs; sincosf(aim * dt, &sn, &cs);
            lr[pb] = er * cs; li[pb] = er * sn;
            { const float e16 = expf(are * dt * 16.0f); float s16, c16; sincosf(aim * dt * 16.0f, &s16, &c16); l16r[pb] = e16 * c16; l16i[pb] = e16 * s16; }
            { const float es = expf(are * dt * (float)(NBS * 32)); float ss, cs2; sincosf(aim * dt * (float)(NBS * 32), &ss, &cs2); lsr[pb] = es * cs2; lsi[pb] = es * ss; }
            const float den = are * are + aim * aim, nr = lr[pb] - 1.0f, ni = li[pb];
            const float cr = (nr * are + ni * aim) / den, ci = (ni * are - nr * aim) / den;
            float br_[8], bi_[8];
#pragma unroll
            for (int j = 0; j < 8; ++j) { const size_t bo = ((size_t)g * 64 + pp) * 16 + 8 * hi + j; const float br = p.in[I_S5_BRE][bo], bi = p.in[I_S5_BIM][bo];
                br_[j] = cr * br - ci * bi; bi_[j] = cr * bi + ci * br; }
            Bre[pb] = pack8(br_); Bim[pb] = pack8(bi_);
        }
        const int slot_proc = 16 * ((pl >> 2) & 1) + (pl & 3) + 4 * (pl >> 3);
        const int nb0 = seg * NBS;
        float cinr[2] = {0.f, 0.f}, cini[2] = {0.f, 0.f};
        if (seg < 3) {
            bf16x8 uf = *(const bf16x8*)(P + (size_t)s5_row(dir, nb0 * 32 + slot_proc) * S5_INW + 16 * g + 8 * hi);
            for (int nb = nb0; nb < nb0 + NBS; ++nb) {
                const bf16x8 ucur = uf;
                if (nb + 1 < nb0 + NBS) uf = *(const bf16x8*)(P + (size_t)s5_row(dir, nb * 32 + 32 + slot_proc) * S5_INW + 16 * g + 8 * hi);
#pragma unroll
                for (int pb = 0; pb < 2; ++pb) {
                    const f32x16 xr = __builtin_amdgcn_mfma_f32_32x32x16_bf16(ucur, Bre[pb], f32x16{}, 0, 0, 0);
                    const f32x16 xi = __builtin_amdgcn_mfma_f32_32x32x16_bf16(ucur, Bim[pb], f32x16{}, 0, 0, 0);
                    const float a = lr[pb], b = li[pb];
                    float cr = hi ? 0.f : cinr[pb], ci = hi ? 0.f : cini[pb];
#pragma unroll
                    for (int r = 0; r < 16; ++r) { const float nr = fmaf(a, cr, fmaf(-b, ci, xr[r])), ni = fmaf(a, ci, fmaf(b, cr, xi[r])); cr = nr; ci = ni; }
                    const float e0r = __shfl(cr, pl), e0i = __shfl(ci, pl), e1r = __shfl(cr, pl + 32), e1i = __shfl(ci, pl + 32);
                    cinr[pb] = e1r + l16r[pb] * e0r - l16i[pb] * e0i; cini[pb] = e1i + l16r[pb] * e0i + l16i[pb] * e0r;
                }
            }
            if (hi == 0) {
#pragma unroll
                for (int pb = 0; pb < 2; ++pb) { EX[(((dir * 4 + seg) * 2 + pb) * 2 + 0) * 32 + pl] = cinr[pb]; EX[(((dir * 4 + seg) * 2 + pb) * 2 + 1) * 32 + pl] = cini[pb]; }
            }
        }
        __syncthreads();
#pragma unroll
        for (int pb = 0; pb < 2; ++pb) {
            float xr = 0.f, xi = 0.f;
            for (int s = 0; s < seg; ++s) { const float er = EX[(((dir * 4 + s) * 2 + pb) * 2 + 0) * 32 + pl], ei = EX[(((dir * 4 + s) * 2 + pb) * 2 + 1) * 32 + pl];
                const float nr = lsr[pb] * xr - lsi[pb] * xi + er, ni = lsr[pb] * xi + lsi[pb] * xr + ei; xr = nr; xi = ni; }
            cinr[pb] = xr; cini[pb] = xi;
        }
        bf16x8 Cf[8];
#pragma unroll
        for (int s = 0; s < 8; ++s) { float cv[8];
#pragma unroll
            for (int j = 0; j < 8; ++j) { const int k = 16 * s + 8 * hi + j, x = k >> 6, pp = k & 63; const size_t co = ((size_t)g * 16 + (pl & 15)) * 64 + pp;
                const float v = x ? -p.in[I_S5_CIM][co] : p.in[I_S5_CRE][co]; cv[j] = (pl < 16) ? v : 0.f; }
            Cf[s] = pack8(cv); }
        bf16x8 uf = *(const bf16x8*)(P + (size_t)s5_row(dir, nb0 * 32 + slot_proc) * S5_INW + 16 * g + 8 * hi);
        for (int nb = nb0; nb < nb0 + NBS; ++nb) {
            const int n0 = nb * 32;
            const bf16x8 ucur = uf;
            if (nb + 1 < nb0 + NBS) uf = *(const bf16x8*)(P + (size_t)s5_row(dir, n0 + 32 + slot_proc) * S5_INW + 16 * g + 8 * hi);
            f32x16 xr[2], xi[2];
#pragma unroll
            for (int pb = 0; pb < 2; ++pb) {
                xr[pb] = __builtin_amdgcn_mfma_f32_32x32x16_bf16(ucur, Bre[pb], f32x16{}, 0, 0, 0);
                xi[pb] = __builtin_amdgcn_mfma_f32_32x32x16_bf16(ucur, Bim[pb], f32x16{}, 0, 0, 0);
            }
#pragma unroll
            for (int pb = 0; pb < 2; ++pb) {
                const float a = lr[pb], b = li[pb];
                float cr = cinr[pb], ci = cini[pb];
#pragma unroll
                for (int r = 0; r < 16; ++r) { const float nr = fmaf(a, cr, fmaf(-b, ci, xr[pb][r])), ni = fmaf(a, ci, fmaf(b, cr, xi[pb][r])); cr = nr; ci = ni; }
                const float e0r = __shfl(cr, pl), e0i = __shfl(ci, pl);
                cr = hi ? e0r : cinr[pb]; ci = hi ? e0i : cini[pb];
#pragma unroll
                for (int r = 0; r < 16; ++r) { const float nr = fmaf(a, cr, fmaf(-b, ci, xr[pb][r])), ni = fmaf(a, ci, fmaf(b, cr, xi[pb][r])); cr = nr; ci = ni; xr[pb][r] = nr; xi[pb][r] = ni; }
                cinr[pb] = __shfl(cr, pl + 32); cini[pb] = __shfl(ci, pl + 32);
            }
            if (n0 >= NCTX) {
#pragma unroll
                for (int pb = 0; pb < 2; ++pb) {
                    u32x4 w0, w1;
                    w0.x = cvt_pk_bf16(xr[pb][0], xr[pb][1]); w0.y = cvt_pk_bf16(xr[pb][2], xr[pb][3]); w0.z = cvt_pk_bf16(xr[pb][4], xr[pb][5]); w0.w = cvt_pk_bf16(xr[pb][6], xr[pb][7]);
                    w1.x = cvt_pk_bf16(xr[pb][8], xr[pb][9]); w1.y = cvt_pk_bf16(xr[pb][10], xr[pb][11]); w1.z = cvt_pk_bf16(xr[pb][12], xr[pb][13]); w1.w = cvt_pk_bf16(xr[pb][14], xr[pb][15]);
                    LAS unsigned char* d = T + (pb * 32 + pl) * 80 + 32 * hi;
                    *(LAS u32x4*)d = w0; *(LAS u32x4*)(d + 16) = w1;
                    w0.x = cvt_pk_bf16(xi[pb][0], xi[pb][1]); w0.y = cvt_pk_bf16(xi[pb][2], xi[pb][3]); w0.z = cvt_pk_bf16(xi[pb][4], xi[pb][5]); w0.w = cvt_pk_bf16(xi[pb][6], xi[pb][7]);
                    w1.x = cvt_pk_bf16(xi[pb][8], xi[pb][9]); w1.y = cvt_pk_bf16(xi[pb][10], xi[pb][11]); w1.z = cvt_pk_bf16(xi[pb][12], xi[pb][13]); w1.w = cvt_pk_bf16(xi[pb][14], xi[pb][15]);
                    d += 64 * 80;
                    *(LAS u32x4*)d = w0; *(LAS u32x4*)(d + 16) = w1;
                }
                asm volatile("s_waitcnt lgkmcnt(0)" ::: "memory");
                s16x4 tl[8], th[8];
#pragma unroll
                for (int s = 0; s < 8; ++s) trfrag_issue(tl[s], th[s], Tb, 80, 16 * s, 0, lane);
                tr_wait();
                f32x16 y = {};
#pragma unroll
                for (int s = 0; s < 8; ++s) y = __builtin_amdgcn_mfma_f32_32x32x16_bf16(Cf[s], TRPK(tl[s], th[s]), y, 0, 0, 0);
                { bf16_t* yp = Y + (size_t)s5_row(dir, n0 + pl) * DM + 16 * g + 4 * hi;
                  u32x2 w0, w1; w0.x = cvt_pk_bf16(y[0], y[1]); w0.y = cvt_pk_bf16(y[2], y[3]); w1.x = cvt_pk_bf16(y[4], y[5]); w1.y = cvt_pk_bf16(y[6], y[7]);
                  *(u32x2*)yp = w0; *(u32x2*)(yp + 8) = w1; }
                asm volatile("s_waitcnt lgkmcnt(0)" ::: "memory");
            }
        }
        __syncthreads();
    }
}
__device__ __forceinline__ void s5_prep_phase(LAS unsigned char* lds, const Params& p) {
    const bf16_t* YF = (const bf16_t*)(p.ws + WS_OF); const bf16_t* YB = YF + (size_t)SEQ * DM; const bf16_t* P = (const bf16_t*)(p.ws + WS_P);
    bf16_t* A2 = (bf16_t*)(p.ws + WS_OB);
    LAS float* dsk = (LAS float*)lds;
    __syncthreads();
    for (int k = threadIdx.x; k < 1024; k += NTHREADS) *(LAS f32x4*)(dsk + 4 * k) = *(const f32x4*)(p.in[I_S5_D] + 4 * k);
    __syncthreads();
    const size_t nchunk = (size_t)SEQ * (DM / 8), stride = (size_t)gridDim.x * NTHREADS;
    for (size_t ch0 = (size_t)blockIdx.x * NTHREADS + threadIdx.x; ch0 < nchunk; ch0 += 4 * stride) {
        u32x4 a[4], b[4], u[4];
#pragma unroll
        for (int j = 0; j < 4; ++j) { const size_t ch = ch0 + j * stride; if (ch < nchunk) { const int row = (int)(ch >> 9), col = (int)(ch & 511) * 8;
            a[j] = __builtin_nontemporal_load((const u32x4*)(YF + (size_t)row * DM + col)); b[j] = __builtin_nontemporal_load((const u32x4*)(YB + (size_t)row * DM + col)); u[j] = __builtin_nontemporal_load((const u32x4*)(P + (size_t)row * S5_INW + col)); } }
#pragma unroll
        for (int j = 0; j < 4; ++j) { const size_t ch = ch0 + j * stride; if (ch < nchunk) { const int row = (int)(ch >> 9), col = (int)(ch & 511) * 8;
            const f32x4 d0 = *(const LAS f32x4*)(dsk + col), d1 = *(const LAS f32x4*)(dsk + col + 4);
            float v[8];
            v[0] = bf_lo(a[j].x) + bf_lo(b[j].x) + d0[0] * bf_lo(u[j].x); v[1] = bf_hi(a[j].x) + bf_hi(b[j].x) + d0[1] * bf_hi(u[j].x);
            v[2] = bf_lo(a[j].y) + bf_lo(b[j].y) + d0[2] * bf_lo(u[j].y); v[3] = bf_hi(a[j].y) + bf_hi(b[j].y) + d0[3] * bf_hi(u[j].y);
            v[4] = bf_lo(a[j].z) + bf_lo(b[j].z) + d1[0] * bf_lo(u[j].z); v[5] = bf_hi(a[j].z) + bf_hi(b[j].z) + d1[1] * bf_hi(u[j].z);
            v[6] = bf_lo(a[j].w) + bf_lo(b[j].w) + d1[2] * bf_lo(u[j].w); v[7] = bf_hi(a[j].w) + bf_hi(b[j].w) + d1[3] * bf_hi(u[j].w);
#pragma unroll
            for (int k = 0; k < 8; ++k) { const float x = v[k], zz = 0.7978845608028654f * (x + 0.044715f * x * x * x); const float t = 1.0f - 2.0f * __builtin_amdgcn_rcpf(__expf(2.0f * zz) + 1.0f); v[k] = 0.5f * x * (1.0f + t); }
            u32x4 w; w.x = cvt_pk_bf16(v[0], v[1]); w.y = cvt_pk_bf16(v[2], v[3]); w.z = cvt_pk_bf16(v[4], v[5]); w.w = cvt_pk_bf16(v[6], v[7]);
            *(u32x4*)(A2 + (size_t)row * DM + col) = w; } }
    }
}

constexpr int N_PHASES = 21;
typedef const __attribute__((address_space(4))) Params* KParamsPtr;
__global__ void __launch_bounds__(NTHREADS, 2) mega_fwd(Params p) {
    extern __shared__ __attribute__((aligned(16))) unsigned char lds_raw[];
    LAS unsigned char* L = (LAS unsigned char*)lds_raw;
    const int tid = threadIdx.x;
    if (tid < 4) ((LAS unsigned*)(L + MISC_OFF))[tid] = 0u;
    __syncthreads();
    const int lo = p.ph_lo, hi = p.ph_hi;
    XcdBarrier bar; bar.bar = (unsigned*)(p.ws + WS_CTL); bar.x = 0; bar.st = (volatile LAS unsigned*)(L + MISC_OFF);
    if (hi - lo > 1) bar = xcd_barrier_post((unsigned*)(p.ws + WS_CTL), (volatile LAS unsigned*)(L + MISC_OFF));
#ifndef PH_MASK
#define PH_MASK 0x1fffff
#endif
#define IN(k) (((PH_MASK >> (k)) & 1) && lo <= (k) && (k) < hi)
#define SEAM(k) do { if (IN((k) + 1)) xcd_barrier(bar); } while (0)
#ifndef REP_MASK
#define REP_MASK 0
#endif
#define REP(k) (((REP_MASK) >> (k)) & 1)
#define PHASE(k, ...) if (IN(k)) { _Pragma("nounroll") for (int rep_ = 0; rep_ <= REP(k); ++rep_) { { LOADP(); __VA_ARGS__ } if (rep_ < REP(k)) xcd_barrier(bar); } SEAM(k); }
    const int GR = gridDim.x, BX = blockIdx.x;
#define LOADP() Params lp; { KParamsPtr q_ = (KParamsPtr)__builtin_amdgcn_kernarg_segment_ptr(); asm volatile("" : "+s"(q_)); __builtin_memcpy(&lp, q_, sizeof(Params)); } \
    const float* mod = (const float*)(lp.ws + WS_MOD); const bf16_t* Wb = (const bf16_t*)(lp.ws + WS_W); float* X = (float*)(lp.ws + WS_X); \
    bf16_t* H = (bf16_t*)(lp.ws + WS_H); bf16_t* Pb = (bf16_t*)(lp.ws + WS_P); bf16_t* G = (bf16_t*)(lp.ws + WS_G); \
    const float* ropeA = (const float*)(lp.ws + WS_ROPEA); const float* ropeB = (const float*)(lp.ws + WS_ROPEB); \
    (void)mod; (void)Wb; (void)X; (void)H; (void)Pb; (void)G; (void)ropeA; (void)ropeB;
#define DYN_ORDER(S_, MM, NN, GIDX) pg8::DynOrder S_; S_.init((MM), (NN), (unsigned*)(lp.ws + WS_CTL + 16384 + (GIDX) * 2048), (volatile LAS int*)(L + 131072), (int)xb_xcc_id()); S_.prime()
#define RUN_IN(WOFF, NN, EPI, GIDX) do { pg8::Gemm g_{H, Wb + (WOFF), MROWS, (NN), DM}; DYN_ORDER(S_, MROWS, (NN), (GIDX)); \
        pg8::gemm_phase<decltype(EPI), pg8::DynOrder, true, true>(L, g_, S_, EPI); } while (0)
#define RUN_OUT(LAYER, WOFF, KK, CTX) do { pg8::Gemm g_{G, Wb + (WOFF), SEQ, DM, (KK)}; \
        pg8::EpiOut E_{H, DM, (float*)(lp.ws + WS_YS)}; \
        pg8::DynOrder S_; S_.init(SEQ, DM, (unsigned*)(lp.ws + WS_CTL + 16384 + (4 + (LAYER)) * 2048), (volatile LAS int*)(L + 131072), (int)xb_xcc_id(), (CTX) ? 16 : 0, SEQ / 256, (KK) / 64 / 16); S_.prime(); \
        pg8::gemm_phase<pg8::EpiOut, pg8::DynOrder, true, true>(L, g_, S_, E_); } while (0)

    PHASE(0, p0_prologue(L, lp);)
    PHASE(1, p1_modulate(L, lp);)
    PHASE(2, pg8::EpiIn<0> E{Pb, WA_INW, ropeA, ropeB, SEQ}; RUN_IN(W_WA_IN, WA_INW, E, 0); cvt_tail(L, lp, 0);)
    PHASE(3, mixerA_phase(lds_raw, lp);)
    PHASE(4, RUN_OUT(0, W_WA_OUT, 4096, true);)
    PHASE(5, ln_phase(L, lp, 0, MROWS, X, true, true);)
    PHASE(6, pg8::EpiIn<1> E{Pb, RT_INW, ropeA, ropeB, SEQ}; RUN_IN(W_RT_IN, RT_INW, E, 1); cvt_tail(L, lp, 1);)
    PHASE(7, retatt_phase(L, lp); xcd_barrier(bar); retention_phase(L, lp);)
    PHASE(8, retnorm_phase(lp);)
    PHASE(9, RUN_OUT(1, W_RT_OUT, 8192, true);)
    PHASE(10, ln_phase(L, lp, 1, MROWS, X, true, true);)
    PHASE(11, pg8::EpiIn<2> E{Pb, NA_INW, ropeA, ropeB, SEQ}; RUN_IN(W_NA_IN, NA_INW, E, 2); cvt_tail(L, lp, 2);)
    PHASE(12, mixerC_phase(lds_raw, lp);)
    PHASE(13, RUN_OUT(2, W_NA_OUT, 4096, true);)
    PHASE(14, ln_phase(L, lp, 2, MROWS, X, true, true);)
    PHASE(15, pg8::EpiIn<3> E{Pb, S5_INW, ropeA, ropeB, SEQ};
        { EpiCPlain EC_{Pb + (size_t)SEQ * S5_INW, S5_INW}; for (int it_ = BX; it_ < 256; it_ += GR) ctx_gemm64(L, H + (size_t)SEQ * DM, Wb + W_S5_IN, DM, it_, EC_); }
        { pg8::Gemm g_{H, Wb + W_S5_IN, SEQ, S5_INW, DM}; DYN_ORDER(S_, SEQ, S5_INW, 3); pg8::gemm_phase<pg8::EpiIn<3>, pg8::DynOrder, true, true>(L, g_, S_, E); })
    PHASE(16, s5_scan_phase(L, lp);)
    PHASE(17, s5_prep_phase(L, lp);)
    PHASE(18, const bf16_t* A2 = (const bf16_t*)(lp.ws + WS_OB);
        pg8::Gemm g_{A2, Wb + W_S5_GLU, SEQ, DM, DM}; DYN_ORDER(S_, SEQ, DM, 8);
        pg8::EpiGlu E{A2, DM, Pb, S5_INW, 4096, lp.in[I_S5_BGLU], G, DM};
        pg8::gemm_phase<pg8::EpiGlu, pg8::DynOrder, true, true>(L, g_, S_, E);)
    PHASE(19, RUN_OUT(3, W_S5_OUT, 4096, false);)
    PHASE(20, ln_phase(L, lp, 3, SEQ, lp.out, false, false);)
#undef IN
#undef SEAM
#undef RUN_IN
#undef RUN_OUT
#undef DYN_ORDER
#undef LOADP
}

#ifdef DUMP_PH
__global__ void dump_x(const float* X, float* out, size_t n) { for (size_t i = (size_t)blockIdx.x * blockDim.x + threadIdx.x; i < n; i += (size_t)gridDim.x * blockDim.x) out[i] = X[i]; }
__global__ void dump_b(const bf16_t* X, float* out, size_t n) { for (size_t i = (size_t)blockIdx.x * blockDim.x + threadIdx.x; i < n; i += (size_t)gridDim.x * blockDim.x) out[i] = bf2f(X[i]); }
#ifndef DUMP_OFF
#define DUMP_OFF WS_X
#endif
#ifndef DUMP_BF
#define DUMP_BF 0
#endif
#endif
#ifndef MK_N_LAUNCHES
#define MK_N_LAUNCHES 1
#endif
extern "C" void kernel_launch(void* const* d_in, const int* in_sizes, int n_in, void* d_out, int out_size, void* d_ws, size_t ws_size, hipStream_t stream) {
    static int grid = 0;
    if (grid == 0) {
        if (n_in != 29 || out_size != SEQ * DM || ws_size < WS_END) { fprintf(stderr, "kernel_launch: unexpected shapes: n_in %d out %d ws %zu (need %zu)\n", n_in, out_size, ws_size, (size_t)WS_END); grid = -1; return; }
        int dev = 0, cus = 0, per_cu = 0;
        if (hipGetDevice(&dev) != hipSuccess || hipDeviceGetAttribute(&cus, hipDeviceAttributeMultiprocessorCount, dev) != hipSuccess) { grid = -1; return; }
        if (hipFuncSetAttribute((const void*)mega_fwd, hipFuncAttributeMaxDynamicSharedMemorySize, LDS_BYTES) != hipSuccess) { fprintf(stderr, "kernel_launch: hipFuncSetAttribute failed\n"); grid = -1; return; }
        if (hipOccupancyMaxActiveBlocksPerMultiprocessor(&per_cu, (const void*)mega_fwd, NTHREADS, LDS_BYTES) != hipSuccess || per_cu < 1) { fprintf(stderr, "kernel_launch: occupancy query reports %d\n", per_cu); per_cu = 1; }
        (void)hipGetLastError();
        grid = cus;
    }
    if (grid < 0) return;
    if (hipMemsetAsync((char*)d_ws + WS_CTL, 0, 65536, stream) != hipSuccess) return;
    Params a{};
    for (int i = 0; i < 29; ++i) a.in[i] = (const float*)d_in[i];
    a.out = (float*)d_out; a.ws = (unsigned char*)d_ws;
    if (MK_N_LAUNCHES == 1) { a.ph_lo = 0; a.ph_hi = N_PHASES; hipLaunchKernelGGL(mega_fwd, dim3(grid), dim3(NTHREADS), LDS_BYTES, stream, a); }
#ifdef DUMP_PH
    else { for (int ph = 0; ph < DUMP_PH; ++ph) { a.ph_lo = ph; a.ph_hi = ph + 1; hipLaunchKernelGGL(mega_fwd, dim3(grid), dim3(NTHREADS), LDS_BYTES, stream, a); }
           if (DUMP_BF) hipLaunchKernelGGL(dump_b, dim3(2048), dim3(256), 0, stream, (const bf16_t*)((char*)d_ws + DUMP_OFF), (float*)d_out, (size_t)SEQ * DM);
           else hipLaunchKernelGGL(dump_x, dim3(2048), dim3(256), 0, stream, (const float*)((char*)d_ws + DUMP_OFF), (float*)d_out, (size_t)SEQ * DM); }
#else
    else for (int ph = 0; ph < N_PHASES; ++ph) { a.ph_lo = ph; a.ph_hi = ph + 1; hipLaunchKernelGGL(mega_fwd, dim3(grid), dim3(NTHREADS), LDS_BYTES, stream, a); }
#endif
    const hipError_t le = hipPeekAtLastError();
    if (le != hipSuccess) fprintf(stderr, "kernel_launch: launch failed: %s\n", hipGetErrorName(le));
}
```

```cpp
#include <hip/hip_runtime.h>
#include <cstdio>
#include <cstdint>
#include <cmath>

#define LAS __attribute__((address_space(3)))
typedef unsigned short bf16_t;
typedef short bf16x8 __attribute__((ext_vector_type(8)));
typedef short s16x4 __attribute__((ext_vector_type(4)));
typedef float f32x2 __attribute__((ext_vector_type(2)));
typedef float f32x4 __attribute__((ext_vector_type(4)));
typedef float f32x16 __attribute__((ext_vector_type(16)));
typedef unsigned u32x2 __attribute__((ext_vector_type(2)));
typedef unsigned u32x4 __attribute__((ext_vector_type(4)));

constexpr int DM = 4096, SEQ = 16384, NCTX = 256, MROWS = SEQ + NCTX;
constexpr int WA_INW = 10240, RT_INW = 24576, NA_INW = 16384, S5_INW = 8192;
constexpr float DN_ALPHA = 1.6817928305074292f;
constexpr float LN_EPS = 1e-6f;
constexpr float L2E = 1.4426950408889634f;
constexpr int NTHREADS = 512;
constexpr int LDS_BYTES = 163840;
constexpr int MISC_OFF = 163824;

constexpr size_t WS_CTL = 0;
constexpr size_t WS_MOD = 65536;
constexpr size_t WS_ROPEA = WS_MOD + 4ull * 2 * 3 * DM * 4;
constexpr size_t WS_ROPEB = WS_ROPEA + 320ull * 32 * 8;
constexpr size_t WS_W = WS_ROPEB + 16384ull * 128 * 8;
constexpr size_t W_WA_IN = 0, W_WA_OUT = W_WA_IN + 10240ull * 4096, W_RT_IN = W_WA_OUT + 4096ull * 4096, W_RT_OUT = W_RT_IN + 24576ull * 4096,
                 W_NA_IN = W_RT_OUT + 4096ull * 8192, W_NA_OUT = W_NA_IN + 16384ull * 4096, W_S5_IN = W_NA_OUT + 4096ull * 4096,
                 W_S5_GLU = W_S5_IN + 8192ull * 4096, W_S5_OUT = W_S5_GLU + 4096ull * 4096, W_END = W_S5_OUT + 4096ull * 4096;
constexpr size_t WS_X = WS_W + W_END * 2;
constexpr size_t WS_H = WS_X + (size_t)MROWS * DM * 4;
constexpr size_t WS_P = WS_H + (size_t)MROWS * DM * 2;
constexpr size_t WS_G = WS_P + (size_t)MROWS * 24576 * 2;
constexpr size_t WS_OF = WS_G + (size_t)MROWS * 8192 * 2;
constexpr size_t WS_OB = WS_OF + (size_t)MROWS * 8192 * 2;
constexpr size_t WS_YS = WS_OB + (size_t)MROWS * 8192 * 2;
constexpr size_t WS_END = WS_YS + 16ull * 256 * DM * 4;

typedef __bf16 bf16v2_t __attribute__((ext_vector_type(2)));
__device__ __forceinline__ unsigned cvt_pk_bf16(float lo, float hi) { bf16v2_t v; v[0] = (__bf16)lo; v[1] = (__bf16)hi; return __builtin_bit_cast(unsigned, v); }
__device__ __forceinline__ float bf_lo(unsigned w) { return __uint_as_float(w << 16); }
__device__ __forceinline__ float bf_hi(unsigned w) { return __uint_as_float(w & 0xffff0000u); }
__device__ __forceinline__ float bf2f(bf16_t b) { return __uint_as_float(((unsigned)b) << 16); }
__device__ __forceinline__ bf16_t f2bf(float f) { return (bf16_t)(cvt_pk_bf16(f, 0.f) & 0xffffu); }
__device__ __forceinline__ float silu_f(float v) { return v * __builtin_amdgcn_rcpf(1.0f + __expf(-v)); }
__device__ __forceinline__ float sigmoid_f(float v) { return __builtin_amdgcn_rcpf(1.0f + __expf(-v)); }

#define XB_TMO      128
#define XB_XCNT(j)  (256  + 64 * (j))
#define XB_XSUB(j)  (1280 + 64 * (j))
#define XB_XGEN(j)  (2304 + 64 * (j))
#define XB_TOP      3328
#define XB_TOPGEN   3392
#define XCD_BAR_WORDS 3456
#define XB_SPIN_CAP (1u << 18)
#define LAS __attribute__((address_space(3)))

__device__ __forceinline__ unsigned xb_ld(unsigned* p)              { return __hip_atomic_load(p, __ATOMIC_RELAXED, __HIP_MEMORY_SCOPE_AGENT); }
__device__ __forceinline__ unsigned xb_add(unsigned* p, unsigned v) { return __hip_atomic_fetch_add(p, v, __ATOMIC_RELAXED, __HIP_MEMORY_SCOPE_AGENT); }
__device__ __forceinline__ unsigned xb_xcc_id() { return (unsigned)__builtin_amdgcn_s_getreg((3 << 11) | 20) & 0xFu; }
#define XB_SPIN(cond, bar) do { unsigned _sp = 0; while (cond) { __builtin_amdgcn_s_sleep(1); \
    if ((++_sp & 255u) == 0u) { if (xb_ld(&(bar)[XB_TMO])) break; if (_sp > XB_SPIN_CAP) { atomicAdd(&(bar)[XB_TMO], 1u); break; } } } } while (0)

struct XcdBarrier {
    unsigned* bar; unsigned x;
    volatile LAS unsigned* st;
};

__device__ __forceinline__ XcdBarrier xcd_barrier_post(unsigned* bar, volatile LAS unsigned* st) {
    XcdBarrier b; b.bar = bar; b.x = xb_xcc_id(); b.st = st;
    if (threadIdx.x == 0) (void)xb_add(&bar[XB_XCNT(b.x)], 1u);
    return b;
}
__device__ __forceinline__ void xcd_barrier_complete(unsigned* bar, unsigned x, unsigned& nloc, unsigned& nx) {
    const unsigned G = gridDim.x * gridDim.y * gridDim.z;
    unsigned sum, cnt, mine, sp = 0u;
    for (;;) {
        sum = 0u; cnt = 0u; mine = 0u;
#pragma unroll
        for (unsigned j = 0; j < 16; ++j) { const unsigned c = xb_ld(&bar[XB_XCNT(j)]); sum += c; cnt += (c > 0u) ? 1u : 0u; mine = (j == x) ? c : mine; }
        if (sum == G) break;
        __builtin_amdgcn_s_sleep(1);
        if ((++sp & 255u) == 0u) { if (xb_ld(&bar[XB_TMO])) break; if (sp > XB_SPIN_CAP) { atomicAdd(&bar[XB_TMO], 1u); break; } }
    }
    nloc = mine > 0u ? mine : 1u; nx = cnt > 0u ? cnt : 1u;
}

__device__ __forceinline__ void xcd_barrier(const XcdBarrier& b) {
    asm volatile("s_waitcnt vmcnt(0)" ::: "memory");
    __syncthreads();
    if (threadIdx.x == 0) {
        unsigned* bar = b.bar;
        __builtin_amdgcn_s_waitcnt(0);
        unsigned nloc = b.st[0], nx = b.st[1];
        if (nloc == 0u) { xcd_barrier_complete(bar, b.x, nloc, nx); b.st[0] = nloc; b.st[1] = nx; }
        const unsigned old = xb_add(&bar[XB_XSUB(b.x)], 1u);
        const unsigned gen = old / nloc;
        if (old + 1u == (gen + 1u) * nloc) {
            __builtin_amdgcn_fence(__ATOMIC_RELEASE, "agent");
            asm volatile("s_waitcnt vmcnt(0)" ::: "memory");
            const unsigned og = xb_add(&bar[XB_TOP], 1u);
            const unsigned tg = og / nx;
            if (og + 1u == (tg + 1u) * nx) xb_add(&bar[XB_TOPGEN], 1u);
            else XB_SPIN(xb_ld(&bar[XB_TOPGEN]) == tg, bar);
            __builtin_amdgcn_fence(__ATOMIC_ACQUIRE, "agent");
            xb_add(&bar[XB_XGEN(b.x)], 1u);
            asm volatile("s_waitcnt vmcnt(0)" ::: "memory");
        } else {
            XB_SPIN(xb_ld(&bar[XB_XGEN(b.x)]) == gen, bar);
            __builtin_amdgcn_fence(__ATOMIC_ACQUIRE, "agent");
            asm volatile("s_waitcnt vmcnt(0)" ::: "memory");
        }
    }
    __syncthreads();
}

namespace pg8 {
#define PG8_LAS __attribute__((address_space(3)))
typedef unsigned short bf16_t;
typedef short bf16x8 __attribute__((ext_vector_type(8)));
typedef float f32x4 __attribute__((ext_vector_type(4)));
typedef unsigned u32x4 __attribute__((ext_vector_type(4)));
constexpr int BM = 256, BK = 64, HALF = 128, HTB = HALF * BK * 2  , STAGE_BYTES = 8 * HTB, NXCD = 8, WGM = 8;

__host__ __device__ __forceinline__ int lds_byte(int r, int c) { const int st = (r >> 4) * 2 + (c >> 5), rr = r & 15, cc = c & 31, ob = rr * 64 + cc * 2; return st * 1024 + (ob ^ (((ob >> 9) & 1) << 5)); }
__host__ __device__ __forceinline__ void stage_rc(int b, int& R, int& C) { const int st = b / 1024, sb = b % 1024, swz = sb ^ (((sb >> 9) & 1) << 5); R = (st >> 1) * 16 + swz / 64; C = (st & 1) * 32 + (swz % 64) / 2; }
__host__ __device__ __forceinline__ int perm32(int rho) { const int n = rho >> 4, i = rho & 15; return 8 * (i >> 2) + 4 * n + (i & 3); }

struct Unit { int pm, pn, koff, nkt, ks; };
struct Gemm { const bf16_t* A; const bf16_t* Bt; int M, N, K; };

struct StaticOrder {
    int nM, nN, nwg, G, c;
    __host__ __device__ void init(int M, int N, int G_, int c_) { nM = M / BM; nN = N / BM; nwg = nM * nN; G = G_; c = c_; }
    __host__ __device__ bool next(int i, Unit& u) const {
        const long L = (long)i * G + c; if (L >= nwg) return false;
        int wgid = (int)L; { const int q = nwg / NXCD, r = nwg % NXCD, xcd = wgid % NXCD, off = wgid / NXCD; wgid = (xcd < r ? xcd * (q + 1) : r * (q + 1) + (xcd - r) * q) + off; }
        const int nig = WGM * nN, gid = wgid / nig, fm = gid * WGM, gsz = (nM - fm) < WGM ? (nM - fm) : WGM;
        u.pm = fm + ((wgid % nig) % gsz); u.pn = (wgid % nig) / gsz; u.koff = 0; u.nkt = 0; u.ks = -1; return true;
    }
    __device__ __forceinline__ void a_ready(const Unit&) const {}
    __device__ __forceinline__ void done(const Unit&) const {}
};

struct DynOrder {
    int nM, nN, nwg, q, xcd;
    int qm, nks, pm_sub, sub_nkt;
    unsigned* ctr;
    volatile PG8_LAS int* slots;
    mutable int nf;
    __device__ void init(int M, int N, unsigned* ctr_, volatile PG8_LAS int* slots_, int xcd_, int nks_ = 0, int pm_sub_ = 0, int sub_nkt_ = 0) {
        nM = M / BM; nN = N / BM; nwg = nM * nN; qm = nwg / NXCD; nks = nks_; pm_sub = pm_sub_; sub_nkt = sub_nkt_; q = qm + (nN * nks_) / NXCD; ctr = ctr_; slots = slots_; xcd = xcd_ & 7; nf = 0; }
    __device__ __forceinline__ int fetch() const {
        for (int a = 0; a < NXCD; ++a) { const int x = (xcd + a) & 7;
            const unsigned k = __hip_atomic_fetch_add(ctr + 64 * x, 1u, __ATOMIC_RELAXED, __HIP_MEMORY_SCOPE_AGENT);
            if (k < (unsigned)qm) return x * qm + (int)k;
            if (k < (unsigned)q) return nwg + x * (q - qm) + (int)k - qm; }
        return -1;
    }
    __device__ __forceinline__ void prime() const { if (threadIdx.x == 0) { slots[0] = fetch(); slots[1] = fetch(); slots[2] = fetch(); } nf = 3; __syncthreads(); }
    __device__ __forceinline__ bool next(int i, Unit& u) const {
        const int wgid = __builtin_amdgcn_readfirstlane(slots[i & 3]);
        const bool sub = wgid >= nwg;
        const int s = sub ? wgid - nwg : 0, nk1 = nks > 0 ? nks : 1, spn = s / nk1, sks = s - spn * nk1;
        const int wm = (wgid < 0 || sub) ? 0 : wgid;
        const int x = wm / qm, k = wm - x * qm, full = WGM * nN, kk = k - full;
        Unit r;
        r.pm = sub ? pm_sub : (k < full ? WGM * x + (k % WGM) : NXCD * WGM); r.pn = sub ? spn : (k < full ? k / WGM : x * (qm - full) + kk);
        r.ks = sub ? sks : -1; r.nkt = sub ? sub_nkt : 0; r.koff = sub ? sks * sub_nkt * BK * 2 : 0;
        u = r;
        return wgid >= 0;
    }
    __device__ __forceinline__ void a_ready(const Unit&) const {}
    __device__ __forceinline__ void done(const Unit&) const { if (threadIdx.x == 0) slots[nf & 3] = fetch(); ++nf; }
};

typedef __bf16 bf16v2_t __attribute__((ext_vector_type(2)));
__device__ __forceinline__ unsigned cvt_pk_bf16(float lo, float hi) { bf16v2_t v; v[0] = (__bf16)lo; v[1] = (__bf16)hi; return __builtin_bit_cast(unsigned, v); }
__device__ __forceinline__ float e_silu(float v) { return v * __builtin_amdgcn_rcpf(1.0f + __expf(-v)); }

template <int LT> struct EpiIn {
    static constexpr bool PERM = true, AFTER_DRAIN = false;
    static constexpr int c1 = LT == 0 ? 1024 : LT == 1 ? 4096 : LT == 2 ? 8192 : 4096, c2 = LT == 0 ? 2048 : LT == 1 ? 12288 : LT == 2 ? 12288 : 8192, c3 = LT == 0 ? 6144 : LT == 1 ? 16384 : LT == 2 ? 12288 : 8192;
    static constexpr int m0 = LT == 0 ? 2 : LT == 1 ? 3 : 0, m1 = LT == 3 ? 1 : 0, m2 = LT == 0 ? 2 : LT == 1 ? 3 : LT == 2 ? 0 : 1, m3 = LT == 1 ? 0 : 1;
    bf16_t* O; int ldc;
    const float* ropeA; const float* ropeB;
    int seq_rows;
    __device__ __forceinline__ void operator()(const f32x4 (&acc)[2][2][4][2], const Unit& u, int wr, int wc, int fr, int fq) const {
        const int colt = u.pn * BM;
        int mode; float scl;
        if (colt < c1) { mode = m0; scl = (LT == 1) ? 0.0625f : 1.0f; } else if (colt < c2) { mode = m1; scl = (LT == 2) ? 0.08838834764831845f : 1.0f; }
        else if (colt < c3) { mode = m2; scl = (LT == 0) ? 0.08838834764831845f : 1.0f; } else { mode = m3; scl = 1.0f; }
        if (u.pm * BM >= seq_rows && mode >= 2) mode = 0;
        const int row0 = u.pm * BM + wr * 64 + fr, col0 = colt + wc * 32 + 8 * fq;
        if (mode >= 2) {
            f32x4 cs[2][2][2];
#define RP_ISSUE(b_) do { const int bj_ = (b_) >> 2, ai_ = ((b_) >> 1) & 1, mp_ = (b_) & 1; \
            _Pragma("unroll") for (int r_ = 0; r_ < 2; ++r_) { const int row_ = row0 + ai_ * HALF + (2 * mp_ + r_) * 16, col_ = col0 + bj_ * HALF; const float* tb_; \
                if (mode == 2) { const int jj0_ = (col_ & 127) >> 1; const int idx_ = (jj0_ < 32) ? (row_ >> 6) : 256 + (row_ & 63); tb_ = ropeA + ((size_t)idx_ * 32 + (jj0_ & 31)) * 2; } \
                else           { const int jj0_ = (col_ & 255) >> 1; tb_ = ropeB + ((size_t)row_ * 128 + jj0_) * 2; } \
                cs[(b_) & 1][r_][0] = *(const f32x4*)tb_; cs[(b_) & 1][r_][1] = *(const f32x4*)(tb_ + 4); } } while (0)
            RP_ISSUE(0);
#pragma unroll
            for (int b = 0; b < 8; ++b) {
                const int bj = b >> 2, ai = (b >> 1) & 1, mp = b & 1;
                if (b + 1 < 8) RP_ISSUE(b + 1);
#pragma unroll
                for (int r = 0; r < 2; ++r) {
                    const int m = 2 * mp + r, row = row0 + ai * HALF + m * 16;
                    const f32x4 v0 = acc[ai][bj][m][0], v1 = acc[ai][bj][m][1], cs0 = cs[b & 1][r][0], cs1 = cs[b & 1][r][1];
                    f32x4 w0, w1;
                    w0[0] = v0[0] * cs0[0] - v0[1] * cs0[1]; w0[1] = v0[1] * cs0[0] + v0[0] * cs0[1];
                    w0[2] = v0[2] * cs0[2] - v0[3] * cs0[3]; w0[3] = v0[3] * cs0[2] + v0[2] * cs0[3];
                    w1[0] = v1[0] * cs1[0] - v1[1] * cs1[1]; w1[1] = v1[1] * cs1[0] + v1[0] * cs1[1];
                    w1[2] = v1[2] * cs1[2] - v1[3] * cs1[3]; w1[3] = v1[3] * cs1[2] + v1[2] * cs1[3];
                    w0 *= scl; w1 *= scl;
                    u32x4 w; w.x = cvt_pk_bf16(w0[0], w0[1]); w.y = cvt_pk_bf16(w0[2], w0[3]); w.z = cvt_pk_bf16(w1[0], w1[1]); w.w = cvt_pk_bf16(w1[2], w1[3]);
                    *(u32x4*)(O + (size_t)row * ldc + col0 + bj * HALF) = w;
                }
            }
#undef RP_ISSUE
            return;
        }
#pragma unroll
        for (int ai = 0; ai < 2; ++ai)
#pragma unroll
            for (int m = 0; m < 4; ++m) {
                const int row = row0 + ai * HALF + m * 16;
                bf16_t* rowp = O + (size_t)row * ldc + col0;
#pragma unroll
                for (int bj = 0; bj < 2; ++bj) {
                    f32x4 v0 = acc[ai][bj][m][0], v1 = acc[ai][bj][m][1];
                    const int col = col0 + bj * HALF;
                    if (mode == 1) {
#pragma unroll
                        for (int j = 0; j < 4; ++j) { v0[j] = e_silu(v0[j]); v1[j] = e_silu(v1[j]); }
                    } else { v0 *= scl; v1 *= scl; }
                    u32x4 w; w.x = cvt_pk_bf16(v0[0], v0[1]); w.y = cvt_pk_bf16(v0[2], v0[3]); w.z = cvt_pk_bf16(v1[0], v1[1]); w.w = cvt_pk_bf16(v1[2], v1[3]);
                    *(u32x4*)(rowp + bj * HALF) = w;
                }
            }
    }
};

struct EpiOut {
    static constexpr bool PERM = true, AFTER_DRAIN = false;
    bf16_t* Y; int ldc;
    float* slab;
    __device__ __forceinline__ void operator()(const f32x4 (&acc)[2][2][4][2], const Unit& u, int wr, int wc, int fr, int fq) const {
        const int col0 = u.pn * BM + wc * 32 + 8 * fq;
        if (u.ks >= 0) {
            float* sp = slab + (size_t)u.ks * 256 * ldc + col0;
#pragma unroll
            for (int ai = 0; ai < 2; ++ai)
#pragma unroll
                for (int m = 0; m < 4; ++m) { float* rowp = sp + (size_t)(wr * 64 + fr + ai * HALF + m * 16) * ldc;
#pragma unroll
                    for (int bj = 0; bj < 2; ++bj) { *(f32x4*)(rowp + bj * HALF) = acc[ai][bj][m][0]; *(f32x4*)(rowp + bj * HALF + 4) = acc[ai][bj][m][1]; } }
            return;
        }
        const int row0 = u.pm * BM + wr * 64 + fr;
#pragma unroll
        for (int ai = 0; ai < 2; ++ai)
#pragma unroll
            for (int m = 0; m < 4; ++m) {
                bf16_t* rowp = Y + (size_t)(row0 + ai * HALF + m * 16) * ldc + col0;
#pragma unroll
                for (int bj = 0; bj < 2; ++bj) { const f32x4 v0 = acc[ai][bj][m][0], v1 = acc[ai][bj][m][1];
                    u32x4 w; w.x = cvt_pk_bf16(v0[0], v0[1]); w.y = cvt_pk_bf16(v0[2], v0[3]); w.z = cvt_pk_bf16(v1[0], v1[1]); w.w = cvt_pk_bf16(v1[2], v1[3]);
                    *(u32x4*)(rowp + bj * HALF) = w; }
            }
    }
};

struct EpiGlu {
    static constexpr bool PERM = true, AFTER_DRAIN = false;
    const bf16_t* A2; int lda; const bf16_t* P; int ldp; int szcol; const float* bglu; bf16_t* G; int ldg;
    __device__ __forceinline__ void operator()(const f32x4 (&acc)[2][2][4][2], const Unit& u, int wr, int wc, int fr, int fq) const {
        const int row0 = u.pm * BM + wr * 64 + fr, col0 = u.pn * BM + wc * 32 + 8 * fq;
        u32x4 av[2][2], zv[2][2];
#define GLU_ISSUE(b_) do { const int bj_ = (b_) >> 2, ai_ = ((b_) >> 1) & 1, mp_ = (b_) & 1; \
            _Pragma("unroll") for (int r_ = 0; r_ < 2; ++r_) { const int row_ = row0 + ai_ * HALF + (2 * mp_ + r_) * 16, col_ = col0 + bj_ * HALF; \
                av[(b_) & 1][r_] = *(const u32x4*)(A2 + (size_t)row_ * lda + col_); zv[(b_) & 1][r_] = *(const u32x4*)(P + (size_t)row_ * ldp + szcol + col_); } } while (0)
        f32x4 bb[2][2];
#pragma unroll
        for (int bj = 0; bj < 2; ++bj) { bb[bj][0] = *(const f32x4*)(bglu + col0 + bj * HALF); bb[bj][1] = *(const f32x4*)(bglu + col0 + bj * HALF + 4); }
        GLU_ISSUE(0);
#pragma unroll
        for (int bj = 0; bj < 2; ++bj) asm volatile("" : "+v"(bb[bj][0]), "+v"(bb[bj][1]));
#pragma unroll
        for (int b = 0; b < 8; ++b) {
            const int bj = b >> 2, ai = (b >> 1) & 1, mp = b & 1, col = col0 + bj * HALF;
            if (b + 1 < 8) GLU_ISSUE(b + 1);
            const f32x4 b0 = bb[bj][0], b1 = bb[bj][1];
#pragma unroll
            for (int r = 0; r < 2; ++r) {
                const int m = 2 * mp + r, row = row0 + ai * HALF + m * 16;
                const u32x4 a = av[b & 1][r], z = zv[b & 1][r];
                const f32x4 t0 = acc[ai][bj][m][0] + b0, t1 = acc[ai][bj][m][1] + b1;
                float q[8];
                q[0] = __uint_as_float(a.x << 16) * __uint_as_float(z.x << 16) * __builtin_amdgcn_rcpf(1.0f + __expf(-t0[0]));
                q[1] = __uint_as_float(a.x & 0xffff0000u) * __uint_as_float(z.x & 0xffff0000u) * __builtin_amdgcn_rcpf(1.0f + __expf(-t0[1]));
                q[2] = __uint_as_float(a.y << 16) * __uint_as_float(z.y << 16) * __builtin_amdgcn_rcpf(1.0f + __expf(-t0[2]));
                q[3] = __uint_as_float(a.y & 0xffff0000u) * __uint_as_float(z.y & 0xffff0000u) * __builtin_amdgcn_rcpf(1.0f + __expf(-t0[3]));
                q[4] = __uint_as_float(a.z << 16) * __uint_as_float(z.z << 16) * __builtin_amdgcn_rcpf(1.0f + __expf(-t1[0]));
                q[5] = __uint_as_float(a.z & 0xffff0000u) * __uint_as_float(z.z & 0xffff0000u) * __builtin_amdgcn_rcpf(1.0f + __expf(-t1[1]));
                q[6] = __uint_as_float(a.w << 16) * __uint_as_float(z.w << 16) * __builtin_amdgcn_rcpf(1.0f + __expf(-t1[2]));
                q[7] = __uint_as_float(a.w & 0xffff0000u) * __uint_as_float(z.w & 0xffff0000u) * __builtin_amdgcn_rcpf(1.0f + __expf(-t1[3]));
                u32x4 w; w.x = cvt_pk_bf16(q[0], q[1]); w.y = cvt_pk_bf16(q[2], q[3]); w.z = cvt_pk_bf16(q[4], q[5]); w.w = cvt_pk_bf16(q[6], q[7]);
                *(u32x4*)(G + (size_t)row * ldg + col) = w;
            }
        }
#undef GLU_ISSUE
    }
};

template <class Epi, class Sched, bool ALIGN_EPI = false, bool SP2 = false>
__device__ __forceinline__ void gemm_phase(PG8_LAS unsigned char* lds, const Gemm g, const Sched& S, const Epi& E) {
    const int tid = threadIdx.x, wid = __builtin_amdgcn_readfirstlane(tid >> 6), lane = tid & 63, wr = wid >> 2, wc = wid & 3, fr = lane & 15, fq = lane >> 4;
    const int K = g.K, nt = K / BK;
    unsigned voffA[2], voffB[2];
#pragma unroll
    for (int i = 0; i < 2; ++i) { int R, C; stage_rc(tid * 16 + i * 8192, R, C); const int Rb = Epi::PERM ? ((R & ~31) + perm32(R & 31)) : R;
        voffA[i] = (unsigned)(R * K + C) * 2u; voffB[i] = (unsigned)(Rb * K + C) * 2u; }
    const size_t kstep = (size_t)(BK * 2);
    const size_t hstep = (size_t)HALF * K * 2;
    const size_t tstep = 2 * hstep;
    const unsigned ldsw = (unsigned)wid * 1024u;
    const int aoff = lds_byte(wr * 64 + fr, fq * 8), boff = lds_byte(wc * 32 + fr, fq * 8);
#define PG8_SA(b, h) (((b) * 2 + (h)) * HTB)
#define PG8_SB(b, h) ((4 + (b) * 2 + (h)) * HTB)
#define PG8_STAGE(bufoff, gbase, voff) do { _Pragma("unroll") for (int _i = 0; _i < 2; ++_i) \
        __builtin_amdgcn_global_load_lds((const unsigned*)((const char*)(gbase) + (voff)[_i]), (PG8_LAS unsigned*)(lds + (bufoff) + ldsw + _i * 8192), 16, 0, 0); } while (0)
#define PG8_LDA(dst, b, h) do { _Pragma("unroll") for (int m = 0; m < 4; ++m) _Pragma("unroll") for (int k = 0; k < 2; ++k) dst[m][k] = *(const PG8_LAS bf16x8*)(lds + PG8_SA(b, h) + aoff + m * 2048 + k * 1024); } while (0)
#define PG8_LDB(dst, b, h) do { _Pragma("unroll") for (int n = 0; n < 2; ++n) _Pragma("unroll") for (int k = 0; k < 2; ++k) dst[n][k] = *(const PG8_LAS bf16x8*)(lds + PG8_SB(b, h) + boff + n * 2048 + k * 1024); } while (0)
#define PG8_MMA(ai, bj, At, Bt) do { __builtin_amdgcn_s_setprio(1); _Pragma("unroll") for (int m = 0; m < 4; ++m) _Pragma("unroll") for (int n = 0; n < 2; ++n) _Pragma("unroll") for (int k = 0; k < 2; ++k) \
        acc[ai][bj][m][n] = __builtin_amdgcn_mfma_f32_16x16x32_bf16(Bt[n][k], At[m][k], acc[ai][bj][m][n], 0, 0, 0); __builtin_amdgcn_s_setprio(0); } while (0)
#define PG8_WAIT_V(n) asm volatile("s_waitcnt vmcnt(" #n ")" ::: "memory")
#define PG8_WAIT_L(n) asm volatile("s_waitcnt lgkmcnt(" #n ")" ::: "memory")
#define PG8_BAR __builtin_amdgcn_s_barrier()
#define PG8_SCHED __builtin_amdgcn_sched_barrier(0)
    Unit cur, nxt; int ui = 0;
    if (!S.next(0, cur)) return;
    f32x4 acc[2][2][4][2];
#pragma unroll
    for (int a = 0; a < 2; ++a)
#pragma unroll
        for (int b = 0; b < 2; ++b)
#pragma unroll
            for (int m = 0; m < 4; ++m)
#pragma unroll
                for (int n = 0; n < 2; ++n) acc[a][b][m][n] = (f32x4){0.f, 0.f, 0.f, 0.f};
    bf16x8 At[4][2], B0[2][2], B1[2][2];
    const char* cA = (const char*)g.A + (size_t)cur.pm * tstep + cur.koff; const char* cB = (const char*)g.Bt + (size_t)cur.pn * tstep + cur.koff;
    int ntc = cur.nkt ? cur.nkt : nt;
    S.a_ready(cur);
    if constexpr (SP2) {
        PG8_STAGE(PG8_SB(0, 0), cB, voffB); PG8_STAGE(PG8_SB(0, 1), cB + hstep, voffB); PG8_STAGE(PG8_SA(0, 0), cA, voffA); PG8_STAGE(PG8_SA(0, 1), cA + hstep, voffA);
        if (wr == 1) PG8_BAR;
        PG8_WAIT_V(2); PG8_BAR;
        PG8_STAGE(PG8_SB(1, 0), cB + kstep, voffB); PG8_STAGE(PG8_SA(1, 0), cA + kstep, voffA); PG8_STAGE(PG8_SB(1, 1), cB + hstep + kstep, voffB);
        PG8_WAIT_V(6); PG8_BAR;
    } else {
        PG8_STAGE(PG8_SB(0, 0), cB, voffB); PG8_STAGE(PG8_SA(0, 0), cA, voffA); PG8_STAGE(PG8_SB(0, 1), cB + hstep, voffB); PG8_STAGE(PG8_SA(0, 1), cA + hstep, voffA);
        if (wr == 1) PG8_BAR;
        PG8_WAIT_V(4); PG8_BAR;
        PG8_STAGE(PG8_SB(1, 0), cB + kstep, voffB); PG8_STAGE(PG8_SA(1, 0), cA + kstep, voffA); PG8_STAGE(PG8_SB(1, 1), cB + hstep + kstep, voffB);
        PG8_WAIT_V(6); PG8_BAR;
    }
    for (;;) {
        const bool has_next = S.next(ui + 1, nxt);
        const char* nA = has_next ? (const char*)g.A + (size_t)nxt.pm * tstep + nxt.koff : cA; const char* nB = has_next ? (const char*)g.Bt + (size_t)nxt.pn * tstep + nxt.koff : cB;
        for (int t = 0; t < ntc; t += 2) {
            const bool last = (t == ntc - 2);
            const char* a1 = cA + (size_t)(t + 1) * kstep;
            const char* a2 = last ? nA : cA + (size_t)(t + 2) * kstep; const char* b2 = last ? nB : cB + (size_t)(t + 2) * kstep;
            const char* a3 = a2 + kstep; const char* b3 = b2 + kstep;
            if (last && has_next) S.a_ready(nxt);
            if constexpr (SP2) {
            PG8_LDB(B0, 0, 0); PG8_LDB(B1, 0, 1); PG8_SCHED; PG8_LDA(At, 0, 0); PG8_STAGE(PG8_SA(1, 1), a1 + hstep, voffA);
            PG8_WAIT_V(8); PG8_WAIT_L(0); PG8_BAR; PG8_MMA(0, 0, At, B0); PG8_MMA(0, 1, At, B1); PG8_BAR; PG8_SCHED;
            PG8_LDA(At, 0, 1); PG8_STAGE(PG8_SB(0, 0), b2, voffB); PG8_STAGE(PG8_SB(0, 1), b2 + hstep, voffB); PG8_STAGE(PG8_SA(0, 0), a2, voffA);
            PG8_WAIT_V(8); PG8_WAIT_L(0); PG8_BAR; PG8_MMA(1, 0, At, B0); PG8_MMA(1, 1, At, B1); PG8_BAR; PG8_SCHED;
            PG8_LDB(B0, 1, 0); PG8_LDB(B1, 1, 1); PG8_SCHED; PG8_LDA(At, 1, 0); PG8_STAGE(PG8_SA(0, 1), a2 + hstep, voffA);
            PG8_WAIT_V(8); PG8_WAIT_L(0); PG8_BAR; PG8_MMA(0, 0, At, B0); PG8_MMA(0, 1, At, B1); PG8_BAR; PG8_SCHED;
            PG8_LDA(At, 1, 1); PG8_STAGE(PG8_SB(1, 0), b3, voffB); PG8_STAGE(PG8_SB(1, 1), b3 + hstep, voffB); PG8_STAGE(PG8_SA(1, 0), a3, voffA);
            PG8_WAIT_V(8); PG8_WAIT_L(0); PG8_BAR; PG8_MMA(1, 0, At, B0); PG8_MMA(1, 1, At, B1); PG8_BAR; PG8_SCHED;
            } else {
            PG8_LDB(B0, 0, 0); PG8_SCHED; PG8_LDA(At, 0, 0); PG8_STAGE(PG8_SA(1, 1), a1 + hstep, voffA);
            PG8_WAIT_L(8); PG8_BAR; PG8_WAIT_L(0); PG8_MMA(0, 0, At, B0); PG8_BAR; PG8_SCHED;
            PG8_LDB(B1, 0, 1); PG8_STAGE(PG8_SB(0, 0), b2, voffB);
            PG8_BAR; PG8_WAIT_L(0); PG8_MMA(0, 1, At, B1); PG8_BAR;
            PG8_LDA(At, 0, 1); PG8_STAGE(PG8_SA(0, 0), a2, voffA);
            PG8_BAR; PG8_WAIT_L(0); PG8_MMA(1, 0, At, B0); PG8_BAR; PG8_SCHED;
            PG8_STAGE(PG8_SB(0, 1), b2 + hstep, voffB);
            PG8_WAIT_V(6); PG8_BAR; PG8_MMA(1, 1, At, B1); PG8_BAR;
            PG8_LDB(B0, 1, 0); PG8_SCHED; PG8_LDA(At, 1, 0); PG8_STAGE(PG8_SA(0, 1), a2 + hstep, voffA);
            PG8_WAIT_L(8); PG8_BAR; PG8_WAIT_L(0); PG8_MMA(0, 0, At, B0); PG8_BAR; PG8_SCHED;
            PG8_LDB(B1, 1, 1); PG8_STAGE(PG8_SB(1, 0), b3, voffB);
            PG8_BAR; PG8_WAIT_L(0); PG8_MMA(0, 1, At, B1); PG8_BAR;
            PG8_LDA(At, 1, 1); PG8_STAGE(PG8_SA(1, 0), a3, voffA);
            PG8_BAR; PG8_WAIT_L(0); PG8_MMA(1, 0, At, B0); PG8_BAR; PG8_SCHED;
            PG8_STAGE(PG8_SB(1, 1), b3 + hstep, voffB);
            PG8_WAIT_V(6); PG8_BAR; PG8_MMA(1, 1, At, B1); PG8_BAR;
            }
        }
        if constexpr (ALIGN_EPI) { if (wr == 0) PG8_BAR; }
        if constexpr (!Epi::AFTER_DRAIN) { E(acc, cur, wr, wc, fr, fq); S.done(cur); }
        if (!has_next) break;
#pragma unroll
        for (int a = 0; a < 2; ++a)
#pragma unroll
            for (int b = 0; b < 2; ++b)
#pragma unroll
                for (int m = 0; m < 4; ++m)
#pragma unroll
                    for (int n = 0; n < 2; ++n) acc[a][b][m][n] = (f32x4){0.f, 0.f, 0.f, 0.f};
        cur = nxt; cA = nA; cB = nB; ++ui; ntc = cur.nkt ? cur.nkt : nt;
        if constexpr (ALIGN_EPI) { if (wr == 1) PG8_BAR; }
    }
    PG8_WAIT_V(0);
    if constexpr (!ALIGN_EPI) { if (wr == 0) PG8_BAR; }
    PG8_BAR;
    if constexpr (Epi::AFTER_DRAIN) { E.fused(acc, cur, wr, wc, fr, fq, lds, wid, lane); S.done(cur); }
#undef PG8_SA
#undef PG8_SB
#undef PG8_STAGE
#undef PG8_LDA
#undef PG8_LDB
#undef PG8_MMA
#undef PG8_WAIT_V
#undef PG8_WAIT_L
#undef PG8_BAR
#undef PG8_SCHED
}
}
struct Params { const float* in[29]; float* out; unsigned char* ws; int ph_lo, ph_hi; };
enum { I_X = 0, I_C, I_CTX, I_CCTX, I_MODW, I_MODB, I_LNG, I_LNB, I_WA_IN, I_WA_OUT, I_WA_SINK, I_RT_IN, I_RT_OUT, I_RT_LD, I_NA_IN, I_NA_OUT, I_NA_RPB,
       I_S5_IN, I_S5_ARE, I_S5_AIM, I_S5_LDT, I_S5_BRE, I_S5_BIM, I_S5_CRE, I_S5_CIM, I_S5_D, I_S5_GLU, I_S5_BGLU, I_S5_OUT };

__device__ __forceinline__ int dst_col(int pmode, int n) {
    if (pmode == 1) {
        if (n < 1024 || (n >= 2048 && n < 6144)) { const int c = n & 127, hlf = c & 64, d = c & 63; return (n - c) + hlf + ((d < 32) ? 2 * d : 2 * (d - 32) + 1); }
        return n;
    }
    if (pmode == 2) {
        if (n < 4096 || (n >= 12288 && n < 16384)) { const int c = n & 255; return (n - c) + ((c < 128) ? 2 * c : 2 * (c - 128) + 1); }
        return n;
    }
    return n;
}
__device__ __forceinline__ void cvt_tile(LAS unsigned char* lds, const float* __restrict__ W, bf16_t* __restrict__ Bt, int K, int N, int pmode, int tile) {
    const int tid = threadIdx.x;
    const int ntn = N / 256, tk = tile / ntn, tn = tile % ntn, k0 = tk * 64, n0 = tn * 256;
    LAS float* T = (LAS float*)lds;
    { const int n4 = tid & 63, ks = tid >> 6;
      const int d0 = dst_col(pmode, n0 + 4 * n4) - n0, d1 = dst_col(pmode, n0 + 4 * n4 + 1) - n0, d2 = dst_col(pmode, n0 + 4 * n4 + 2) - n0, d3 = dst_col(pmode, n0 + 4 * n4 + 3) - n0;
      f32x4 v[8];
#pragma unroll
      for (int i = 0; i < 8; ++i) v[i] = __builtin_nontemporal_load((const f32x4*)(W + (size_t)(k0 + ks + 8 * i) * N + n0 + 4 * n4));
#pragma unroll
      for (int i = 0; i < 8; ++i) { LAS float* r = T + (ks + 8 * i) * 257; r[d0] = v[i][0]; r[d1] = v[i][1]; r[d2] = v[i][2]; r[d3] = v[i][3]; } }
    __syncthreads();
    { const int nr = tid >> 1, kh = (tid & 1) * 32;
      float v[32];
#pragma unroll
      for (int j = 0; j < 32; ++j) v[j] = T[(kh + j) * 257 + nr];
      bf16_t* dp = Bt + (size_t)(n0 + nr) * K + k0 + kh;
#pragma unroll
      for (int q = 0; q < 4; ++q) { u32x4 w; w.x = cvt_pk_bf16(v[8 * q], v[8 * q + 1]); w.y = cvt_pk_bf16(v[8 * q + 2], v[8 * q + 3]); w.z = cvt_pk_bf16(v[8 * q + 4], v[8 * q + 5]); w.w = cvt_pk_bf16(v[8 * q + 6], v[8 * q + 7]);
          *(u32x4*)(dp + 8 * q) = w; } }
    __syncthreads();
}
__device__ __forceinline__ void mod_unit(LAS unsigned char* lds, const Params& p, int unit) {
    const int tid = threadIdx.x, i = unit / 192, cb = unit % 192;
    LAS float* S0 = (LAS float*)lds; LAS float* S1 = S0 + 4096; LAS float* PT = S1 + 4096;
    for (int k = tid; k < 4096; k += NTHREADS) { S0[k] = silu_f(p.in[I_C][k]); S1[k] = silu_f(p.in[I_CCTX][k]); }
    __syncthreads();
    const int cg = tid & 15, kl = tid >> 4;
    const float* Wp = p.in[I_MODW] + (size_t)i * 4096 * 12288 + cb * 64 + cg * 4;
    f32x4 a0 = {0.f, 0.f, 0.f, 0.f}, a1 = {0.f, 0.f, 0.f, 0.f};
    for (int kk = 0; kk < 128; kk += 8) {
        f32x4 w[8];
#pragma unroll
        for (int j = 0; j < 8; ++j) w[j] = __builtin_nontemporal_load((const f32x4*)(Wp + (size_t)(kl + 32 * (kk + j)) * 12288));
#pragma unroll
        for (int j = 0; j < 8; ++j) { const int k = kl + 32 * (kk + j); a0 += w[j] * S0[k]; a1 += w[j] * S1[k]; }
    }
#pragma unroll
    for (int j = 0; j < 4; ++j) { PT[kl * 128 + cg * 4 + j] = a0[j]; PT[kl * 128 + 64 + cg * 4 + j] = a1[j]; }
    __syncthreads();
    if (tid < 128) {
        float s = 0.f;
        for (int k = 0; k < 32; ++k) s += PT[k * 128 + tid];
        const int v = tid >> 6, col = cb * 64 + (tid & 63);
        ((float*)(p.ws + WS_MOD))[(size_t)(i * 2 + v) * 12288 + col] = s + p.in[I_MODB][(size_t)i * 12288 + col];
    }
    __syncthreads();
}
__device__ __forceinline__ void rope_unit(const Params& p, int unit) {
    const int e = unit * 4096 + threadIdx.x * 8;
    if (unit < 512) {
        float* T = (float*)(p.ws + WS_ROPEB);
#pragma unroll
        for (int q = 0; q < 8; ++q) { const int idx = e + q, t = idx >> 7, j = idx & 127;
            const double ang = (double)t * exp(-(double)j * (9.210340371976184 / 128.0)); double s, c; sincos(ang, &s, &c);
            T[(size_t)idx * 2] = (float)c; T[(size_t)idx * 2 + 1] = (float)s; }
    } else {
        float* T = (float*)(p.ws + WS_ROPEA);
#pragma unroll
        for (int q = 0; q < 8; ++q) { const int idx = (unit - 512) * 4096 + threadIdx.x * 8 + q;
            if (idx < 320 * 32) { const int i = idx >> 5, j = idx & 31; const int pos = (i < 256) ? i : i - 256;
                const double ang = (double)pos * exp(-(double)j * (9.210340371976184 / 32.0)); double s, c; sincos(ang, &s, &c);
                T[(size_t)idx * 2] = (float)c; T[(size_t)idx * 2 + 1] = (float)s; } }
    }
}
constexpr int CVT_T0 = 0, CVT_T1 = CVT_T0 + 64 * 40, CVT_T2 = CVT_T1 + 64 * 16, CVT_T3 = CVT_T2 + 128 * 16;
constexpr int P0_MOD0 = 0, P0_CVT0 = 768, P0_ROPE0 = P0_CVT0 + CVT_T3, P0_END = P0_ROPE0 + 515;
__device__ __forceinline__ void p0_prologue(LAS unsigned char* lds, const Params& p) {
    bf16_t* Wb = (bf16_t*)(p.ws + WS_W);
    for (int u = blockIdx.x; u < P0_END; u += gridDim.x) {
        if (u < P0_CVT0) mod_unit(lds, p, u);
        else if (u < P0_ROPE0) {
            const int t = u - P0_CVT0;
            if      (t < CVT_T1) cvt_tile(lds, p.in[I_WA_IN],  Wb + W_WA_IN,  4096, 10240, 1, t - CVT_T0);
            else if (t < CVT_T2) cvt_tile(lds, p.in[I_WA_OUT], Wb + W_WA_OUT, 4096, 4096,  0, t - CVT_T1);
            else                 cvt_tile(lds, p.in[I_RT_OUT], Wb + W_RT_OUT, 8192, 4096,  0, t - CVT_T2);
        } else rope_unit(p, u - P0_ROPE0);
    }
}
#define CVT_DESC(t_, SRC, DST, NN, PM, N0) do { const float* W_; size_t wo_; int tile_; \
    if (which == 0) { W_ = wp0; wo_ = W_RT_IN; NN = 24576; PM = 2; tile_ = (t_); } \
    else if (which == 1) { const bool a_ = (t_) < 64 * 64; W_ = a_ ? wp0 : wp1; wo_ = a_ ? W_NA_IN : W_NA_OUT; NN = a_ ? 16384 : 4096; PM = 0; tile_ = a_ ? (t_) : (t_) - 64 * 64; } \
    else { const bool a_ = (t_) < 64 * 32, b_ = (t_) < 64 * 32 + 64 * 16; W_ = a_ ? wp0 : b_ ? wp1 : wp2; wo_ = a_ ? W_S5_IN : b_ ? W_S5_GLU : W_S5_OUT; \
        NN = a_ ? 8192 : 4096; PM = 0; tile_ = a_ ? (t_) : b_ ? (t_) - 64 * 32 : (t_) - 64 * 32 - 64 * 16; } \
    const int ntn_ = NN >> 8, tk_ = tile_ / ntn_, tn_ = tile_ - tk_ * ntn_; \
    SRC = W_ + (size_t)(tk_ * 64) * NN + tn_ * 256; DST = Wb + wo_ + (size_t)(tn_ * 256) * 4096 + tk_ * 64; N0 = tn_ * 256; } while (0)
#define CVT_TAKE(dst_) do { int r_ = -1; \
    if (!(early && __hip_atomic_load(ctr, __ATOMIC_RELAXED, __HIP_MEMORY_SCOPE_AGENT) >= limit)) { \
        const unsigned t_ = __hip_atomic_fetch_add(ctr, 1u, __ATOMIC_RELAXED, __HIP_MEMORY_SCOPE_AGENT); if (t_ < (unsigned)ntile) r_ = (int)t_; } \
    dst_ = r_; } while (0)
__device__ __forceinline__ void cvt_tail(LAS unsigned char* lds, const Params& p, int which, bool early = false) {
    bf16_t* Wb = (bf16_t*)(p.ws + WS_W);
    unsigned* ctr = (unsigned*)(p.ws + WS_CTL + 16384 + 9 * 2048 + which * 256);
    volatile LAS int* slot = (volatile LAS int*)(lds + 131072 + 64);
    const int ntile = (which == 0) ? 64 * 96 : (which == 1) ? 64 * 64 + 64 * 16 : 64 * 32 + 2 * 64 * 16;
    const unsigned limit = early ? (unsigned)(ntile - ntile / 6) : 0xffffffffu;
    const int tid = threadIdx.x, n4 = tid & 63, ks = tid >> 6, nr = tid >> 1, kh = (tid & 1) * 32;
    LAS float* T = (LAS float*)lds;
    const float* wp0 = (which == 0) ? p.in[I_RT_IN] : (which == 1) ? p.in[I_NA_IN] : p.in[I_S5_IN];
    const float* wp1 = (which == 1) ? p.in[I_NA_OUT] : p.in[I_S5_GLU];
    const float* wp2 = p.in[I_S5_OUT];
    asm volatile("" : "+s"(wp0), "+s"(wp1), "+s"(wp2));
    __syncthreads();
    if (tid == 0) CVT_TAKE(slot[0]);
    __syncthreads();
    int t = __builtin_amdgcn_readfirstlane(slot[0]);
    if (t < 0) return;
    const float* src; bf16_t* dst; int N, pmode, n0;
    CVT_DESC(t, src, dst, N, pmode, n0);
    f32x4 v[8];
#pragma unroll
    for (int i = 0; i < 8; ++i) v[i] = __builtin_nontemporal_load((const f32x4*)(src + (size_t)(ks + 8 * i) * N + 4 * n4));
    for (;;) {
        if (tid == 0) CVT_TAKE(slot[1]);
        { const int d0 = dst_col(pmode, n0 + 4 * n4) - n0, d1 = dst_col(pmode, n0 + 4 * n4 + 1) - n0, d2 = dst_col(pmode, n0 + 4 * n4 + 2) - n0, d3 = dst_col(pmode, n0 + 4 * n4 + 3) - n0;
#pragma unroll
          for (int i = 0; i < 8; ++i) { LAS float* r = T + (ks + 8 * i) * 257; r[d0] = v[i][0]; r[d1] = v[i][1]; r[d2] = v[i][2]; r[d3] = v[i][3]; } }
        __syncthreads();
        const int tn = __builtin_amdgcn_readfirstlane(slot[1]);
        bf16_t* dcur = dst;
        if (tn >= 0) {
            CVT_DESC(tn, src, dst, N, pmode, n0);
#pragma unroll
            for (int i = 0; i < 8; ++i) v[i] = __builtin_nontemporal_load((const f32x4*)(src + (size_t)(ks + 8 * i) * N + 4 * n4));
        }
        { float w_[32];
#pragma unroll
          for (int j = 0; j < 32; ++j) w_[j] = T[(kh + j) * 257 + nr];
          bf16_t* dp = dcur + (size_t)nr * 4096 + kh;
#pragma unroll
          for (int q = 0; q < 4; ++q) { u32x4 w; w.x = cvt_pk_bf16(w_[8 * q], w_[8 * q + 1]); w.y = cvt_pk_bf16(w_[8 * q + 2], w_[8 * q + 3]); w.z = cvt_pk_bf16(w_[8 * q + 4], w_[8 * q + 5]); w.w = cvt_pk_bf16(w_[8 * q + 6], w_[8 * q + 7]);
              *(u32x4*)(dp + 8 * q) = w; } }
        __syncthreads();
        if (tn < 0) break;
    }
}
#undef CVT_DESC
#undef CVT_TAKE

__device__ __forceinline__ void p1_modulate(LAS unsigned char* lds, const Params& p) {
    const float* mod = (const float*)(p.ws + WS_MOD);
    bf16_t* H = (bf16_t*)(p.ws + WS_H);
    LAS float* Lm = (LAS float*)lds;
    __syncthreads();
    for (int k = threadIdx.x; k < 2048; k += NTHREADS) { *(LAS f32x4*)(Lm + 4 * k) = *(const f32x4*)(mod + 4 * k); *(LAS f32x4*)(Lm + 8192 + 4 * k) = *(const f32x4*)(mod + 12288 + 4 * k); }
    __syncthreads();
    const size_t nchunk = (size_t)MROWS * (DM / 8), stride = (size_t)gridDim.x * NTHREADS;
    for (size_t ch0 = (size_t)blockIdx.x * NTHREADS + threadIdx.x; ch0 < nchunk; ch0 += 4 * stride) {
        f32x4 x0[4], x1[4];
#pragma unroll
        for (int j = 0; j < 4; ++j) { const size_t ch = ch0 + j * stride; if (ch < nchunk) { const int row = (int)(ch >> 9), col = (int)(ch & 511) * 8;
            const float* src = (row >= SEQ) ? p.in[I_CTX] + (size_t)(row - SEQ) * DM + col : p.in[I_X] + (size_t)row * DM + col; x0[j] = __builtin_nontemporal_load((const f32x4*)src); x1[j] = __builtin_nontemporal_load((const f32x4*)(src + 4)); } }
#pragma unroll
        for (int j = 0; j < 4; ++j) { const size_t ch = ch0 + j * stride; if (ch < nchunk) { const int row = (int)(ch >> 9), col = (int)(ch & 511) * 8;
            LAS float* md = Lm + ((row >= SEQ) ? 8192 : 0);
            const f32x4 sh0 = *(const LAS f32x4*)(md + col), sh1 = *(const LAS f32x4*)(md + col + 4), sc0 = *(const LAS f32x4*)(md + 4096 + col), sc1 = *(const LAS f32x4*)(md + 4096 + col + 4);
            const f32x4 h0 = x0[j] * (sc0 + 1.0f) + sh0, h1 = x1[j] * (sc1 + 1.0f) + sh1;
            u32x4 w; w.x = cvt_pk_bf16(h0[0], h0[1]); w.y = cvt_pk_bf16(h0[2], h0[3]); w.z = cvt_pk_bf16(h1[0], h1[1]); w.w = cvt_pk_bf16(h1[2], h1[3]);
            *(u32x4*)(H + (size_t)row * DM + col) = w; } }
    }
}

typedef _Float16 f16v2_t __attribute__((ext_vector_type(2)));
__device__ __forceinline__ unsigned pk_f16(float lo, float hi) { f16v2_t v; v[0] = (_Float16)lo; v[1] = (_Float16)hi; return __builtin_bit_cast(unsigned, v); }
__device__ __forceinline__ float f16_lo(unsigned w) { return (float)__builtin_bit_cast(_Float16, (unsigned short)(w & 0xffffu)); }
__device__ __forceinline__ float f16_hi(unsigned w) { return (float)__builtin_bit_cast(_Float16, (unsigned short)(w >> 16)); }
__device__ __forceinline__ f32x4 unpk_f16x4(u32x2 w) { f32x4 r; r[0] = f16_lo(w.x); r[1] = f16_hi(w.x); r[2] = f16_lo(w.y); r[3] = f16_hi(w.y); return r; }
__device__ __forceinline__ void ln_phase(LAS unsigned char* lds, const Params& p, int layer, int nrows, float* Xout, bool write_h, bool ctx_slabs) {
    const int wid = threadIdx.x >> 6, lane = threadIdx.x & 63;
    unsigned short* Xh = (unsigned short*)(p.ws + WS_X);
    const float* g = p.in[I_LNG] + (size_t)layer * DM; const float* b = p.in[I_LNB] + (size_t)layer * DM;
    const float* modc = (const float*)(p.ws + WS_MOD) + (size_t)layer * 2 * 12288;
    const float* modn = (const float*)(p.ws + WS_MOD) + (size_t)(layer + 1) * 2 * 12288;
    bf16_t* H = (bf16_t*)(p.ws + WS_H);
    const int nrows_w = ctx_slabs ? SEQ : nrows;
    if (ctx_slabs) {
        LAS float* red = (LAS float*)(lds + 90112);
        for (int cr = blockIdx.x; cr < NCTX; cr += gridDim.x) {
            const int row = SEQ + cr;
            const float* gate = modc + 12288 + 8192; const float* md = modn + 12288;
            const float* ys = (const float*)(p.ws + WS_YS) + (size_t)cr * DM;
            f32x4 t[2]; float s = 0.f;
#pragma unroll
            for (int j = 0; j < 2; ++j) { const int col = wid * 512 + j * 256 + lane * 4;
                f32x4 yk[16];
#pragma unroll
                for (int ks = 0; ks < 16; ++ks) yk[ks] = *(const f32x4*)(ys + (size_t)ks * 256 * DM + col);
                const f32x4 y = ((yk[0] + yk[1]) + (yk[2] + yk[3])) + ((yk[4] + yk[5]) + (yk[6] + yk[7])) + (((yk[8] + yk[9]) + (yk[10] + yk[11])) + ((yk[12] + yk[13]) + (yk[14] + yk[15])));
                const f32x4 xv = (layer == 0) ? *(const f32x4*)(p.in[I_CTX] + (size_t)cr * DM + col) : unpk_f16x4(*(const u32x2*)(Xh + (size_t)row * DM + col));
                t[j] = xv * DN_ALPHA + *(const f32x4*)(gate + col) * y;
                s += (t[j][0] + t[j][1]) + (t[j][2] + t[j][3]); }
#pragma unroll
            for (int o = 32; o >= 1; o >>= 1) s += __shfl_xor(s, o);
            __syncthreads();
            if (lane == 0) red[wid] = s;
            __syncthreads();
            float tot = 0.f;
#pragma unroll
            for (int w = 0; w < 8; ++w) tot += red[w];
            const float mean = tot * (1.0f / DM);
            float q = 0.f;
#pragma unroll
            for (int j = 0; j < 2; ++j) { const f32x4 d = t[j] - mean; q += (d[0] * d[0] + d[1] * d[1]) + (d[2] * d[2] + d[3] * d[3]); }
#pragma unroll
            for (int o = 32; o >= 1; o >>= 1) q += __shfl_xor(q, o);
            if (lane == 0) red[8 + wid] = q;
            __syncthreads();
            float qt = 0.f;
#pragma unroll
            for (int w = 0; w < 8; ++w) qt += red[8 + w];
            const float rstd = 1.0f / sqrtf(qt * (1.0f / DM) + LN_EPS);
#pragma unroll
            for (int j = 0; j < 2; ++j) { const int col = wid * 512 + j * 256 + lane * 4;
                const f32x4 y = (t[j] - mean) * rstd * *(const f32x4*)(g + col) + *(const f32x4*)(b + col);
                if (write_h) { u32x2 xw; xw.x = pk_f16(y[0], y[1]); xw.y = pk_f16(y[2], y[3]); *(u32x2*)(Xh + (size_t)row * DM + col) = xw; } else *(f32x4*)(Xout + (size_t)row * DM + col) = y;
                if (write_h) { const f32x4 h = y * (*(const f32x4*)(md + 4096 + col) + 1.0f) + *(const f32x4*)(md + col);
                    u32x2 w; w.x = cvt_pk_bf16(h[0], h[1]); w.y = cvt_pk_bf16(h[2], h[3]); *(u32x2*)(H + (size_t)row * DM + col) = w; } }
        }
    }
    LAS float* Lv = (LAS float*)lds;
    __syncthreads();
    for (int k = threadIdx.x; k < 1024; k += NTHREADS) {
        *(LAS f32x4*)(Lv + 4 * k) = *(const f32x4*)(modc + 8192 + 4 * k); *(LAS f32x4*)(Lv + 4096 + 4 * k) = *(const f32x4*)(g + 4 * k); *(LAS f32x4*)(Lv + 8192 + 4 * k) = *(const f32x4*)(b + 4 * k);
        if (write_h) { *(LAS f32x4*)(Lv + 12288 + 4 * k) = *(const f32x4*)(modn + 4 * k); *(LAS f32x4*)(Lv + 16384 + 4 * k) = *(const f32x4*)(modn + 4096 + 4 * k); } }
    __syncthreads();
    for (int row = blockIdx.x * 8 + wid; row < nrows_w; row += gridDim.x * 8) {
        const bool ctx = row >= SEQ;
        const float* xr = ctx ? p.in[I_CTX] + (size_t)(row - SEQ) * DM : p.in[I_X] + (size_t)row * DM;
        const float* gate = modc + (ctx ? 12288 : 0) + 8192;
        const float* gr = g; const float* br = b; const float* md = modn + (ctx ? 12288 : 0);
        int lane4 = lane * 4; asm volatile("" : "+v"(lane4));
        f32x4 v[16]; u32x2 yv[16];
        if (layer == 0) {
#pragma unroll
            for (int i = 0; i < 16; ++i) { v[i] = __builtin_nontemporal_load((const f32x4*)(xr + i * 256 + lane * 4)); yv[i] = *(const u32x2*)(H + (size_t)row * DM + i * 256 + lane * 4); }
        } else {
            u32x2 xh[16];
#pragma unroll
            for (int i = 0; i < 16; ++i) { xh[i] = __builtin_nontemporal_load((const u32x2*)(Xh + (size_t)row * DM + i * 256 + lane * 4)); yv[i] = *(const u32x2*)(H + (size_t)row * DM + i * 256 + lane * 4); }
#pragma unroll
            for (int i = 0; i < 16; ++i) v[i] = unpk_f16x4(xh[i]);
        }
        float s = 0.f;
#pragma unroll
        for (int i = 0; i < 16; ++i) { const f32x4 gt = *(const LAS f32x4*)(Lv + i * 256 + lane4);
            v[i][0] = v[i][0] * DN_ALPHA + gt[0] * bf_lo(yv[i].x); v[i][1] = v[i][1] * DN_ALPHA + gt[1] * bf_hi(yv[i].x);
            v[i][2] = v[i][2] * DN_ALPHA + gt[2] * bf_lo(yv[i].y); v[i][3] = v[i][3] * DN_ALPHA + gt[3] * bf_hi(yv[i].y);
            s += (v[i][0] + v[i][1]) + (v[i][2] + v[i][3]); }
#pragma unroll
        for (int o = 32; o >= 1; o >>= 1) s += __shfl_xor(s, o);
        const float mean = s * (1.0f / DM);
        float q = 0.f;
#pragma unroll
        for (int i = 0; i < 16; ++i) { const f32x4 d = v[i] - mean; q += (d[0] * d[0] + d[1] * d[1]) + (d[2] * d[2] + d[3] * d[3]); }
#pragma unroll
        for (int o = 32; o >= 1; o >>= 1) q += __shfl_xor(q, o);
        const float rstd = 1.0f / sqrtf(q * (1.0f / DM) + LN_EPS);
        float* xo = Xout + (size_t)row * DM;
#pragma unroll
        for (int i = 0; i < 16; ++i) {
            const int col = i * 256 + lane4;
            const f32x4 gv = *(const LAS f32x4*)(Lv + 4096 + col), bv = *(const LAS f32x4*)(Lv + 8192 + col);
            const f32x4 y = (v[i] - mean) * rstd * gv + bv;
            if (write_h) { u32x2 xw; xw.x = pk_f16(y[0], y[1]); xw.y = pk_f16(y[2], y[3]); *(u32x2*)(Xh + (size_t)row * DM + col) = xw; } else *(f32x4*)(xo + col) = y;
            if (write_h) {
                const f32x4 sh = *(const LAS f32x4*)(Lv + 12288 + col), sc = *(const LAS f32x4*)(Lv + 16384 + col);
                const f32x4 h = y * (sc + 1.0f) + sh;
                u32x2 w; w.x = cvt_pk_bf16(h[0], h[1]); w.y = cvt_pk_bf16(h[2], h[3]);
                *(u32x2*)(H + (size_t)row * DM + col) = w;
            }
        }
    }
}

namespace att {
#define KSWZ(row, colB) ((row) * 256 + ((colB) ^ ((((row) & 7) | ((((row) >> 4) & 1) << 3)) << 4)))
__device__ __forceinline__ int crow(int r, int hi) { return (r & 3) + 8 * (r >> 2) + 4 * hi; }
__device__ __forceinline__ void qkt(f32x16& p0, f32x16& p1, const bf16_t* Ks, const bf16x8* qr, int r32, int hi) {
  p0 = f32x16{}; p1 = f32x16{};
#pragma unroll
  for (int d0 = 0; d0 < 8; ++d0) { const int cb = (d0 * 16 + hi * 8) * 2;
    const bf16x8 b0 = *reinterpret_cast<const bf16x8*>((const char*)Ks + KSWZ(r32, cb));
    const bf16x8 b1 = *reinterpret_cast<const bf16x8*>((const char*)Ks + KSWZ(32 + r32, cb));
    p0 = __builtin_amdgcn_mfma_f32_32x32x16_bf16(b0, qr[d0], p0, 0, 0, 0);
    p1 = __builtin_amdgcn_mfma_f32_32x32x16_bf16(b1, qr[d0], p1, 0, 0, 0); }
}
__device__ __forceinline__ int v_st(int k, int c) { const int kk = (k & ~0xC) | ((k & 4) << 1) | ((k & 8) >> 1); return ((kk >> 3) * 4 + (c >> 5)) * 512 + ((kk & 7) * 32 + (c & 31)) * 2; }
__device__ __forceinline__ int v_rd_base(int lane) { return ((lane & 3) << 3) | (((lane >> 2) & 3) << 6) | (((lane >> 4) & 1) << 5) | (((lane >> 5) & 1) << 8); }
constexpr int v_rd_off(int d0, int ks, int half) { return d0 * 512 + ks * 4096 + half * 2048; }
template <int OFF> __device__ __forceinline__ s16x4 tr_read(int vb) {
  s16x4 r; asm volatile("ds_read_b64_tr_b16 %0, %1 offset:%2" : "=&v"(r) : "v"(vb), "i"(OFF) : "memory"); return r;
}
#define PK(L, H) (bf16x8){L[0], L[1], L[2], L[3], H[0], H[1], H[2], H[3]}
template <int D0> __device__ __forceinline__ void pv_reads(int vb, s16x4 (&f)[8], bool k0, bool k3) {
  if (k0) { f[0] = tr_read<v_rd_off(D0, 0, 0)>(vb); f[1] = tr_read<v_rd_off(D0, 0, 1)>(vb); }
  f[2] = tr_read<v_rd_off(D0, 1, 0)>(vb); f[3] = tr_read<v_rd_off(D0, 1, 1)>(vb); f[4] = tr_read<v_rd_off(D0, 2, 0)>(vb); f[5] = tr_read<v_rd_off(D0, 2, 1)>(vb);
  if (k3) { f[6] = tr_read<v_rd_off(D0, 3, 0)>(vb); f[7] = tr_read<v_rd_off(D0, 3, 1)>(vb); }
}
__device__ __forceinline__ void pv_mma(f32x16& od, const s16x4 (&f)[8], bf16x8 pa0, bf16x8 pa1, bf16x8 pa2, bf16x8 pa3, bool k0, bool k3) {
  if (k0) od = __builtin_amdgcn_mfma_f32_32x32x16_bf16(pa0, PK(f[0], f[1]), od, 0, 0, 0);
  od = __builtin_amdgcn_mfma_f32_32x32x16_bf16(pa1, PK(f[2], f[3]), od, 0, 0, 0);
  od = __builtin_amdgcn_mfma_f32_32x32x16_bf16(pa2, PK(f[4], f[5]), od, 0, 0, 0);
  if (k3) od = __builtin_amdgcn_mfma_f32_32x32x16_bf16(pa3, PK(f[6], f[7]), od, 0, 0, 0);
}
#define PV_WAIT1(k0_, k3_) do { if ((k0_) && (k3_)) asm volatile("s_waitcnt lgkmcnt(8)" ::: "memory"); else asm volatile("s_waitcnt lgkmcnt(6)" ::: "memory"); __builtin_amdgcn_sched_barrier(0); } while (0)
__device__ __forceinline__ void pv_all(f32x16 (&o)[4], int vb, bf16x8 pa0, bf16x8 pa1, bf16x8 pa2, bf16x8 pa3, bool k0, bool k3) {
  s16x4 fa[8] = {}, fb[8] = {};
  pv_reads<0>(vb, fa, k0, k3); pv_reads<1>(vb, fb, k0, k3);
  PV_WAIT1(k0, k3); pv_mma(o[0], fa, pa0, pa1, pa2, pa3, k0, k3);
  pv_reads<2>(vb, fa, k0, k3);
  PV_WAIT1(k0, k3); pv_mma(o[1], fb, pa0, pa1, pa2, pa3, k0, k3);
  pv_reads<3>(vb, fb, k0, k3);
  PV_WAIT1(k0, k3); pv_mma(o[2], fa, pa0, pa1, pa2, pa3, k0, k3);
  asm volatile("s_waitcnt lgkmcnt(0)" ::: "memory"); __builtin_amdgcn_sched_barrier(0);
  pv_mma(o[3], fb, pa0, pa1, pa2, pa3, k0, k3);
}
#undef PV_WAIT1
#undef PK

template <int MODE>
__device__ __forceinline__ void attn_unit(unsigned char* lds, const bf16_t* __restrict__ P,
                                          int qrow_w, int qcol, int kcol, int vcol, int n_local, int local_row0,
                                          int qtok0, int wrow, int wcol0, int a_lo, float sink, const float* rpbs,
                                          bf16_t* __restrict__ G, int gcol, int szcol) {
  constexpr int ldp = (MODE == 0) ? WA_INW : NA_INW, ldg = DM;
  const int tid = threadIdx.x, wid = tid >> 6, lane = tid & 63, r32 = lane & 31, hi = lane >> 5;
  bf16_t* V_lds = (bf16_t*)lds;
  float* wsx = (float*)(lds + 65536) + wid * 64; float* li_l = wsx; float* al_l = wsx + 32;
  float m_reg = -1e30f, l_reg = 0.f; f32x16 o[4] = {}; bf16x8 qr[8];
  const bf16_t* Qw = P + (size_t)(qrow_w + r32) * ldp + qcol + hi * 8;
#pragma unroll
  for (int d0 = 0; d0 < 8; ++d0) qr[d0] = *reinterpret_cast<const bf16x8*>(Qw + d0 * 16);
  const int sr = tid >> 4, sc = (tid & 15) * 8, vst0 = v_st(sr, sc), vst1 = v_st(32 + sr, sc);
  const int vb0 = (int)(uintptr_t)V_lds + v_rd_base(lane);
  const int nt = 4 + n_local;
  bf16x8 vs0, vs1, ks0, ks1;
#define TROW(i) ((i) < 4 ? SEQ + 64 * (i) : local_row0 + 64 * ((i) - 4))
#define SLOAD(k0) do { const bf16_t* b_ = P + (size_t)((k0) + sr) * ldp + sc; \
    vs0 = *reinterpret_cast<const bf16x8*>(b_ + vcol); vs1 = *reinterpret_cast<const bf16x8*>(b_ + (size_t)32 * ldp + vcol); \
    ks0 = *reinterpret_cast<const bf16x8*>(b_ + kcol); ks1 = *reinterpret_cast<const bf16x8*>(b_ + (size_t)32 * ldp + kcol); } while (0)
#define SWRITE(b) do { char* vb_ = (char*)lds + (b) * 32768; *(bf16x8*)(vb_ + vst0) = vs0; *(bf16x8*)(vb_ + vst1) = vs1; \
    *(bf16x8*)(vb_ + 16384 + KSWZ(sr, sc * 2)) = ks0; *(bf16x8*)(vb_ + 16384 + KSWZ(32 + sr, sc * 2)) = ks1; } while (0)
  __syncthreads();
  SLOAD(TROW(0)); SWRITE(0); SLOAD(TROW(1));
  __syncthreads();
  for (int i = 0; i < nt; ++i) {
    const int cb = i & 1;
    if (i + 1 < nt) SWRITE(cb ^ 1);
    if (i + 2 < nt) SLOAD(TROW(i + 2));
    const bf16_t* K_cur = (const bf16_t*)(lds + cb * 32768 + 16384); const int vb_cur = vb0 + cb * 32768;
    bool active = true; int arow = 0;
    if (MODE == 1 && i >= 4) { arow = a_lo + (i - 4); const int rs = min(max(wrow - 4, 0), 248); active = (arow >= rs) && (arow < rs + 8); }
    if (active) {
      const bool nA = !(MODE == 1 && i >= 4 && wcol0 != 0), nD = !(MODE == 1 && i >= 4 && wcol0 == 0);
      f32x16 p0, p1; qkt(p0, p1, K_cur, qr, r32, hi);
      if (i >= 4) {
        if (MODE == 0) {
          const int dbase = (qtok0 + r32) - (local_row0 + 64 * (i - 4));
          const int tdiff = (qtok0 >> 6) - ((local_row0 >> 6) + (i - 4));
          if (tdiff >= 2 || tdiff <= -2)
#pragma unroll
          for (int r = 0; r < 16; ++r) { const int d0 = dbase - crow(r, hi), d1 = d0 - 32;
            if (d0 > 128 || d0 < -128) p0[r] = -1e30f; if (d1 > 128 || d1 < -128) p1[r] = -1e30f; }
        } else {
          const int c = wcol0 + r32, cs = min(max(c - 8, 0), 48);
          const unsigned baddr = (unsigned)(uintptr_t)rpbs + (unsigned)(((arow - wrow + 7) * 31 + 15 - c + 4 * hi) * 4);
          const int tv = 4 * hi - cs;
#define NB_RD(dst, OFF) asm volatile("ds_read_b32 %0, %1 offset:%2" : "=v"(dst) : "v"(baddr), "i"(OFF) : "memory")
#define NB_HALF(P_, BASEKEY) do { float b0_, b1_, b2_, b3_, b4_, b5_, b6_, b7_, b8_, b9_, b10_, b11_, b12_, b13_, b14_, b15_; \
            NB_RD(b0_, ((BASEKEY) + 0) * 4); NB_RD(b1_, ((BASEKEY) + 1) * 4); NB_RD(b2_, ((BASEKEY) + 2) * 4); NB_RD(b3_, ((BASEKEY) + 3) * 4); \
            NB_RD(b4_, ((BASEKEY) + 8) * 4); NB_RD(b5_, ((BASEKEY) + 9) * 4); NB_RD(b6_, ((BASEKEY) + 10) * 4); NB_RD(b7_, ((BASEKEY) + 11) * 4); \
            NB_RD(b8_, ((BASEKEY) + 16) * 4); NB_RD(b9_, ((BASEKEY) + 17) * 4); NB_RD(b10_, ((BASEKEY) + 18) * 4); NB_RD(b11_, ((BASEKEY) + 19) * 4); \
            NB_RD(b12_, ((BASEKEY) + 24) * 4); NB_RD(b13_, ((BASEKEY) + 25) * 4); NB_RD(b14_, ((BASEKEY) + 26) * 4); NB_RD(b15_, ((BASEKEY) + 27) * 4); \
            asm volatile("s_waitcnt lgkmcnt(0)" ::: "memory"); __builtin_amdgcn_sched_barrier(0); \
            const float bb_[16] = {b0_, b1_, b2_, b3_, b4_, b5_, b6_, b7_, b8_, b9_, b10_, b11_, b12_, b13_, b14_, b15_}; \
            _Pragma("unroll") for (int r = 0; r < 16; ++r) { const int key_ = (BASEKEY) + (r & 3) + 8 * (r >> 2); P_[r] = ((unsigned)(key_ + tv) < 16u) ? P_[r] + bb_[r] : -1e30f; } } while (0)
#define NB_QUAD(P_, R0, KEY0) do { float b0_, b1_, b2_, b3_; \
            NB_RD(b0_, ((KEY0) + 0) * 4); NB_RD(b1_, ((KEY0) + 1) * 4); NB_RD(b2_, ((KEY0) + 2) * 4); NB_RD(b3_, ((KEY0) + 3) * 4); \
            asm volatile("s_waitcnt lgkmcnt(0)" ::: "memory"); __builtin_amdgcn_sched_barrier(0); \
            const float bb_[4] = {b0_, b1_, b2_, b3_}; \
            _Pragma("unroll") for (int r = 0; r < 4; ++r) { const int key_ = (KEY0) + r; P_[(R0) + r] = ((unsigned)(key_ + tv) < 16u) ? P_[(R0) + r] + bb_[r] : -1e30f; } } while (0)
          if (nA) NB_HALF(p0, 0); else NB_QUAD(p0, 12, 24);
          if (nD) NB_HALF(p1, 32); else NB_QUAD(p1, 0, 32);
#undef NB_RD
#undef NB_HALF
#undef NB_QUAD
        }
      }
      float pmax = fmaxf(fmaxf(p0[12], p0[13]), fmaxf(p0[14], p0[15]));
#pragma unroll
      for (int r = 0; r < 4; ++r) pmax = fmaxf(pmax, p1[r]);
      if (nA) {
#pragma unroll
        for (int r = 0; r < 12; ++r) pmax = fmaxf(pmax, p0[r]); }
      if (nD) {
#pragma unroll
        for (int r = 4; r < 16; ++r) pmax = fmaxf(pmax, p1[r]); }
      { auto rr = __builtin_amdgcn_permlane32_swap(__float_as_uint(pmax), __float_as_uint(pmax), false, false);
        pmax = fmaxf(__uint_as_float(rr[0]), __uint_as_float(rr[1])); }
      const bool resc = !__all(pmax - m_reg <= 8.0f);
      float alpha = 1.0f;
      if (resc) { const float mn_ = fmaxf(m_reg, pmax); alpha = __builtin_amdgcn_exp2f((m_reg - mn_) * L2E); m_reg = mn_; }
      const float mnC = -m_reg * L2E;
      float ps = 0.f;
#pragma unroll
      for (int r = 12; r < 16; ++r) { p0[r] = __builtin_amdgcn_exp2f(fmaf(p0[r], L2E, mnC)); p1[r - 12] = __builtin_amdgcn_exp2f(fmaf(p1[r - 12], L2E, mnC)); ps += p0[r] + p1[r - 12]; }
      if (nA) {
#pragma unroll
        for (int r = 0; r < 12; ++r) { p0[r] = __builtin_amdgcn_exp2f(fmaf(p0[r], L2E, mnC)); ps += p0[r]; }
      } else {
#pragma unroll
        for (int r = 8; r < 12; ++r) p0[r] = 0.f; }
      if (nD) {
#pragma unroll
        for (int r = 4; r < 16; ++r) { p1[r] = __builtin_amdgcn_exp2f(fmaf(p1[r], L2E, mnC)); ps += p1[r]; }
      } else {
#pragma unroll
        for (int r = 4; r < 8; ++r) p1[r] = 0.f; }
      { auto rr = __builtin_amdgcn_permlane32_swap(__float_as_uint(ps), __float_as_uint(ps), false, false);
        ps = __uint_as_float(rr[0]) + __uint_as_float(rr[1]); }
      l_reg = l_reg * alpha + ps;
      bf16x8 pa0, pa1, pa2, pa3;
#define PK4(Pv, BASE, OUT) do { unsigned a0 = cvt_pk_bf16(Pv[BASE + 0], Pv[BASE + 1]), a1 = cvt_pk_bf16(Pv[BASE + 2], Pv[BASE + 3]);   \
    unsigned b0 = cvt_pk_bf16(Pv[BASE + 4], Pv[BASE + 5]), b1 = cvt_pk_bf16(Pv[BASE + 6], Pv[BASE + 7]);                              \
    auto r0 = __builtin_amdgcn_permlane32_swap(a0, b0, false, false); auto r1 = __builtin_amdgcn_permlane32_swap(a1, b1, false, false); \
    u32x4 w = {r0[0], r1[0], r0[1], r1[1]}; OUT = *reinterpret_cast<bf16x8*>(&w); } while (0)
      pa0 = bf16x8{}; pa3 = bf16x8{};
      if (nA) PK4(p0, 0, pa0);
      PK4(p0, 8, pa1); PK4(p1, 0, pa2);
      if (nD) PK4(p1, 8, pa3);
#undef PK4
      if (resc) {
        if (hi == 0) al_l[r32] = alpha;
        asm volatile("s_waitcnt lgkmcnt(0)" ::: "memory");
#pragma unroll
        for (int r = 0; r < 16; ++r) { const float a = al_l[crow(r, hi)];
#pragma unroll
          for (int d = 0; d < 4; ++d) o[d][r] *= a; }
      }
      pv_all(o, vb_cur, pa0, pa1, pa2, pa3, nA, nD);
    }
    __syncthreads();
  }
  if (MODE == 0) l_reg += __builtin_amdgcn_exp2f((sink - m_reg) * L2E);
  if (hi == 0) li_l[r32] = l_reg;
  asm volatile("s_waitcnt lgkmcnt(0)" ::: "memory");
  char* ot = (char*)lds + 73728 + wid * 8704;
#pragma unroll
  for (int r = 0; r < 16; ++r) { const float rl = __builtin_amdgcn_rcpf(li_l[crow(r, hi)]); bf16_t* orow = (bf16_t*)(ot + crow(r, hi) * 272) + r32;
#pragma unroll
    for (int d0 = 0; d0 < 4; ++d0) orow[d0 * 32] = f2bf(o[d0][r] * rl); }
  asm volatile("s_waitcnt lgkmcnt(0)" ::: "memory");
#pragma unroll
  for (int i = 0; i < 8; ++i) { const int id = lane + 64 * i, row = id >> 4, pc = id & 15;
    const u32x4 ov = *(const u32x4*)(ot + row * 272 + pc * 16);
    const u32x4 zv = *(const u32x4*)(P + (size_t)(qrow_w + row) * ldp + szcol + pc * 8);
    u32x4 w;
    w.x = cvt_pk_bf16(bf_lo(ov.x) * bf_lo(zv.x), bf_hi(ov.x) * bf_hi(zv.x)); w.y = cvt_pk_bf16(bf_lo(ov.y) * bf_lo(zv.y), bf_hi(ov.y) * bf_hi(zv.y));
    w.z = cvt_pk_bf16(bf_lo(ov.z) * bf_lo(zv.z), bf_hi(ov.z) * bf_hi(zv.z)); w.w = cvt_pk_bf16(bf_lo(ov.w) * bf_lo(zv.w), bf_hi(ov.w) * bf_hi(zv.w));
    *(u32x4*)(G + (size_t)(qrow_w + row) * ldg + gcol + pc * 8) = w; }
#undef TROW
#undef SLOAD
#undef SWRITE
}
}

__device__ __forceinline__ void mixerA_phase(unsigned char* lds, const Params& p) {
  const bf16_t* P = (const bf16_t*)(p.ws + WS_P); bf16_t* G = (bf16_t*)(p.ws + WS_G);
  const int wid = threadIdx.x >> 6;
  for (int u = blockIdx.x; u < 8 * 260; u += gridDim.x) {
    const int kvh = u & 7, j = u >> 3;
    const int hq = kvh * 4 + (wid >> 1);
    const float sink = p.in[I_WA_SINK][hq];
    int qrow_w, n_local = 0, local_row0 = 0, qtok0 = 0;
    if (j < 256) { qrow_w = 64 * j + 32 * (wid & 1); qtok0 = qrow_w; const int lo = max(j - 2, 0), hi_ = min(j + 2, 255); n_local = hi_ - lo + 1; local_row0 = 64 * lo; }
    else { qrow_w = SEQ + 64 * (j - 256) + 32 * (wid & 1); }
    att::attn_unit<0>(lds, P, qrow_w, 2048 + hq * 128, kvh * 128, 1024 + kvh * 128, n_local, local_row0, qtok0, 0, 0, 0, sink, nullptr,
                      G, hq * 128, 6144 + hq * 128);
  }
}
__device__ __forceinline__ void mixerC_phase(unsigned char* lds, const Params& p) {
  const bf16_t* P = (const bf16_t*)(p.ws + WS_P); bf16_t* G = (bf16_t*)(p.ws + WS_G);
  const int wid = threadIdx.x >> 6;
  float* rpbs = (float*)(lds + 69632);
  for (int u = blockIdx.x; u < 32 * 65; u += gridDim.x) {
    const int h = u & 31, rg = u >> 5;
    __syncthreads();
    if (threadIdx.x < 465) rpbs[threadIdx.x] = p.in[I_NA_RPB][h * 465 + threadIdx.x];
    int qrow_w, n_local = 0, local_row0 = 0, wrow = 0, wcol0 = 0, a_lo = 0;
    if (rg < 64) { wrow = 4 * rg + (wid >> 1); wcol0 = 32 * (wid & 1); qrow_w = 64 * wrow + wcol0;
      a_lo = min(max(4 * rg - 4, 0), 248); const int a_hi = min(max(4 * rg + 3 - 4, 0), 248) + 7; n_local = a_hi - a_lo + 1; local_row0 = 64 * a_lo; }
    else { qrow_w = SEQ + 32 * wid; }
    att::attn_unit<1>(lds, P, qrow_w, 8192 + h * 128, h * 128, 4096 + h * 128, n_local, local_row0, 0, wrow, wcol0, a_lo, 0.f, rpbs,
                      G, h * 128, 12288 + h * 128);
  }
}

__device__ __forceinline__ bf16x8 rowfrag(LAS unsigned char* base, int stride, int row0, int k0, int r32, int hi) {
    return *(const LAS bf16x8*)(base + (row0 + r32) * stride + (k0 + 8 * hi) * 2);
}
__device__ __forceinline__ void trfrag_issue(s16x4& lo, s16x4& hh, unsigned base_addr, int stride, int k0, int n0, int lane) {
    const int hi = lane >> 5, blk = (lane >> 4) & 1, q = (lane & 15) >> 2, pp = lane & 3;
    const unsigned a0 = base_addr + (unsigned)((k0 + 8 * hi + q) * stride + (n0 + 16 * blk + 4 * pp) * 2);
    const unsigned a1 = a0 + (unsigned)(4 * stride);
    asm volatile("ds_read_b64_tr_b16 %0, %1" : "=&v"(lo) : "v"(a0) : "memory");
    asm volatile("ds_read_b64_tr_b16 %0, %1" : "=&v"(hh) : "v"(a1) : "memory");
}
__device__ __forceinline__ void tr_wait() { asm volatile("s_waitcnt lgkmcnt(0)" ::: "memory"); __builtin_amdgcn_sched_barrier(0); }
#define TR2(lo_, hh_, base_, OFF_, STRIDE_) asm volatile("ds_read_b64_tr_b16 %0, %2 offset:%3\n\tds_read_b64_tr_b16 %1, %2 offset:%4" : "=&v"(lo_), "=&v"(hh_) : "v"(base_), "i"(OFF_), "i"((OFF_) + 4 * (STRIDE_)) : "memory")
__device__ __forceinline__ unsigned tr_lane_base(unsigned tile_addr, int stride, int lane) { const int hi = lane >> 5, blk = (lane >> 4) & 1, q = (lane & 15) >> 2, pp = lane & 3; return tile_addr + (unsigned)((8 * hi + q) * stride + (16 * blk + 4 * pp) * 2); }
#define TRPK(L_, H_) (bf16x8){L_[0], L_[1], L_[2], L_[3], H_[0], H_[1], H_[2], H_[3]}
__device__ __forceinline__ int crow16(int r, int hi) { return (r & 3) + 8 * (r >> 2) + 4 * hi; }

typedef float f32x4c __attribute__((ext_vector_type(4)));
template <class EpiC>
__device__ __forceinline__ void ctx_gemm64(LAS unsigned char* L, const bf16_t* __restrict__ A, const bf16_t* __restrict__ Bt, int K, int item, const EpiC& E) {
    constexpr int STR = 528, WOFF = 64 * 528;
    const int tid = threadIdx.x, lane = tid & 63, wid = tid >> 6, li = lane & 15, q = lane >> 4;
    const int rb = item & 3, cb = item >> 2, ar = wid & 3, nb2 = (wid >> 2) * 2;
    const bf16_t* Ab = A + (size_t)(64 * rb) * K; const bf16_t* Wb_ = Bt + (size_t)(64 * cb) * K;
    f32x4c acc0 = {0.f, 0.f, 0.f, 0.f}, acc1 = {0.f, 0.f, 0.f, 0.f};
    bf16x8 gA[8], gB[8];
#define CG_LOAD(R_, kc) do { _Pragma("unroll") for (int i = 0; i < 4; ++i) { const int id = tid + NTHREADS * i; \
        R_[i] = *(const bf16x8*)(Ab + (size_t)(id >> 5) * K + (kc) + (id & 31) * 8); R_[4 + i] = *(const bf16x8*)(Wb_ + (size_t)(id >> 5) * K + (kc) + (id & 31) * 8); } } while (0)
#define CG_WRITE(R_) do { _Pragma("unroll") for (int i = 0; i < 4; ++i) { const int id = tid + NTHREADS * i; \
        *(LAS bf16x8*)(L + (id >> 5) * STR + (id & 31) * 16) = R_[i]; *(LAS bf16x8*)(L + WOFF + (id >> 5) * STR + (id & 31) * 16) = R_[4 + i]; } } while (0)
    CG_LOAD(gA, 0); CG_LOAD(gB, 256);
    const int nch = K / 256;
    for (int c = 0; c < nch; ++c) {
        __syncthreads();
        if (c & 1) CG_WRITE(gB); else CG_WRITE(gA);
        __syncthreads();
        if (c + 2 < nch) { if (c & 1) CG_LOAD(gB, (c + 2) * 256); else CG_LOAD(gA, (c + 2) * 256); }
#pragma unroll
        for (int s = 0; s < 8; ++s) {
            const bf16x8 af = *(const LAS bf16x8*)(L + (16 * ar + li) * STR + (32 * s + 8 * q) * 2);
            const bf16x8 w0 = *(const LAS bf16x8*)(L + WOFF + (16 * nb2 + li) * STR + (32 * s + 8 * q) * 2), w1 = *(const LAS bf16x8*)(L + WOFF + (16 * nb2 + 16 + li) * STR + (32 * s + 8 * q) * 2);
            acc0 = __builtin_amdgcn_mfma_f32_16x16x32_bf16(w0, af, acc0, 0, 0, 0); acc1 = __builtin_amdgcn_mfma_f32_16x16x32_bf16(w1, af, acc1, 0, 0, 0);
        }
    }
#undef CG_LOAD
#undef CG_WRITE
    __syncthreads();
    E(acc0, 64 * cb + 16 * nb2 + 4 * q, 64 * rb + 16 * ar + li); E(acc1, 64 * cb + 16 * nb2 + 16 + 4 * q, 64 * rb + 16 * ar + li);
}
struct EpiCPlain {
    bf16_t* Pc; int ldp;
    __device__ __forceinline__ void operator()(f32x4c acc, int n, int row) const {
        u32x2 w; w.x = cvt_pk_bf16(acc[0], acc[1]); w.y = cvt_pk_bf16(acc[2], acc[3]);
        *(u32x2*)(Pc + (size_t)row * ldp + n) = w;
    }
};

namespace ret {
constexpr int QS = 0, KS = 33792, VS = 70656, ST0 = 82944, ST1 = 116736;
constexpr int QSTR = 528, KSTR = 576, VSTR = 192;
constexpr int NSTEP = 260, LDP = RT_INW;
constexpr size_t ATT_TILE = 64 * 64, ATT_DIR = (size_t)16 * 260 * ATT_TILE;
__device__ __forceinline__ int cid_row(int cid) { return cid < 4 ? SEQ + 64 * cid : 64 * (cid - 4); }
__device__ __forceinline__ int step_cid(int dir, int step) { return dir ? (step < 4 ? 3 - step : 263 - step) : step; }
}
__device__ __forceinline__ void retatt_phase(LAS unsigned char* L, const Params& p) {
    using namespace ret;
    const bf16_t* P = (const bf16_t*)(p.ws + WS_P); bf16_t* ATT = (bf16_t*)(p.ws + WS_G);
    const int tid = threadIdx.x, wid = __builtin_amdgcn_readfirstlane(tid >> 6), lane = tid & 63, r32 = lane & 31, hi = lane >> 5;
    const int hb = wid >> 2, t8 = tid & 255, w4 = wid & 3, qb = w4 >> 1, kb = w4 & 1;
    LAS unsigned char* Lq = L + hb * 67584; LAS unsigned char* Lk = Lq + 33792;
    for (int pair = blockIdx.x; pair < 2080; pair += gridDim.x) {
        const int u = 2 * pair + hb, h = u / 260, cid = u - h * 260, row0 = cid_row(cid);
        const float lgf = p.in[I_RT_LD][h] * L2E, lgb = p.in[I_RT_LD][16 + h] * L2E;
        bf16x8 qg[8], kg[8];
#pragma unroll
        for (int i = 0; i < 8; ++i) { const int idx = t8 + 256 * i, rr = idx >> 5, cc = idx & 31; const bf16_t* b_ = P + (size_t)(row0 + rr) * LDP + cc * 8;
            qg[i] = *(const bf16x8*)(b_ + 12288 + h * 256); kg[i] = *(const bf16x8*)(b_ + h * 256); }
        __syncthreads();
#pragma unroll
        for (int i = 0; i < 8; ++i) { const int idx = t8 + 256 * i, rr = idx >> 5, cc = idx & 31; *(LAS bf16x8*)(Lq + rr * QSTR + cc * 16) = qg[i]; *(LAS bf16x8*)(Lk + rr * QSTR + cc * 16) = kg[i]; }
        __syncthreads();
        f32x16 acc = {};
#pragma unroll 4
        for (int s = 0; s < 16; ++s) acc = __builtin_amdgcn_mfma_f32_32x32x16_bf16(rowfrag(Lk, QSTR, 32 * kb, 16 * s, r32, hi), rowfrag(Lq, QSTR, 32 * qb, 16 * s, r32, hi), acc, 0, 0, 0);
        const int a = 32 * qb + r32;
        const float ef = __builtin_amdgcn_exp2f((float)(a - 63) * lgf), eb = __builtin_amdgcn_exp2f((float)(-a) * lgb);
        bf16_t* af = ATT + ((size_t)h * 260 + cid) * ATT_TILE + (size_t)a * 64; bf16_t* ab = af + ATT_DIR;
#pragma unroll
        for (int g4 = 0; g4 < 4; ++g4) {
            float vf[4], vb[4];
#pragma unroll
            for (int i = 0; i < 4; ++i) { const int b = 32 * kb + 8 * g4 + 4 * hi + i, df = a - b; const float sc = acc[4 * g4 + i];
                vf[i] = (df >= 0) ? sc * ef : 0.f; vb[i] = (df < 0) ? sc * eb : 0.f; }
            u32x2 wf, wb; wf.x = cvt_pk_bf16(vf[0], vf[1]); wf.y = cvt_pk_bf16(vf[2], vf[3]); wb.x = cvt_pk_bf16(vb[0], vb[1]); wb.y = cvt_pk_bf16(vb[2], vb[3]);
            *(u32x2*)(af + 32 * kb + 8 * g4 + 4 * hi) = wf; *(u32x2*)(ab + 32 * kb + 8 * g4 + 4 * hi) = wb;
        }
    }
}
struct RetCtx { const bf16_t* P; const bf16_t* Ad; bf16_t* Ob; float lg2, cdec; int dir, h, ebI, qcol0, kcol0, vcol0; unsigned Lb; };
__device__ __forceinline__ void ret_step_o(LAS unsigned char* L, const RetCtx& c, int step, bf16x8 (&G)[10], bf16x8 (&atc)[4], bf16x8 (&atn)[4], int t8, int wid, int lane) {
    using namespace ret;
    const int r32 = lane & 31, hi = lane >> 5, qb = (wid & 3) >> 1, xb = wid & 1;
    const int cid = step_cid(c.dir, step), row0 = cid_row(cid);
    const int stc = (step & 1) ? ST1 : ST0;
    __syncthreads();
#pragma unroll
    for (int i = 0; i < 8; ++i) { const int idx = t8 + 256 * i, rr = idx >> 5, cc = idx & 31; *(LAS bf16x8*)(L + QS + rr * QSTR + cc * 16) = G[i]; }
    float lg2s = c.lg2; asm volatile("" : "+v"(lg2s));
    int t8o = t8; asm volatile("" : "+v"(t8o));
#pragma unroll
    for (int i = 0; i < 2; ++i) { const int idx = t8 + 256 * i, rr = idx >> 3, cc = idx & 7;
        const int rro = (t8o >> 3) + 32 * i;
        const u32x4 w = *reinterpret_cast<const u32x4*>(&G[8 + i]); u32x4 s; const float f = __builtin_amdgcn_exp2f((float)(c.dir ? rro : 63 - rro) * lg2s);
        s.x = cvt_pk_bf16(bf_lo(w.x) * f, bf_hi(w.x) * f); s.y = cvt_pk_bf16(bf_lo(w.y) * f, bf_hi(w.y) * f);
        s.z = cvt_pk_bf16(bf_lo(w.z) * f, bf_hi(w.z) * f); s.w = cvt_pk_bf16(bf_lo(w.w) * f, bf_hi(w.w) * f);
        *(LAS u32x4*)(L + VS + rr * VSTR + cc * 16) = s; }
    __syncthreads();
    { const int sn = (step + 2 < NSTEP) ? step + 2 : NSTEP - 1; const int rown = cid_row(step_cid(c.dir, sn));
#pragma unroll
        for (int i = 0; i < 8; ++i) { const int idx = t8 + 256 * i, rr = idx >> 5, cc = idx & 31; G[i] = *(const bf16x8*)(c.P + (size_t)(rown + rr) * LDP + c.qcol0 + cc * 8); }
#pragma unroll
        for (int i = 0; i < 2; ++i) { const int idx = t8 + 256 * i, rr = idx >> 3, cc = idx & 7; G[8 + i] = *(const bf16x8*)(c.P + (size_t)(rown + rr) * LDP + c.vcol0 + cc * 8); } }
    { const int sn = (step + 1 < NSTEP) ? step + 1 : NSTEP - 1; const bf16_t* ap = c.Ad + (size_t)step_cid(c.dir, sn) * ATT_TILE + (size_t)(32 * qb + r32) * 64 + 8 * hi;
        atn[0] = *(const bf16x8*)ap; atn[1] = *(const bf16x8*)(ap + 16); atn[2] = *(const bf16x8*)(ap + 32); atn[3] = *(const bf16x8*)(ap + 48); }
    f32x16 acc1 = {};
#pragma unroll 4
    for (int s = 0; s < 16; ++s) acc1 = __builtin_amdgcn_mfma_f32_32x32x16_bf16(rowfrag(L + stc, QSTR, 32 * xb, 16 * s, r32, hi), rowfrag(L + QS, QSTR, 32 * qb, 16 * s, r32, hi), acc1, 0, 0, 0);
    { int r32o = r32; asm volatile("" : "+v"(r32o)); const int a = 32 * qb + r32o;
      const float qd = __builtin_amdgcn_exp2f((float)(c.dir ? 64 - a : a + 1) * lg2s);
#pragma unroll
      for (int r = 0; r < 16; ++r) acc1[r] *= qd; }
    const unsigned vb1_ = tr_lane_base(c.Lb + VS, VSTR, lane) + (unsigned)(64 * xb);
    s16x4 vl0, vh0, vl1, vh1, vl2, vh2, vl3, vh3;
    TR2(vl0, vh0, vb1_, 0 * VSTR, VSTR); TR2(vl1, vh1, vb1_, 16 * VSTR, VSTR); TR2(vl2, vh2, vb1_, 32 * VSTR, VSTR); TR2(vl3, vh3, vb1_, 48 * VSTR, VSTR);
    tr_wait();
    acc1 = __builtin_amdgcn_mfma_f32_32x32x16_bf16(TRPK(vl0, vh0), atc[0], acc1, 0, 0, 0);
    acc1 = __builtin_amdgcn_mfma_f32_32x32x16_bf16(TRPK(vl1, vh1), atc[1], acc1, 0, 0, 0);
    acc1 = __builtin_amdgcn_mfma_f32_32x32x16_bf16(TRPK(vl2, vh2), atc[2], acc1, 0, 0, 0);
    acc1 = __builtin_amdgcn_mfma_f32_32x32x16_bf16(TRPK(vl3, vh3), atc[3], acc1, 0, 0, 0);
    bf16_t* op = c.Ob + (size_t)(row0 + 32 * qb + r32) * 8192 + c.h * 512 + c.ebI * 64 + 32 * xb + 4 * hi;
#pragma unroll
    for (int g4 = 0; g4 < 4; ++g4) { u32x2 w; w.x = cvt_pk_bf16(acc1[4 * g4], acc1[4 * g4 + 1]); w.y = cvt_pk_bf16(acc1[4 * g4 + 2], acc1[4 * g4 + 3]); *(u32x2*)(op + 8 * g4) = w; }
}
__device__ __forceinline__ void ret_step_s(LAS unsigned char* L, const RetCtx& c, int step, bf16x8 (&G)[8], f32x16& S00, f32x16& S01, f32x16& S10, f32x16& S11, int t8, int wid, int lane) {
    using namespace ret;
    const int r32 = lane & 31, hi = lane >> 5, sw = wid & 3;
    const int stn = (step & 1) ? ST0 : ST1;
    __syncthreads();
#pragma unroll
    for (int i = 0; i < 8; ++i) { const int idx = t8 + 256 * i, rr = idx >> 5, cc = idx & 31; *(LAS bf16x8*)(L + KS + rr * KSTR + cc * 16) = G[i]; }
    __syncthreads();
    { const int sn = (step + 2 < NSTEP) ? step + 2 : NSTEP - 1; const int rown = cid_row(step_cid(c.dir, sn));
#pragma unroll
        for (int i = 0; i < 8; ++i) { const int idx = t8 + 256 * i, rr = idx >> 5, cc = idx & 31; G[i] = *(const bf16x8*)(c.P + (size_t)(rown + rr) * LDP + c.kcol0 + cc * 8); } }
    S00 *= c.cdec; S01 *= c.cdec; S10 *= c.cdec; S11 *= c.cdec;
    const unsigned vbase = tr_lane_base(c.Lb + VS, VSTR, lane);
    const unsigned kbase = tr_lane_base(c.Lb + KS, KSTR, lane) + (unsigned)(128 * sw);
#define RET_SUPD(S0_) do { s16x4 ka0, kb0, kc0, kd0, va0, vb0, vc0, vd0; \
    TR2(ka0, kb0, kbase, (16 * (S0_)) * KSTR, KSTR); TR2(kc0, kd0, kbase, (16 * (S0_)) * KSTR + 64, KSTR); TR2(va0, vb0, vbase, (16 * (S0_)) * VSTR, VSTR); TR2(vc0, vd0, vbase, (16 * (S0_)) * VSTR + 64, VSTR); \
    tr_wait(); \
    { const bf16x8 k0_ = TRPK(ka0, kb0), k1_ = TRPK(kc0, kd0), v0_ = TRPK(va0, vb0), v1_ = TRPK(vc0, vd0); \
      S00 = __builtin_amdgcn_mfma_f32_32x32x16_bf16(k0_, v0_, S00, 0, 0, 0); S01 = __builtin_amdgcn_mfma_f32_32x32x16_bf16(k0_, v1_, S01, 0, 0, 0); \
      S10 = __builtin_amdgcn_mfma_f32_32x32x16_bf16(k1_, v0_, S10, 0, 0, 0); S11 = __builtin_amdgcn_mfma_f32_32x32x16_bf16(k1_, v1_, S11, 0, 0, 0); } \
    __builtin_amdgcn_sched_barrier(0); } while (0)
    RET_SUPD(0); RET_SUPD(1); RET_SUPD(2); RET_SUPD(3);
#undef RET_SUPD
#define RET_STW(S_, T_, EB_) do { _Pragma("unroll") for (int g4 = 0; g4 < 4; ++g4) { u32x2 w; w.x = cvt_pk_bf16(S_[4 * g4], S_[4 * g4 + 1]); w.y = cvt_pk_bf16(S_[4 * g4 + 2], S_[4 * g4 + 3]); \
        *(LAS u32x2*)(L + stn + (32 * (EB_) + r32) * QSTR + (64 * sw + 32 * (T_) + 8 * g4 + 4 * hi) * 2) = w; } } while (0)
    RET_STW(S00, 0, 0); RET_STW(S01, 0, 1); RET_STW(S10, 1, 0); RET_STW(S11, 1, 1);
#undef RET_STW
}
__device__ __forceinline__ void retention_phase(LAS unsigned char* L, const Params& p) {
    using namespace ret;
    const int tid = threadIdx.x, wid = __builtin_amdgcn_readfirstlane(tid >> 6), lane = tid & 63, r32 = lane & 31, hi = lane >> 5, t8 = tid & 255;
    for (int item = blockIdx.x; item < 256; item += gridDim.x) {
        const int grp = (item & 7) * 4 + (item >> 6), ebI = (item >> 3) & 7, h = grp >> 1, dir = grp & 1;
        RetCtx c;
        c.P = (const bf16_t*)(p.ws + WS_P); c.Ad = (const bf16_t*)(p.ws + WS_G) + (dir ? ATT_DIR : 0) + (size_t)h * 260 * ATT_TILE; c.Ob = (bf16_t*)(p.ws + (dir ? WS_OB : WS_OF));
        c.lg2 = p.in[I_RT_LD][dir * 16 + h] * L2E; c.cdec = __builtin_amdgcn_exp2f(64.0f * c.lg2);
        c.dir = dir; c.h = h; c.ebI = ebI; c.qcol0 = 12288 + h * 256; c.kcol0 = h * 256; c.vcol0 = 4096 + h * 512 + ebI * 64; c.Lb = (unsigned)(uintptr_t)L;
        __syncthreads();
        for (int i = tid; i < 33792 / 16; i += NTHREADS) *(LAS u32x4*)(L + ST0 + i * 16) = (u32x4){0u, 0u, 0u, 0u};
        const int row_0 = cid_row(step_cid(dir, 0)), row_1 = cid_row(step_cid(dir, 1));
        if (wid < 4) {
            bf16x8 gA[10], gB[10], atA[4], atB[4] = {};
            { const int qb = (wid & 3) >> 1; const bf16_t* ap = c.Ad + (size_t)step_cid(dir, 0) * ATT_TILE + (size_t)(32 * qb + r32) * 64 + 8 * hi;
              atA[0] = *(const bf16x8*)ap; atA[1] = *(const bf16x8*)(ap + 16); atA[2] = *(const bf16x8*)(ap + 32); atA[3] = *(const bf16x8*)(ap + 48); }
#pragma unroll
            for (int i = 0; i < 8; ++i) { const int idx = t8 + 256 * i, rr = idx >> 5, cc = idx & 31; gA[i] = *(const bf16x8*)(c.P + (size_t)(row_0 + rr) * LDP + c.qcol0 + cc * 8); }
#pragma unroll
            for (int i = 0; i < 2; ++i) { const int idx = t8 + 256 * i, rr = idx >> 3, cc = idx & 7; gA[8 + i] = *(const bf16x8*)(c.P + (size_t)(row_0 + rr) * LDP + c.vcol0 + cc * 8); }
            asm volatile("" ::: "memory");
#pragma unroll
            for (int i = 0; i < 8; ++i) { const int idx = t8 + 256 * i, rr = idx >> 5, cc = idx & 31; gB[i] = *(const bf16x8*)(c.P + (size_t)(row_1 + rr) * LDP + c.qcol0 + cc * 8); }
#pragma unroll
            for (int i = 0; i < 2; ++i) { const int idx = t8 + 256 * i, rr = idx >> 3, cc = idx & 7; gB[8 + i] = *(const bf16x8*)(c.P + (size_t)(row_1 + rr) * LDP + c.vcol0 + cc * 8); }
            for (int step = 0; step < NSTEP; step += 2) {
                ret_step_o(L, c, step, gA, atA, atB, t8, wid, lane);
                ret_step_o(L, c, step + 1, gB, atB, atA, t8, wid, lane);
            }
        } else {
            bf16x8 gA[8], gB[8];
            f32x16 S00 = {}, S01 = {}, S10 = {}, S11 = {};
#pragma unroll
            for (int i = 0; i < 8; ++i) { const int idx = t8 + 256 * i, rr = idx >> 5, cc = idx & 31; gA[i] = *(const bf16x8*)(c.P + (size_t)(row_0 + rr) * LDP + c.kcol0 + cc * 8); }
            asm volatile("" ::: "memory");
#pragma unroll
            for (int i = 0; i < 8; ++i) { const int idx = t8 + 256 * i, rr = idx >> 5, cc = idx & 31; gB[i] = *(const bf16x8*)(c.P + (size_t)(row_1 + rr) * LDP + c.kcol0 + cc * 8); }
            for (int step = 0; step < NSTEP; step += 2) {
                ret_step_s(L, c, step, gA, S00, S01, S10, S11, t8, wid, lane);
                ret_step_s(L, c, step + 1, gB, S00, S01, S10, S11, t8, wid, lane);
            }
        }
    }
}
__device__ __forceinline__ void retnorm_phase(const Params& p) {
    const bf16_t* OF = (const bf16_t*)(p.ws + WS_OF); const bf16_t* OB = (const bf16_t*)(p.ws + WS_OB); const bf16_t* P = (const bf16_t*)(p.ws + WS_P); bf16_t* G = (bf16_t*)(p.ws + WS_G);
    const int wid = threadIdx.x >> 6, lane = threadIdx.x & 63;
    for (int unit0 = (blockIdx.x * 8 + wid) * 4; unit0 < MROWS * 16; unit0 += gridDim.x * 32) {
        u32x4 a[4], b[4], z[4];
#pragma unroll
        for (int j = 0; j < 4; ++j) { const int unit = unit0 + j, row = unit >> 4, h = unit & 15; const size_t off = (size_t)row * 8192 + h * 512 + lane * 8;
            a[j] = __builtin_nontemporal_load((const u32x4*)(OF + off)); b[j] = __builtin_nontemporal_load((const u32x4*)(OB + off)); z[j] = __builtin_nontemporal_load((const u32x4*)(P + (size_t)row * RT_INW + 16384 + h * 512 + lane * 8)); }
#pragma unroll
        for (int j = 0; j < 4; ++j) { const int unit = unit0 + j, row = unit >> 4, h = unit & 15; const size_t off = (size_t)row * 8192 + h * 512 + lane * 8;
            float o[8];
            o[0] = bf_lo(a[j].x) + bf_lo(b[j].x); o[1] = bf_hi(a[j].x) + bf_hi(b[j].x); o[2] = bf_lo(a[j].y) + bf_lo(b[j].y); o[3] = bf_hi(a[j].y) + bf_hi(b[j].y);
            o[4] = bf_lo(a[j].z) + bf_lo(b[j].z); o[5] = bf_hi(a[j].z) + bf_hi(b[j].z); o[6] = bf_lo(a[j].w) + bf_lo(b[j].w); o[7] = bf_hi(a[j].w) + bf_hi(b[j].w);
            float s = ((o[0] + o[1]) + (o[2] + o[3])) + ((o[4] + o[5]) + (o[6] + o[7]));
#pragma unroll
            for (int x = 32; x >= 1; x >>= 1) s += __shfl_xor(s, x);
            const float mu = s * (1.0f / 512.0f);
            float q = 0.f;
#pragma unroll
            for (int k = 0; k < 8; ++k) { o[k] -= mu; q += o[k] * o[k]; }
#pragma unroll
            for (int x = 32; x >= 1; x >>= 1) q += __shfl_xor(q, x);
            const float rstd = 1.0f / sqrtf(q * (1.0f / 512.0f) + LN_EPS);
            u32x4 w;
            w.x = cvt_pk_bf16(o[0] * rstd * silu_f(bf_lo(z[j].x)), o[1] * rstd * silu_f(bf_hi(z[j].x))); w.y = cvt_pk_bf16(o[2] * rstd * silu_f(bf_lo(z[j].y)), o[3] * rstd * silu_f(bf_hi(z[j].y)));
            w.z = cvt_pk_bf16(o[4] * rstd * silu_f(bf_lo(z[j].z)), o[5] * rstd * silu_f(bf_hi(z[j].z))); w.w = cvt_pk_bf16(o[6] * rstd * silu_f(bf_lo(z[j].w)), o[7] * rstd * silu_f(bf_hi(z[j].w)));
            *(u32x4*)(G + off) = w; }
    }
}

__device__ __forceinline__ int s5_row(int dir, int n) { return n < NCTX ? (dir ? SEQ + NCTX - 1 - n : SEQ + n) : (dir ? SEQ - 1 - (n - NCTX) : n - NCTX); }
__device__ __forceinline__ bf16x8 pack8(const float* v) { u32x4 w; w.x = cvt_pk_bf16(v[0], v[1]); w.y = cvt_pk_bf16(v[2], v[3]); w.z = cvt_pk_bf16(v[4], v[5]); w.w = cvt_pk_bf16(v[6], v[7]); return *reinterpret_cast<bf16x8*>(&w); }
__device__ __forceinline__ void s5_scan_phase(LAS unsigned char* L, const Params& p) {
    const bf16_t* P = (const bf16_t*)(p.ws + WS_P);
    const int tid = threadIdx.x, wid = __builtin_amdgcn_readfirstlane(tid >> 6), lane = tid & 63, pl = lane & 31, hi = lane >> 5;
    const int dir = wid >> 2, seg = wid & 3;
    constexpr int NBS = (MROWS / 32) / 4;
    bf16_t* Y = (bf16_t*)(p.ws + WS_OF) + (size_t)dir * SEQ * DM;
    LAS unsigned char* T = L + wid * 10240;
    LAS float* EX = (LAS float*)(L + 81920);
    const unsigned Tb = (unsigned)(uintptr_t)T;
    for (int g = blockIdx.x; g < 256; g += gridDim.x) {
        const float dt = expf(p.in[I_S5_LDT][dir * 256 + g]);
        float lr[2], li[2], l16r[2], l16i[2], lsr[2], lsi[2]; bf16x8 Bre[2], Bim[2];
#pragma unroll
        for (int pb = 0; pb < 2; ++pb) {
            const int pp = pb * 32 + pl;
            const float are = p.in[I_S5_ARE][(size_t)(dir * 256 + g) * 64 + pp], aim = p.in[I_S5_AIM][(size_t)(dir * 256 + g) * 64 + pp];
            const float er = expf(are * dt); float sn, cs; sincosf(aim * dt, &sn, &cs);
            lr[pb] = er * cs; li[pb] = er * sn;
            { const float e16 = expf(are * dt * 16.0f); float s16, c16; sincosf(aim * dt * 16.0f, &s16, &c16); l16r[pb] = e16 * c16; l16i[pb] = e16 * s16; }
            { const float es = expf(are * dt * (float)(NBS * 32)); float ss, cs2; sincosf(aim * dt * (float)(NBS * 32), &ss, &cs2); lsr[pb] = es * cs2; lsi[pb] = es * ss; }
            const float den = are * are + aim * aim, nr = lr[pb] - 1.0f, ni = li[pb];
            const float cr = (nr * are + ni * aim) / den, ci = (ni * are - nr * aim) / den;
            float br_[8], bi_[8];
#pragma unroll
            for (int j = 0; j < 8; ++j) { const size_t bo = ((size_t)g * 64 + pp) * 16 + 8 * hi + j; const float br = p.in[I_S5_BRE][bo], bi = p.in[I_S5_BIM][bo];
                br_[j] = cr * br - ci * bi; bi_[j] = cr * bi + ci * br; }
            Bre[pb] = pack8(br_); Bim[pb] = pack8(bi_);
        }
        const int slot_proc = 16 * ((pl >> 2) & 1) + (pl & 3) + 4 * (pl >> 3);
        const int nb0 = seg * NBS;
        float cinr[2] = {0.f, 0.f}, cini[2] = {0.f, 0.f};
        if (seg < 3) {
            bf16x8 uf = *(const bf16x8*)(P + (size_t)s5_row(dir, nb0 * 32 + slot_proc) * S5_INW + 16 * g + 8 * hi);
            for (int nb = nb0; nb < nb0 + NBS; ++nb) {
                const bf16x8 ucur = uf;
                if (nb + 1 < nb0 + NBS) uf = *(const bf16x8*)(P + (size_t)s5_row(dir, nb * 32 + 32 + slot_proc) * S5_INW + 16 * g + 8 * hi);
#pragma unroll
                for (int pb = 0; pb < 2; ++pb) {
                    const f32x16 xr = __builtin_amdgcn_mfma_f32_32x32x16_bf16(ucur, Bre[pb], f32x16{}, 0, 0, 0);
                    const f32x16 xi = __builtin_amdgcn_mfma_f32_32x32x16_bf16(ucur, Bim[pb], f32x16{}, 0, 0, 0);
                    const float a = lr[pb], b = li[pb];
                    float cr = hi ? 0.f : cinr[pb], ci = hi ? 0.f : cini[pb];
#pragma unroll
                    for (int r = 0; r < 16; ++r) { const float nr = fmaf(a, cr, fmaf(-b, ci, xr[r])), ni = fmaf(a, ci, fmaf(b, cr, xi[r])); cr = nr; ci = ni; }
                    const float e0r = __shfl(cr, pl), e0i = __shfl(ci, pl), e1r = __shfl(cr, pl + 32), e1i = __shfl(ci, pl + 32);
                    cinr[pb] = e1r + l16r[pb] * e0r - l16i[pb] * e0i; cini[pb] = e1i + l16r[pb] * e0i + l16i[pb] * e0r;
                }
            }
            if (hi == 0) {
#pragma unroll
                for (int pb = 0; pb < 2; ++pb) { EX[(((dir * 4 + seg) * 2 + pb) * 2 + 0) * 32 + pl] = cinr[pb]; EX[(((dir * 4 + seg) * 2 + pb) * 2 + 1) * 32 + pl] = cini[pb]; }
            }
        }
        __syncthreads();
#pragma unroll
        for (int pb = 0; pb < 2; ++pb) {
            float xr = 0.f, xi = 0.f;
            for (int s = 0; s < seg; ++s) { const float er = EX[(((dir * 4 + s) * 2 + pb) * 2 + 0) * 32 + pl], ei = EX[(((dir * 4 + s) * 2 + pb) * 2 + 1) * 32 + pl];
                const float nr = lsr[pb] * xr - lsi[pb] * xi + er, ni = lsr[pb] * xi + lsi[pb] * xr + ei; xr = nr; xi = ni; }
            cinr[pb] = xr; cini[pb] = xi;
        }
        bf16x8 Cf[8];
#pragma unroll
        for (int s = 0; s < 8; ++s) { float cv[8];
#pragma unroll
            for (int j = 0; j < 8; ++j) { const int k = 16 * s + 8 * hi + j, x = k >> 6, pp = k & 63; const size_t co = ((size_t)g * 16 + (pl & 15)) * 64 + pp;
                const float v = x ? -p.in[I_S5_CIM][co] : p.in[I_S5_CRE][co]; cv[j] = (pl < 16) ? v : 0.f; }
            Cf[s] = pack8(cv); }
        bf16x8 uf = *(const bf16x8*)(P + (size_t)s5_row(dir, nb0 * 32 + slot_proc) * S5_INW + 16 * g + 8 * hi);
        for (int nb = nb0; nb < nb0 + NBS; ++nb) {
            const int n0 = nb * 32;
            const bf16x8 ucur = uf;
            if (nb + 1 < nb0 + NBS) uf = *(const bf16x8*)(P + (size_t)s5_row(dir, n0 + 32 + slot_proc) * S5_INW + 16 * g + 8 * hi);
            f32x16 xr[2], xi[2];
#pragma unroll
            for (int pb = 0; pb < 2; ++pb) {
                xr[pb] = __builtin_amdgcn_mfma_f32_32x32x16_bf16(ucur, Bre[pb], f32x16{}, 0, 0, 0);
                xi[pb] = __builtin_amdgcn_mfma_f32_32x32x16_bf16(ucur, Bim[pb], f32x16{}, 0, 0, 0);
            }
#pragma unroll
            for (int pb = 0; pb < 2; ++pb) {
                const float a = lr[pb], b = li[pb];
                float cr = cinr[pb], ci = cini[pb];
#pragma unroll
                for (int r = 0; r < 16; ++r) { const float nr = fmaf(a, cr, fmaf(-b, ci, xr[pb][r])), ni = fmaf(a, ci, fmaf(b, cr, xi[pb][r])); cr = nr; ci = ni; }
                const float e0r = __shfl(cr, pl), e0i = __shfl(ci, pl);
                cr = hi ? e0r : cinr[pb]; ci = hi ? e0i : cini[pb];
#pragma unroll
                for (int r = 0; r < 16; ++r) { const float nr = fmaf(a, cr, fmaf(-b, ci, xr[pb][r])), ni = fmaf(a, ci, fmaf(b, cr, xi[pb][r])); cr = nr; ci = ni; xr[pb][r] = nr; xi[pb][r] = ni; }
                cinr[pb] = __shfl(cr, pl + 32); cini[pb] = __shfl(ci, pl + 32);
            }
            if (n0 >= NCTX) {
#pragma unroll
                for (int pb = 0; pb < 2; ++pb) {
                    u32x4 w0, w1;
                    w0.x = cvt_pk_bf16(xr[pb][0], xr[pb][1]); w0.y = cvt_pk_bf16(xr[pb][2], xr[pb][3]); w0.z = cvt_pk_bf16(xr[pb][4], xr[pb][5]); w0.w = cvt_pk_bf16(xr[pb][6], xr[pb][7]);
                    w1.x = cvt_pk_bf16(xr[pb][8], xr[pb][9]); w1.y = cvt_pk_bf16(xr[pb][10], xr[pb][11]); w1.z = cvt_pk_bf16(xr[pb][12], xr[pb][13]); w1.w = cvt_pk_bf16(xr[pb][14], xr[pb][15]);
                    LAS unsigned char* d = T + (pb * 32 + pl) * 80 + 32 * hi;
                    *(LAS u32x4*)d = w0; *(LAS u32x4*)(d + 16) = w1;
                    w0.x = cvt_pk_bf16(xi[pb][0], xi[pb][1]); w0.y = cvt_pk_bf16(xi[pb][2], xi[pb][3]); w0.z = cvt_pk_bf16(xi[pb][4], xi[pb][5]); w0.w = cvt_pk_bf16(xi[pb][6], xi[pb][7]);
                    w1.x = cvt_pk_bf16(xi[pb][8], xi[pb][9]); w1.y = cvt_pk_bf16(xi[pb][10], xi[pb][11]); w1.z = cvt_pk_bf16(xi[pb][12], xi[pb][13]); w1.w = cvt_pk_bf16(xi[pb][14], xi[pb][15]);
                    d += 64 * 80;
                    *(LAS u32x4*)d = w0; *(LAS u32x4*)(d + 16) = w1;
                }
                asm volatile("s_waitcnt lgkmcnt(0)" ::: "memory");
                s16x4 tl[8], th[8];
#pragma unroll
                for (int s = 0; s < 8; ++s) trfrag_issue(tl[s], th[s], Tb, 80, 16 * s, 0, lane);
                tr_wait();
                f32x16 y = {};
#pragma unroll
                for (int s = 0; s < 8; ++s) y = __builtin_amdgcn_mfma_f32_32x32x16_bf16(Cf[s], TRPK(tl[s], th[s]), y, 0, 0, 0);
                { bf16_t* yp = Y + (size_t)s5_row(dir, n0 + pl) * DM + 16 * g + 4 * hi;
                  u32x2 w0, w1; w0.x = cvt_pk_bf16(y[0], y[1]); w0.y = cvt_pk_bf16(y[2], y[3]); w1.x = cvt_pk_bf16(y[4], y[5]); w1.y = cvt_pk_bf16(y[6], y[7]);
                  *(u32x2*)yp = w0; *(u32x2*)(yp + 8) = w1; }
                asm volatile("s_waitcnt lgkmcnt(0)" ::: "memory");
            }
        }
        __syncthreads();
    }
}
__device__ __forceinline__ void s5_prep_phase(LAS unsigned char* lds, const Params& p) {
    const bf16_t* YF = (const bf16_t*)(p.ws + WS_OF); const bf16_t* YB = YF + (size_t)SEQ * DM; const bf16_t* P = (const bf16_t*)(p.ws + WS_P);
    bf16_t* A2 = (bf16_t*)(p.ws + WS_OB);
    LAS float* dsk = (LAS float*)lds;
    __syncthreads();
    for (int k = threadIdx.x; k < 1024; k += NTHREADS) *(LAS f32x4*)(dsk + 4 * k) = *(const f32x4*)(p.in[I_S5_D] + 4 * k);
    __syncthreads();
    const size_t nchunk = (size_t)SEQ * (DM / 8), stride = (size_t)gridDim.x * NTHREADS;
    for (size_t ch0 = (size_t)blockIdx.x * NTHREADS + threadIdx.x; ch0 < nchunk; ch0 += 4 * stride) {
        u32x4 a[4], b[4], u[4];
#pragma unroll
        for (int j = 0; j < 4; ++j) { const size_t ch = ch0 + j * stride; if (ch < nchunk) { const int row = (int)(ch >> 9), col = (int)(ch & 511) * 8;
            a[j] = __builtin_nontemporal_load((const u32x4*)(YF + (size_t)row * DM + col)); b[j] = __builtin_nontemporal_load((const u32x4*)(YB + (size_t)row * DM + col)); u[j] = __builtin_nontemporal_load((const u32x4*)(P + (size_t)row * S5_INW + col)); } }
#pragma unroll
        for (int j = 0; j < 4; ++j) { const size_t ch = ch0 + j * stride; if (ch < nchunk) { const int row = (int)(ch >> 9), col = (int)(ch & 511) * 8;
            const f32x4 d0 = *(const LAS f32x4*)(dsk + col), d1 = *(const LAS f32x4*)(dsk + col + 4);
            float v[8];
            v[0] = bf_lo(a[j].x) + bf_lo(b[j].x) + d0[0] * bf_lo(u[j].x); v[1] = bf_hi(a[j].x) + bf_hi(b[j].x) + d0[1] * bf_hi(u[j].x);
            v[2] = bf_lo(a[j].y) + bf_lo(b[j].y) + d0[2] * bf_lo(u[j].y); v[3] = bf_hi(a[j].y) + bf_hi(b[j].y) + d0[3] * bf_hi(u[j].y);
            v[4] = bf_lo(a[j].z) + bf_lo(b[j].z) + d1[0] * bf_lo(u[j].z); v[5] = bf_hi(a[j].z) + bf_hi(b[j].z) + d1[1] * bf_hi(u[j].z);
            v[6] = bf_lo(a[j].w) + bf_lo(b[j].w) + d1[2] * bf_lo(u[j].w); v[7] = bf_hi(a[j].w) + bf_hi(b[j].w) + d1[3] * bf_hi(u[j].w);
#pragma unroll
            for (int k = 0; k < 8; ++k) { const float x = v[k], zz = 0.7978845608028654f * (x + 0.044715f * x * x * x); const float t = 1.0f - 2.0f * __builtin_amdgcn_rcpf(__expf(2.0f * zz) + 1.0f); v[k] = 0.5f * x * (1.0f + t); }
            u32x4 w; w.x = cvt_pk_bf16(v[0], v[1]); w.y = cvt_pk_bf16(v[2], v[3]); w.z = cvt_pk_bf16(v[4], v[5]); w.w = cvt_pk_bf16(v[6], v[7]);
            *(u32x4*)(A2 + (size_t)row * DM + col) = w; } }
    }
}

constexpr int N_PHASES = 21;
typedef const __attribute__((address_space(4))) Params* KParamsPtr;
__global__ void __launch_bounds__(NTHREADS, 2) mega_fwd(Params p) {
    extern __shared__ __attribute__((aligned(16))) unsigned char lds_raw[];
    LAS unsigned char* L = (LAS unsigned char*)lds_raw;
    const int tid = threadIdx.x;
    if (tid < 4) ((LAS unsigned*)(L + MISC_OFF))[tid] = 0u;
    __syncthreads();
    const int lo = p.ph_lo, hi = p.ph_hi;
    XcdBarrier bar; bar.bar = (unsigned*)(p.ws + WS_CTL); bar.x = 0; bar.st = (volatile LAS unsigned*)(L + MISC_OFF);
    if (hi - lo > 1) bar = xcd_barrier_post((unsigned*)(p.ws + WS_CTL), (volatile LAS unsigned*)(L + MISC_OFF));
#ifndef PH_MASK
#define PH_MASK 0x1fffff
#endif
#define IN(k) (((PH_MASK >> (k)) & 1) && lo <= (k) && (k) < hi)
#define SEAM(k) do { if (IN((k) + 1)) xcd_barrier(bar); } while (0)
#ifndef REP_MASK
#define REP_MASK 0
#endif
#define REP(k) (((REP_MASK) >> (k)) & 1)
#define PHASE(k, ...) if (IN(k)) { _Pragma("nounroll") for (int rep_ = 0; rep_ <= REP(k); ++rep_) { { LOADP(); __VA_ARGS__ } if (rep_ < REP(k)) xcd_barrier(bar); } SEAM(k); }
    const int GR = gridDim.x, BX = blockIdx.x;
#define LOADP() Params lp; { KParamsPtr q_ = (KParamsPtr)__builtin_amdgcn_kernarg_segment_ptr(); asm volatile("" : "+s"(q_)); __builtin_memcpy(&lp, q_, sizeof(Params)); } \
    const float* mod = (const float*)(lp.ws + WS_MOD); const bf16_t* Wb = (const bf16_t*)(lp.ws + WS_W); float* X = (float*)(lp.ws + WS_X); \
    bf16_t* H = (bf16_t*)(lp.ws + WS_H); bf16_t* Pb = (bf16_t*)(lp.ws + WS_P); bf16_t* G = (bf16_t*)(lp.ws + WS_G); \
    const float* ropeA = (const float*)(lp.ws + WS_ROPEA); const float* ropeB = (const float*)(lp.ws + WS_ROPEB); \
    (void)mod; (void)Wb; (void)X; (void)H; (void)Pb; (void)G; (void)ropeA; (void)ropeB;
#define DYN_ORDER(S_, MM, NN, GIDX) pg8::DynOrder S_; S_.init((MM), (NN), (unsigned*)(lp.ws + WS_CTL + 16384 + (GIDX) * 2048), (volatile LAS int*)(L + 131072), (int)xb_xcc_id()); S_.prime()
#define RUN_IN(WOFF, NN, EPI, GIDX) do { pg8::Gemm g_{H, Wb + (WOFF), MROWS, (NN), DM}; DYN_ORDER(S_, MROWS, (NN), (GIDX)); \
        pg8::gemm_phase<decltype(EPI), pg8::DynOrder, true, true>(L, g_, S_, EPI); } while (0)
#define RUN_OUT(LAYER, WOFF, KK, CTX) do { pg8::Gemm g_{G, Wb + (WOFF), SEQ, DM, (KK)}; \
        pg8::EpiOut E_{H, DM, (float*)(lp.ws + WS_YS)}; \
        pg8::DynOrder S_; S_.init(SEQ, DM, (unsigned*)(lp.ws + WS_CTL + 16384 + (4 + (LAYER)) * 2048), (volatile LAS int*)(L + 131072), (int)xb_xcc_id(), (CTX) ? 16 : 0, SEQ / 256, (KK) / 64 / 16); S_.prime(); \
        pg8::gemm_phase<pg8::EpiOut, pg8::DynOrder, true, true>(L, g_, S_, E_); } while (0)

    PHASE(0, p0_prologue(L, lp);)
    PHASE(1, p1_modulate(L, lp);)
    PHASE(2, pg8::EpiIn<0> E{Pb, WA_INW, ropeA, ropeB, SEQ}; RUN_IN(W_WA_IN, WA_INW, E, 0); cvt_tail(L, lp, 0);)
    PHASE(3, mixerA_phase(lds_raw, lp);)
    PHASE(4, RUN_OUT(0, W_WA_OUT, 4096, true);)
    PHASE(5, ln_phase(L, lp, 0, MROWS, X, true, true);)
    PHASE(6, pg8::EpiIn<1> E{Pb, RT_INW, ropeA, ropeB, SEQ}; RUN_IN(W_RT_IN, RT_INW, E, 1); cvt_tail(L, lp, 1);)
    PHASE(7, retatt_phase(L, lp); xcd_barrier(bar); retention_phase(L, lp);)
    PHASE(8, retnorm_phase(lp);)
    PHASE(9, RUN_OUT(1, W_RT_OUT, 8192, true);)
    PHASE(10, ln_phase(L, lp, 1, MROWS, X, true, true);)
    PHASE(11, pg8::EpiIn<2> E{Pb, NA_INW, ropeA, ropeB, SEQ}; RUN_IN(W_NA_IN, NA_INW, E, 2); cvt_tail(L, lp, 2);)
    PHASE(12, mixerC_phase(lds_raw, lp);)
    PHASE(13, RUN_OUT(2, W_NA_OUT, 4096, true);)
    PHASE(14, ln_phase(L, lp, 2, MROWS, X, true, true);)
    PHASE(15, pg8::EpiIn<3> E{Pb, S5_INW, ropeA, ropeB, SEQ};
        { EpiCPlain EC_{Pb + (size_t)SEQ * S5_INW, S5_INW}; for (int it_ = BX; it_ < 256; it_ += GR) ctx_gemm64(L, H + (size_t)SEQ * DM, Wb + W_S5_IN, DM, it_, EC_); }
        { pg8::Gemm g_{H, Wb + W_S5_IN, SEQ, S5_INW, DM}; DYN_ORDER(S_, SEQ, S5_INW, 3); pg8::gemm_phase<pg8::EpiIn<3>, pg8::DynOrder, true, true>(L, g_, S_, E); })
    PHASE(16, s5_scan_phase(L, lp);)
    PHASE(17, s5_prep_phase(L, lp);)
    PHASE(18, const bf16_t* A2 = (const bf16_t*)(lp.ws + WS_OB);
        pg8::Gemm g_{A2, Wb + W_S5_GLU, SEQ, DM, DM}; DYN_ORDER(S_, SEQ, DM, 8);
        pg8::EpiGlu E{A2, DM, Pb, S5_INW, 4096, lp.in[I_S5_BGLU], G, DM};
        pg8::gemm_phase<pg8::EpiGlu, pg8::DynOrder, true, true>(L, g_, S_, E);)
    PHASE(19, RUN_OUT(3, W_S5_OUT, 4096, false);)
    PHASE(20, ln_phase(L, lp, 3, SEQ, lp.out, false, false);)
#undef IN
#undef SEAM
#undef RUN_IN
#undef RUN_OUT
#undef DYN_ORDER
#undef LOADP
}

#ifdef DUMP_PH
__global__ void dump_x(const float* X, float* out, size_t n) { for (size_t i = (size_t)blockIdx.x * blockDim.x + threadIdx.x; i < n; i += (size_t)gridDim.x * blockDim.x) out[i] = X[i]; }
__global__ void dump_b(const bf16_t* X, float* out, size_t n) { for (size_t i = (size_t)blockIdx.x * blockDim.x + threadIdx.x; i < n; i += (size_t)gridDim.x * blockDim.x) out[i] = bf2f(X[i]); }
#ifndef DUMP_OFF
#define DUMP_OFF WS_X
#endif
#ifndef DUMP_BF
#define DUMP_BF 0
#endif
#endif
#ifndef MK_N_LAUNCHES
#define MK_N_LAUNCHES 1
#endif
extern "C" void kernel_launch(void* const* d_in, const int* in_sizes, int n_in, void* d_out, int out_size, void* d_ws, size_t ws_size, hipStream_t stream) {
    static int grid = 0;
    if (grid == 0) {
        if (n_in != 29 || out_size != SEQ * DM || ws_size < WS_END) { fprintf(stderr, "kernel_launch: unexpected shapes: n_in %d out %d ws %zu (need %zu)\n", n_in, out_size, ws_size, (size_t)WS_END); grid = -1; return; }
        int dev = 0, cus = 0, per_cu = 0;
        if (hipGetDevice(&dev) != hipSuccess || hipDeviceGetAttribute(&cus, hipDeviceAttributeMultiprocessorCount, dev) != hipSuccess) { grid = -1; return; }
        if (hipFuncSetAttribute((const void*)mega_fwd, hipFuncAttributeMaxDynamicSharedMemorySize, LDS_BYTES) != hipSuccess) { fprintf(stderr, "kernel_launch: hipFuncSetAttribute failed\n"); grid = -1; return; }
        if (hipOccupancyMaxActiveBlocksPerMultiprocessor(&per_cu, (const void*)mega_fwd, NTHREADS, LDS_BYTES) != hipSuccess || per_cu < 1) { fprintf(stderr, "kernel_launch: occupancy query reports %d\n", per_cu); per_cu = 1; }
        (void)hipGetLastError();
        grid = cus;
    }
    if (grid < 0) return;
    if (hipMemsetAsync((char*)d_ws + WS_CTL, 0, 65536, stream) != hipSuccess) return;
    Params a{};
    for (int i = 0; i < 29; ++i) a.in[i] = (const float*)d_in[i];
    a.out = (float*)d_out; a.ws = (unsigned char*)d_ws;
    if (MK_N_LAUNCHES == 1) { a.ph_lo = 0; a.ph_hi = N_PHASES; hipLaunchKernelGGL(mega_fwd, dim3(grid), dim3(NTHREADS), LDS_BYTES, stream, a); }
#ifdef DUMP_PH
    else { for (int ph = 0; ph < DUMP_PH; ++ph) { a.ph_lo = ph; a.ph_hi = ph + 1; hipLaunchKernelGGL(mega_fwd, dim3(grid), dim3(NTHREADS), LDS_BYTES, stream, a); }
           if (DUMP_BF) hipLaunchKernelGGL(dump_b, dim3(2048), dim3(256), 0, stream, (const bf16_t*)((char*)d_ws + DUMP_OFF), (float*)d_out, (size_t)SEQ * DM);
           else hipLaunchKernelGGL(dump_x, dim3(2048), dim3(256), 0, stream, (const float*)((char*)d_ws + DUMP_OFF), (float*)d_out, (size_t)SEQ * DM); }
#else
    else for (int ph = 0; ph < N_PHASES; ++ph) { a.ph_lo = ph; a.ph_hi = ph + 1; hipLaunchKernelGGL(mega_fwd, dim3(grid), dim3(NTHREADS), LDS_BYTES, stream, a); }
#endif
    const hipError_t le = hipPeekAtLastError();
    if (le != hipSuccess) fprintf(stderr, "kernel_launch: launch failed: %s\n", hipGetErrorName(le));
}
```
